# Optimizing an MI355X kernel written in HIP

```python
import jax, jax.numpy as jnp
from jax import lax
import numpy as np

D_MODEL = 1024
BATCH = 2
SEQ = 16384
DEPTH = 2
DEC_BATCH = 8
DEC_SEQ = 4096
PAST_LEN = 128

N_EVEN = (DEPTH + 1) // 2
N_ODD = DEPTH // 2
EPS = 1e-6

D_RNN = D_MODEL // 2
RG_HEADS = 8
RG_HEAD_DIM = D_RNN // RG_HEADS
RG_CONV = 4
RG_C = 8.0
MLA_HEADS = 8
Q_LORA = D_MODEL // 4
KV_LORA = D_MODEL // 8
QK_NOPE = 64
QK_ROPE = 32
V_DIM = 64
QK_DIM = QK_NOPE + QK_ROPE
ROPE_THETA = 10000.0
Q_BLOCK = 128
AB_IN = 2 * D_RNN + Q_LORA + KV_LORA + QK_ROPE
AB_OUT = D_RNN + MLA_HEADS * V_DIM
D_CONV = D_MODEL
C_CONV = 3
PEER_HEADS = 8
N_KEYS = 128
N_EXPERTS = N_KEYS * N_KEYS
PEER_TOPK = 16
D_KEY = 256
PEER_CHUNK = 128

kernel_name = 'hybrid_bidir_rglru_mla_shortconv_peer'


def rms_norm(x, g):
    xf = x.astype(jnp.float32)
    y = xf * lax.rsqrt(jnp.mean(xf * xf, axis=-1, keepdims=True) + EPS)
    return (y * g.astype(jnp.float32)).astype(x.dtype)


def depthwise_conv(x, w, pad):
    return lax.conv_general_dilated(x, w[:, None, :].astype(x.dtype), window_strides=(1,), padding=[pad],
                                    dimension_numbers=('NWC', 'WIO', 'NWC'), feature_group_count=x.shape[-1])


def _lin_combine(e1, e2):
    a1, b1 = e1
    a2, b2 = e2
    return a1 * a2, a2 * b1 + b2


def rg_lru_scan(xc, wa, ba, wx, bx, lam):
    b_, s_, _ = xc.shape
    xh = xc.reshape(b_, s_, RG_HEADS, RG_HEAD_DIM)
    r = jax.nn.sigmoid(jnp.einsum('bshi,hij->bshj', xh, wa.astype(jnp.float32)).reshape(b_, s_, D_RNN) + ba.astype(jnp.float32))
    i = jax.nn.sigmoid(jnp.einsum('bshi,hij->bshj', xh, wx.astype(jnp.float32)).reshape(b_, s_, D_RNN) + bx.astype(jnp.float32))
    log_a = -RG_C * r * jax.nn.softplus(-lam.astype(jnp.float32))
    a = jnp.exp(log_a)
    b = jnp.sqrt(-jnp.expm1(2.0 * log_a)) * (i * xc)
    _, h = lax.associative_scan(_lin_combine, (a, b), axis=1)
    return h


def rope_tables(s_):
    inv = 1.0 / (ROPE_THETA ** (jnp.arange(0, QK_ROPE, 2, dtype=jnp.float32) / QK_ROPE))
    ang = jnp.arange(s_, dtype=jnp.float32)[:, None] * inv[None, :]
    return jnp.cos(ang), jnp.sin(ang)


def apply_rope(t, cos, sin):
    half = QK_ROPE // 2
    nope = t[..., :QK_NOPE]
    rot = t[..., QK_NOPE:].astype(jnp.float32)
    r1, r2 = rot[..., :half], rot[..., half:]
    c = cos[None, :, None, :]
    s = sin[None, :, None, :]
    rot = jnp.concatenate([r1 * c - r2 * s, r2 * c + r1 * s], axis=-1)
    return jnp.concatenate([nope, rot.astype(t.dtype)], axis=-1)


def block_attention(q, k, v):
    b_, s_, h_, dq = q.shape
    nb = s_ // Q_BLOCK
    qb = q.reshape(b_, nb, Q_BLOCK, h_, dq).transpose(1, 0, 2, 3, 4)
    scale = QK_DIM ** -0.5

    def one(qblk):
        s = jnp.einsum('bqhd,bkhd->bhqk', qblk, k).astype(jnp.float32) * scale
        p = jax.nn.softmax(s, axis=-1).astype(v.dtype)
        return jnp.einsum('bhqk,bkhd->bqhd', p, v)

    o = lax.map(one, qb)
    return o.transpose(1, 0, 2, 3, 4).reshape(b_, s_, h_ * V_DIM)


def mixer_ab(h, w_in, conv_w, conv_b, rg_wa, rg_ba, rg_wx, rg_bx, rg_lam,
             q_norm, w_uq, kv_norm, w_ukv, qn_q, qn_k, w_out):
    b_, s_, _ = h.shape
    z = h @ w_in
    cuts = [D_RNN, 2 * D_RNN, 2 * D_RNN + Q_LORA, 2 * D_RNN + Q_LORA + KV_LORA]
    xr, yr, q_lat, kv_lat, k_rope = jnp.split(z, cuts, axis=-1)
    xr = depthwise_conv(xr, conv_w, (2, 1)) + conv_b
    xf = xr.astype(jnp.float32)
    h_fw = rg_lru_scan(xf, rg_wa[0], rg_ba[0], rg_wx[0], rg_bx[0], rg_lam[0])
    h_bw = jnp.flip(rg_lru_scan(jnp.flip(xf, axis=1), rg_wa[1], rg_ba[1], rg_wx[1], rg_bx[1], rg_lam[1]), axis=1)
    rg_out = (h_fw + h_bw).astype(h.dtype) * jax.nn.gelu(yr)
    q = (rms_norm(q_lat, q_norm) @ w_uq).reshape(b_, s_, MLA_HEADS, QK_DIM)
    kv = (rms_norm(kv_lat, kv_norm) @ w_ukv).reshape(b_, s_, MLA_HEADS, QK_NOPE + V_DIM)
    k_nope, v = kv[..., :QK_NOPE], kv[..., QK_NOPE:]
    k = jnp.concatenate([k_nope, jnp.broadcast_to(k_rope[:, :, None, :], (b_, s_, MLA_HEADS, QK_ROPE))], axis=-1)
    q = rms_norm(q, qn_q)
    k = rms_norm(k, qn_k)
    cos, sin = rope_tables(s_)
    q = apply_rope(q, cos, sin)
    k = apply_rope(k, cos, sin)
    attn = block_attention(q, k, v)
    return jnp.concatenate([rg_out, attn], axis=-1) @ w_out


def mixer_c(h, w_in, conv_w, w_out):
    z = h @ w_in
    bg, cg, xin = jnp.split(z, 3, axis=-1)
    y = bg * depthwise_conv(cg * xin, conv_w, (1, 1))
    return y @ w_out


def peer(h, wq, k1, k2, u, v):
    b_, s_, d = h.shape
    t = b_ * s_
    hf = h.reshape(t, d)
    q = (hf @ wq).reshape(t, PEER_HEADS, D_KEY).astype(jnp.float32)
    half = D_KEY // 2
    s1 = jnp.einsum('thd,nd->thn', q[..., :half], k1.astype(jnp.float32))
    s2 = jnp.einsum('thd,nd->thn', q[..., half:], k2.astype(jnp.float32))
    v1, i1 = lax.top_k(s1, PEER_TOPK)
    v2, i2 = lax.top_k(s2, PEER_TOPK)
    cand = (v1[..., :, None] + v2[..., None, :]).reshape(t, PEER_HEADS, PEER_TOPK * PEER_TOPK)
    vs, j = lax.top_k(cand, PEER_TOPK)
    e1 = jnp.take_along_axis(i1, j // PEER_TOPK, axis=-1)
    e2 = jnp.take_along_axis(i2, j % PEER_TOPK, axis=-1)
    idx = e1 * N_KEYS + e2
    g = jax.nn.softmax(vs, axis=-1).astype(h.dtype)
    nc = t // PEER_CHUNK

    def chunk(args):
        xc, ic, gc = args
        act = jax.nn.gelu(jnp.einsum('chkd,cd->chk', u[ic], xc)) * gc
        return jnp.einsum('chk,chkd->cd', act, v[ic])

    out = lax.map(chunk, (hf.reshape(nc, PEER_CHUNK, d),
                          idx.reshape(nc, PEER_CHUNK, PEER_HEADS, PEER_TOPK),
                          g.reshape(nc, PEER_CHUNK, PEER_HEADS, PEER_TOPK)))
    return out.reshape(b_, s_, d)


def trunk(x, c, p):
    for i in range(DEPTH):
        mod = jax.nn.silu(c) @ p['ada_w'][i] + p['ada_b'][i]
        sh1, sc1, g1, sh2, sc2, g2 = jnp.split(mod[:, None, :], 6, axis=-1)
        h = rms_norm(x, p['norm1_g'][i]) * (1.0 + sc1) + sh1
        if i % 2 == 0:
            j = i // 2
            m = mixer_ab(h, p['ab_w_in'][j], p['rg_conv_w'][j], p['rg_conv_b'][j], p['rg_wa'][j], p['rg_ba'][j],
                         p['rg_wx'][j], p['rg_bx'][j], p['rg_lambda'][j], p['mla_q_norm'][j], p['mla_w_uq'][j],
                         p['mla_kv_norm'][j], p['mla_w_ukv'][j], p['mla_qn_q'][j], p['mla_qn_k'][j], p['ab_w_out'][j])
        else:
            j = i // 2
            m = mixer_c(h, p['c_w_in'][j], p['c_conv_w'][j], p['c_w_out'][j])
        x = x + g1 * m
        h = rms_norm(x, p['norm2_g'][i]) * (1.0 + sc2) + sh2
        x = x + g2 * peer(h, p['peer_wq'][i], p['peer_k1'][i], p['peer_k2'][i], p['peer_u'][i], p['peer_v'][i])
    return x


def setup_inputs(seed: int = 0) -> dict:
    key = jax.random.key(seed)
    keys = iter(jax.random.split(key, 64))
    f32 = jnp.float32

    def nrm(shape, scale):
        return jax.random.normal(next(keys), shape, f32) * scale

    def gain(shape):
        return 1.0 + nrm(shape, 0.05)

    u_lam = jax.random.uniform(next(keys), (N_EVEN, 2, D_RNN), f32, 0.9, 0.999)
    a0 = u_lam ** (1.0 / RG_C)
    rg_lambda = jnp.log(a0) - jnp.log1p(-a0)
    return {
        'x_prompt': nrm((BATCH, SEQ, D_MODEL), 1.0),
        'x_sample': nrm((DEC_BATCH, DEC_SEQ, D_MODEL), 1.0),
        'c_prompt': nrm((BATCH, D_MODEL), 1.0),
        'c_sample': nrm((DEC_BATCH, D_MODEL), 1.0),
        'ada_w': nrm((DEPTH, D_MODEL, 6 * D_MODEL), 0.02),
        'ada_b': nrm((DEPTH, 6 * D_MODEL), 0.01),
        'norm1_g': gain((DEPTH, D_MODEL)),
        'norm2_g': gain((DEPTH, D_MODEL)),
        'ab_w_in': nrm((N_EVEN, D_MODEL, AB_IN), D_MODEL ** -0.5),
        'rg_conv_w': nrm((N_EVEN, RG_CONV, D_RNN), RG_CONV ** -0.5),
        'rg_conv_b': nrm((N_EVEN, D_RNN), 0.01),
        'rg_wa': nrm((N_EVEN, 2, RG_HEADS, RG_HEAD_DIM, RG_HEAD_DIM), RG_HEAD_DIM ** -0.5),
        'rg_ba': nrm((N_EVEN, 2, D_RNN), 0.01),
        'rg_wx': nrm((N_EVEN, 2, RG_HEADS, RG_HEAD_DIM, RG_HEAD_DIM), RG_HEAD_DIM ** -0.5),
        'rg_bx': nrm((N_EVEN, 2, D_RNN), 0.01),
        'rg_lambda': rg_lambda,
        'mla_q_norm': gain((N_EVEN, Q_LORA)),
        'mla_w_uq': nrm((N_EVEN, Q_LORA, MLA_HEADS * QK_DIM), Q_LORA ** -0.5),
        'mla_kv_norm': gain((N_EVEN, KV_LORA)),
        'mla_w_ukv': nrm((N_EVEN, KV_LORA, MLA_HEADS * (QK_NOPE + V_DIM)), KV_LORA ** -0.5),
        'mla_qn_q': gain((N_EVEN, QK_DIM)),
        'mla_qn_k': gain((N_EVEN, QK_DIM)),
        'ab_w_out': nrm((N_EVEN, AB_OUT, D_MODEL), AB_OUT ** -0.5),
        'c_w_in': nrm((N_ODD, D_MODEL, 3 * D_CONV), D_MODEL ** -0.5),
        'c_conv_w': nrm((N_ODD, C_CONV, D_CONV), C_CONV ** -0.5),
        'c_w_out': nrm((N_ODD, D_CONV, D_MODEL), D_CONV ** -0.5),
        'peer_wq': nrm((DEPTH, D_MODEL, PEER_HEADS * D_KEY), D_MODEL ** -0.5),
        'peer_k1': nrm((DEPTH, N_KEYS, D_KEY // 2), (D_KEY // 2) ** -0.5),
        'peer_k2': nrm((DEPTH, N_KEYS, D_KEY // 2), (D_KEY // 2) ** -0.5),
        'peer_u': nrm((DEPTH, N_EXPERTS, D_MODEL), D_MODEL ** -0.5),
        'peer_v': nrm((DEPTH, N_EXPERTS, D_MODEL), PEER_HEADS ** -0.5),
    }


def reference(x_prompt, x_sample, c_prompt, c_sample, ada_w, ada_b, norm1_g, norm2_g, ab_w_in, rg_conv_w, rg_conv_b,
              rg_wa, rg_ba, rg_wx, rg_bx, rg_lambda, mla_q_norm, mla_w_uq, mla_kv_norm, mla_w_ukv, mla_qn_q, mla_qn_k,
              ab_w_out, c_w_in, c_conv_w, c_w_out, peer_wq, peer_k1, peer_k2, peer_u, peer_v):
    p = dict(ada_w=ada_w, ada_b=ada_b, norm1_g=norm1_g, norm2_g=norm2_g, ab_w_in=ab_w_in, rg_conv_w=rg_conv_w,
             rg_conv_b=rg_conv_b, rg_wa=rg_wa, rg_ba=rg_ba, rg_wx=rg_wx, rg_bx=rg_bx, rg_lambda=rg_lambda,
             mla_q_norm=mla_q_norm, mla_w_uq=mla_w_uq, mla_kv_norm=mla_kv_norm, mla_w_ukv=mla_w_ukv,
             mla_qn_q=mla_qn_q, mla_qn_k=mla_qn_k, ab_w_out=ab_w_out, c_w_in=c_w_in, c_conv_w=c_conv_w,
             c_w_out=c_w_out, peer_wq=peer_wq, peer_k1=peer_k1, peer_k2=peer_k2, peer_u=peer_u, peer_v=peer_v)
    y_prompt = trunk(x_prompt, c_prompt, p)
    y_sample = trunk(x_sample, c_sample, p)
    return (y_prompt, y_sample)
```

```cpp
#include <hip/hip_runtime.h>
#include <hip/hip_cooperative_groups.h>
#include <cstdio>
#include <cstdint>
namespace cg = cooperative_groups;

typedef unsigned short bf16_t;
using bf16x8 = __attribute__((ext_vector_type(8))) short;
using bf16x4 = __attribute__((ext_vector_type(4))) short;
using f32x16 = __attribute__((ext_vector_type(16))) float;

#define T_TOK 65536
#define EPSN 1e-6f

struct Params {
  const float* in[31];
  float* out;
  unsigned char* ws;
};

constexpr size_t MBY = (size_t)1 << 20;
constexpr size_t OFF_WIN = 0;
constexpr size_t OFF_WUQ = OFF_WIN + (size_t)1536 * 1024 * 2;
constexpr size_t OFF_WUKV = OFF_WUQ + (size_t)768 * 256 * 2;
constexpr size_t OFF_WGATE = OFF_WUKV + (size_t)1024 * 128 * 2;
constexpr size_t OFF_WOUT = OFF_WGATE + (size_t)16 * 128 * 64 * 2;
constexpr size_t OFF_WCIN = OFF_WOUT + (size_t)1024 * 1024 * 2;
constexpr size_t OFF_WCOUT = OFF_WCIN + (size_t)3072 * 1024 * 2;
constexpr size_t OFF_WPQ = OFF_WCOUT + (size_t)1024 * 1024 * 2;
constexpr size_t OFF_KEYS = OFF_WPQ + (size_t)2 * 2048 * 1024 * 2;
constexpr size_t OFF_MOD = OFF_KEYS + (size_t)4 * 128 * 128 * 2;
constexpr size_t OFF_C8 = OFF_MOD + (size_t)2 * 10 * 6144 * 4;
constexpr size_t OFF_RSTDQ = OFF_C8 + 4096;
constexpr size_t OFF_RSTDKV = OFF_RSTDQ + (size_t)T_TOK * 4;
constexpr size_t OFF_AGGA = OFF_RSTDKV + (size_t)T_TOK * 4;
constexpr size_t OFF_AGGB = OFF_AGGA + 2 * MBY;
constexpr size_t OFF_CARRY = OFF_AGGB + 2 * MBY;
constexpr size_t OFF_CNT = OFF_CARRY + 2 * MBY;
static_assert(OFF_CNT + 4096 < 40 * MBY, "small region overflow");
constexpr size_t OFF_H = 40 * MBY;
constexpr size_t OFF_R1 = 168 * MBY;
constexpr size_t OFF_Z2 = OFF_R1 + 128 * MBY;
constexpr size_t OFF_XC = OFF_R1 + 180 * MBY;
constexpr size_t OFF_B = 424 * MBY;
constexpr size_t OFF_VT = OFF_B + 96 * MBY;
constexpr size_t OFF_UT = OFF_B;
constexpr size_t OFF_VTAB = OFF_B + 32 * MBY;
constexpr size_t OFF_IDX = OFF_B + 64 * MBY;
constexpr size_t OFF_GW = OFF_B + 96 * MBY;
constexpr size_t WS_NEED = 584 * MBY;

#define LDS_BYTES 73728

__device__ __forceinline__ float bf2f(unsigned short h) { return __uint_as_float(((unsigned)h) << 16); }
__device__ __forceinline__ unsigned short f2bf(float f) {
  unsigned u = __float_as_uint(f);
  u += 0x7fffu + ((u >> 16) & 1u);
  return (unsigned short)(u >> 16);
}
__device__ __forceinline__ unsigned pack2(float a, float b) { return (unsigned)f2bf(a) | ((unsigned)f2bf(b) << 16); }
__device__ __forceinline__ float lo2f(unsigned u) { return __uint_as_float(u << 16); }
__device__ __forceinline__ float hi2f(unsigned u) { return __uint_as_float(u & 0xffff0000u); }
__device__ __forceinline__ float gelu_t(float x) {
  float u = 0.7978845608f * (x + 0.044715f * x * x * x);
  float t = 1.f - 2.f / (1.f + __expf(2.f * u));
  return 0.5f * x * (1.f + t);
}
__device__ __forceinline__ float sigmoid_f(float x) { return 1.f / (1.f + __expf(-x)); }
__device__ __forceinline__ float wave_sum(float v) {
#pragma unroll
  for (int o = 32; o > 0; o >>= 1) v += __shfl_xor(v, o);
  return v;
}
struct SeqInfo { int b, s0, S; };
__device__ __forceinline__ SeqInfo seq_of(int t) {
  SeqInfo r;
  if (t < 32768) { r.b = t >> 14; r.s0 = r.b << 14; r.S = 16384; }
  else { int u = (t - 32768) >> 12; r.b = 2 + u; r.s0 = 32768 + (u << 12); r.S = 4096; }
  return r;
}
__device__ __forceinline__ const float* xin_row(const Params& p, int t) {
  return t < 32768 ? p.in[0] + (size_t)t * 1024 : p.in[1] + (size_t)(t - 32768) * 1024;
}

__device__ __forceinline__ void gemm_tile(const bf16_t* __restrict__ A, int lda, const bf16_t* __restrict__ B, int ldb,
                                          int K, f32x16 (&acc)[2][2], bf16_t* sm) {
  const int tid = threadIdx.x, lane = tid & 63, wave = tid >> 6, wm = wave >> 1, wn = wave & 1;
  const int lr = tid >> 3, lc = (tid & 7) * 8;
  uint4 ra[4], rb[4];
  const bf16_t* Ap = A + (size_t)lr * lda + lc;
  const bf16_t* Bp = B + (size_t)lr * ldb + lc;
#pragma unroll
  for (int i = 0; i < 4; i++) {
    ra[i] = *(const uint4*)(Ap + (size_t)(i * 32) * lda);
    rb[i] = *(const uint4*)(Bp + (size_t)(i * 32) * ldb);
  }
#pragma unroll
  for (int mi = 0; mi < 2; mi++)
#pragma unroll
    for (int ni = 0; ni < 2; ni++)
#pragma unroll
      for (int r = 0; r < 16; r++) acc[mi][ni][r] = 0.f;
  {
    bf16_t* sA = sm; bf16_t* sB = sm + 128 * 72;
#pragma unroll
    for (int i = 0; i < 4; i++) {
      *(uint4*)(sA + (lr + i * 32) * 72 + lc) = ra[i];
      *(uint4*)(sB + (lr + i * 32) * 72 + lc) = rb[i];
    }
  }
  __syncthreads();
  const int nk = K >> 6;
  for (int kt = 0; kt < nk; ++kt) {
    const bf16_t* cA = sm + (kt & 1) * (2 * 128 * 72);
    const bf16_t* cB = cA + 128 * 72;
    if (kt + 1 < nk) {
#pragma unroll
      for (int i = 0; i < 4; i++) {
        ra[i] = *(const uint4*)(Ap + (size_t)(i * 32) * lda + (kt + 1) * 64);
        rb[i] = *(const uint4*)(Bp + (size_t)(i * 32) * ldb + (kt + 1) * 64);
      }
    }
#pragma unroll
    for (int kk = 0; kk < 4; ++kk) {
      bf16x8 a[2], b[2];
#pragma unroll
      for (int mi = 0; mi < 2; mi++)
        a[mi] = *(const bf16x8*)(cA + (wm * 64 + mi * 32 + (lane & 31)) * 72 + kk * 16 + (lane >> 5) * 8);
#pragma unroll
      for (int ni = 0; ni < 2; ni++)
        b[ni] = *(const bf16x8*)(cB + (wn * 64 + ni * 32 + (lane & 31)) * 72 + kk * 16 + (lane >> 5) * 8);
#pragma unroll
      for (int mi = 0; mi < 2; mi++)
#pragma unroll
        for (int ni = 0; ni < 2; ni++)
          acc[mi][ni] = __builtin_amdgcn_mfma_f32_32x32x16_bf16(a[mi], b[ni], acc[mi][ni], 0, 0, 0);
    }
    if (kt + 1 < nk) {
      bf16_t* nA = sm + ((kt + 1) & 1) * (2 * 128 * 72);
      bf16_t* nB = nA + 128 * 72;
#pragma unroll
      for (int i = 0; i < 4; i++) {
        *(uint4*)(nA + (lr + i * 32) * 72 + lc) = ra[i];
        *(uint4*)(nB + (lr + i * 32) * 72 + lc) = rb[i];
      }
    }
    __syncthreads();
  }
}

#define EPI_ROW(wm, mi, r, lane) ((wm) * 64 + (mi) * 32 + 8 * ((r) >> 2) + 4 * ((lane) >> 5) + ((r) & 3))
#define EPI_COL(wn, ni, lane) ((wn) * 64 + (ni) * 32 + ((lane) & 31))

template <class F>
__device__ __forceinline__ void tconv(bf16_t* dst, int N, int K, F src, float* tile) {
  const int tn = N >> 6, tk = K >> 6;
  for (int it = blockIdx.x; it < tn * tk; it += gridDim.x) {
    const int n0 = (it % tn) << 6, k0 = (it / tn) << 6;
    for (int i = threadIdx.x; i < 4096; i += 256) { int kk = i >> 6, nn = i & 63; tile[kk * 65 + nn] = src(k0 + kk, n0 + nn); }
    __syncthreads();
    for (int i = threadIdx.x; i < 4096; i += 256) { int nn = i >> 6, kk = i & 63; dst[(size_t)(n0 + nn) * K + k0 + kk] = f2bf(tile[kk * 65 + nn]); }
    __syncthreads();
  }
}

__device__ __forceinline__ void phase_prep(const Params& p, unsigned char* smem) {
  unsigned char* ws = p.ws;
  float* tile = (float*)smem;
  const int tid = threadIdx.x;
  const int gtid = blockIdx.x * 256 + tid, gsz = gridDim.x * 256;
  {
    const float* w_in = p.in[8];
    tconv((bf16_t*)(ws + OFF_WIN), 1536, 1024, [=](int k, int n) { return n < 1440 ? w_in[(size_t)k * 1440 + n] : 0.f; }, tile);
    const float* w_uq = p.in[17]; const float* qn = p.in[16];
    tconv((bf16_t*)(ws + OFF_WUQ), 768, 256, [=](int k, int n) { return w_uq[k * 768 + n] * qn[k]; }, tile);
    const float* w_ukv = p.in[19]; const float* kvn = p.in[18];
    tconv((bf16_t*)(ws + OFF_WUKV), 1024, 128, [=](int k, int n) { return w_ukv[k * 1024 + n] * kvn[k]; }, tile);
    const float* wa = p.in[11]; const float* wx = p.in[13];
    for (int hd = 0; hd < 16; ++hd) {
      const int h = hd >> 1, d = hd & 1;
      tconv((bf16_t*)(ws + OFF_WGATE) + hd * 128 * 64, 128, 64, [=](int k, int n) {
        int wn = n >> 6, ty = (n >> 5) & 1, j = n & 31; int c = wn * 32 + j;
        const float* W = ty ? wx : wa;
        return W[((d * 8 + h) * 64 + k) * 64 + c]; }, tile);
    }
    const float* w_out = p.in[22];
    tconv((bf16_t*)(ws + OFF_WOUT), 1024, 1024, [=](int k, int n) { return w_out[((k + 512) & 1023) * 1024 + n]; }, tile);
    const float* c_w_in = p.in[23];
    tconv((bf16_t*)(ws + OFF_WCIN), 3072, 1024, [=](int k, int n) {
      int col;
      if (n < 1024) col = n;
      else { int q = n - 1024; int tl = q >> 7, wi = q & 127; int wn = wi >> 6, ty = (wi >> 5) & 1, j = wi & 31; col = 1024 + ty * 1024 + tl * 64 + wn * 32 + j; }
      return c_w_in[(size_t)k * 3072 + col]; }, tile);
    const float* c_w_out = p.in[25];
    tconv((bf16_t*)(ws + OFF_WCOUT), 1024, 1024, [=](int k, int n) { return c_w_out[k * 1024 + n]; }, tile);
    const float* wq = p.in[26];
    for (int l = 0; l < 2; ++l)
      tconv((bf16_t*)(ws + OFF_WPQ) + (size_t)l * 2048 * 1024, 2048, 1024, [=](int k, int n) { return wq[((size_t)(l * 1024 + k)) * 2048 + n]; }, tile);
  }
  {
    bf16_t* keys = (bf16_t*)(ws + OFF_KEYS);
    const float* k1 = p.in[27]; const float* k2 = p.in[28];
    for (int i = gtid; i < 65536; i += gsz) {
      int l = i >> 15, pp = (i >> 14) & 1, r = i & 16383;
      keys[i] = f2bf((pp ? k2 : k1)[l * 16384 + r]);
    }
    float* c8 = (float*)(ws + OFF_C8);
    const float* lam = p.in[15];
    for (int i = gtid; i < 1024; i += gsz) c8[i] = 8.f * log1pf(__expf(-lam[i])) * 1.44269504f;
    if (gtid < 16) ((int*)(ws + OFF_CNT))[gtid] = 0;
  }
  {
    float* silu_s = (float*)smem;
    float* red = silu_s + 10240;
    float* mod = (float*)(ws + OFF_MOD);
    const float* cp = p.in[2]; const float* cs = p.in[3];
    const float* ada_w = p.in[4]; const float* ada_b = p.in[5];
    __syncthreads();
    for (int i = tid; i < 10240; i += 256) {
      int b = i >> 10, k = i & 1023;
      float c = b < 2 ? cp[b * 1024 + k] : cs[(b - 2) * 1024 + k];
      silu_s[i] = c / (1.f + __expf(-c));
    }
    __syncthreads();
    for (int it = blockIdx.x; it < 192; it += gridDim.x) {
      const int l = it / 96, n = (it % 96) * 64 + (tid & 63), kq = tid >> 6;
      float acc[10];
#pragma unroll
      for (int b = 0; b < 10; b++) acc[b] = 0.f;
      for (int k = kq * 256; k < kq * 256 + 256; ++k) {
        float w = ada_w[((size_t)(l * 1024 + k)) * 6144 + n];
#pragma unroll
        for (int b = 0; b < 10; b++) acc[b] += silu_s[b * 1024 + k] * w;
      }
#pragma unroll
      for (int b = 0; b < 10; b++) red[(kq * 10 + b) * 64 + (tid & 63)] = acc[b];
      __syncthreads();
      if (tid < 64) {
#pragma unroll
        for (int b = 0; b < 10; b++)
          mod[(l * 10 + b) * 6144 + n] = ada_b[l * 6144 + n] + red[(0 * 10 + b) * 64 + tid] + red[(1 * 10 + b) * 64 + tid] +
                                         red[(2 * 10 + b) * 64 + tid] + red[(3 * 10 + b) * 64 + tid];
      }
      __syncthreads();
    }
  }
}

__device__ __forceinline__ void phase_uvconv(const Params& p, int l) {
  const int gtid = blockIdx.x * 256 + threadIdx.x, gsz = gridDim.x * 256;
  const float4* us = (const float4*)(p.in[29] + (size_t)l * 16384 * 1024);
  const float4* vs = (const float4*)(p.in[30] + (size_t)l * 16384 * 1024);
  uint2* ud = (uint2*)(p.ws + OFF_UT);
  uint2* vd = (uint2*)(p.ws + OFF_VTAB);
  for (int i = gtid; i < 16384 * 256; i += gsz) {
    float4 a = us[i]; float4 b = vs[i];
    ud[i] = make_uint2(pack2(a.x, a.y), pack2(a.z, a.w));
    vd[i] = make_uint2(pack2(b.x, b.y), pack2(b.z, b.w));
  }
}

__device__ __forceinline__ void phase_norm(const Params& p, int layer, int which, bool from_input) {
  const int lane = threadIdx.x & 63;
  const int gw = (blockIdx.x * 256 + threadIdx.x) >> 6, nw = gridDim.x * 4;
  const float* g = (which == 1 ? p.in[6] : p.in[7]) + layer * 1024;
  const float* mod = (const float*)(p.ws + OFF_MOD);
  bf16_t* H = (bf16_t*)(p.ws + OFF_H);
  for (int t = gw; t < T_TOK; t += nw) {
    SeqInfo si = seq_of(t);
    const float* x = from_input ? xin_row(p, t) : p.out + (size_t)t * 1024;
    const float* md = mod + (layer * 10 + si.b) * 6144 + (which == 1 ? 0 : 3 * 1024);
    float4 v[4];
    float ss = 0.f;
#pragma unroll
    for (int j = 0; j < 4; j++) {
      v[j] = *(const float4*)(x + j * 256 + lane * 4);
      ss += v[j].x * v[j].x + v[j].y * v[j].y + v[j].z * v[j].z + v[j].w * v[j].w;
    }
    ss = wave_sum(ss);
    const float rstd = rsqrtf(ss * (1.f / 1024.f) + EPSN);
#pragma unroll
    for (int j = 0; j < 4; j++) {
      const int idx = j * 256 + lane * 4;
      float4 gg = *(const float4*)(g + idx);
      float4 sh = *(const float4*)(md + idx);
      float4 sc = *(const float4*)(md + 1024 + idx);
      float y0 = v[j].x * rstd * gg.x * (1.f + sc.x) + sh.x;
      float y1 = v[j].y * rstd * gg.y * (1.f + sc.y) + sh.y;
      float y2 = v[j].z * rstd * gg.z * (1.f + sc.z) + sh.z;
      float y3 = v[j].w * rstd * gg.w * (1.f + sc.w) + sh.w;
      *(uint2*)(H + (size_t)t * 1024 + idx) = make_uint2(pack2(y0, y1), pack2(y2, y3));
    }
  }
}

__device__ __forceinline__ void phase_g1(const Params& p, bf16_t* sm) {
  const int lane = threadIdx.x & 63, wave = threadIdx.x >> 6, wm = wave >> 1, wn = wave & 1;
  const bf16_t* H = (const bf16_t*)(p.ws + OFF_H);
  const bf16_t* W = (const bf16_t*)(p.ws + OFF_WIN);
  bf16_t* Z1 = (bf16_t*)(p.ws + OFF_R1);
  bf16_t* Z2 = (bf16_t*)(p.ws + OFF_Z2);
  for (int it = blockIdx.x; it < 512 * 12; it += gridDim.x) {
    const int mt = it / 12, nt = it % 12;
    f32x16 acc[2][2];
    gemm_tile(H + (size_t)mt * 128 * 1024, 1024, W + (size_t)nt * 128 * 1024, 1024, 1024, acc, sm);
#pragma unroll
    for (int mi = 0; mi < 2; mi++)
#pragma unroll
      for (int ni = 0; ni < 2; ni++) {
        const int col = nt * 128 + EPI_COL(wn, ni, lane);
#pragma unroll
        for (int r = 0; r < 16; r++) {
          const int row = mt * 128 + EPI_ROW(wm, mi, r, lane);
          const unsigned short v = f2bf(acc[mi][ni][r]);
          if (col < 1024) Z1[(size_t)row * 1024 + col] = v;
          else if (col < 1440) Z2[(size_t)row * 416 + (col - 1024)] = v;
        }
      }
  }
}

__device__ __forceinline__ void phase_conv0(const Params& p) {
  const int gtid = blockIdx.x * 256 + threadIdx.x, gsz = gridDim.x * 256;
  const bf16_t* Z1 = (const bf16_t*)(p.ws + OFF_R1);
  const bf16_t* Z2 = (const bf16_t*)(p.ws + OFF_Z2);
  bf16_t* XC = (bf16_t*)(p.ws + OFF_XC);
  const float* cw = p.in[9]; const float* cb = p.in[10];
  for (int i = gtid; i < T_TOK * 64; i += gsz) {
    const int t = i >> 6, c = (i & 63) * 8;
    SeqInfo si = seq_of(t);
    float acc[8];
#pragma unroll
    for (int j = 0; j < 8; j++) acc[j] = cb[c + j];
#pragma unroll
    for (int k = 0; k < 4; k++) {
      const int tt = t + k - 2;
      if (tt >= si.s0 && tt < si.s0 + si.S) {
        uint4 v = *(const uint4*)(Z1 + (size_t)tt * 1024 + c);
        const float* w = cw + k * 512 + c;
        acc[0] += w[0] * lo2f(v.x); acc[1] += w[1] * hi2f(v.x);
        acc[2] += w[2] * lo2f(v.y); acc[3] += w[3] * hi2f(v.y);
        acc[4] += w[4] * lo2f(v.z); acc[5] += w[5] * hi2f(v.z);
        acc[6] += w[6] * lo2f(v.w); acc[7] += w[7] * hi2f(v.w);
      }
    }
    *(uint4*)(XC + (size_t)t * 512 + c) = make_uint4(pack2(acc[0], acc[1]), pack2(acc[2], acc[3]), pack2(acc[4], acc[5]), pack2(acc[6], acc[7]));
  }
  const int lane = threadIdx.x & 63;
  const int gw = gtid >> 6, nw = gsz >> 6;
  float* rq = (float*)(p.ws + OFF_RSTDQ);
  float* rkv = (float*)(p.ws + OFF_RSTDKV);
  for (int t = gw; t < T_TOK; t += nw) {
    const bf16_t* z = Z2 + (size_t)t * 416;
    uint2 a = *(const uint2*)(z + lane * 4);
    unsigned b = *(const unsigned*)(z + 256 + lane * 2);
    float ssq = lo2f(a.x) * lo2f(a.x) + hi2f(a.x) * hi2f(a.x) + lo2f(a.y) * lo2f(a.y) + hi2f(a.y) * hi2f(a.y);
    float ssk = lo2f(b) * lo2f(b) + hi2f(b) * hi2f(b);
    ssq = wave_sum(ssq); ssk = wave_sum(ssk);
    if (lane == 0) { rq[t] = rsqrtf(ssq * (1.f / 256.f) + EPSN); rkv[t] = rsqrtf(ssk * (1.f / 128.f) + EPSN); }
  }
}

__device__ __forceinline__ void phase_g234(const Params& p, bf16_t* sm) {
  const int lane = threadIdx.x & 63, wave = threadIdx.x >> 6, wm = wave >> 1, wn = wave & 1;
  const bf16_t* Z2 = (const bf16_t*)(p.ws + OFF_Z2);
  const bf16_t* XC = (const bf16_t*)(p.ws + OFF_XC);
  bf16_t* QR = (bf16_t*)(p.ws + OFF_H);
  bf16_t* Kb = (bf16_t*)(p.ws + OFF_B);
  bf16_t* Vt = (bf16_t*)(p.ws + OFF_VT);
  unsigned* AB = (unsigned*)p.out;
  const float* rq = (const float*)(p.ws + OFF_RSTDQ);
  const float* rkv = (const float*)(p.ws + OFF_RSTDKV);
  const float* c8 = (const float*)(p.ws + OFF_C8);
  for (int it = blockIdx.x; it < 15360; it += gridDim.x) {
    f32x16 acc[2][2];
    if (it < 3072) {
      const int mt = it / 6, nt = it % 6;
      gemm_tile(Z2 + (size_t)mt * 128 * 416, 416, (const bf16_t*)(p.ws + OFF_WUQ) + nt * 128 * 256, 256, 256, acc, sm);
#pragma unroll
      for (int mi = 0; mi < 2; mi++)
#pragma unroll
        for (int r = 0; r < 16; r++) {
          const int row = mt * 128 + EPI_ROW(wm, mi, r, lane);
          const float rs = rq[row];
#pragma unroll
          for (int ni = 0; ni < 2; ni++) {
            const int col = nt * 128 + EPI_COL(wn, ni, lane);
            QR[(size_t)row * 768 + col] = f2bf(acc[mi][ni][r] * rs);
          }
        }
    } else if (it < 7168) {
      const int j = it - 3072;
      const int mt = j >> 3, h = j & 7;
      gemm_tile(Z2 + (size_t)mt * 128 * 416 + 256, 416, (const bf16_t*)(p.ws + OFF_WUKV) + h * 128 * 128, 128, 128, acc, sm);
      SeqInfo si = seq_of(mt * 128);
      if (wn == 0) {
#pragma unroll
        for (int mi = 0; mi < 2; mi++)
#pragma unroll
          for (int r = 0; r < 16; r++) {
            const int row = mt * 128 + EPI_ROW(wm, mi, r, lane);
            const float rs = rkv[row];
            const size_t krow = (size_t)si.s0 * 8 + (size_t)h * si.S + (row - si.s0);
#pragma unroll
            for (int ni = 0; ni < 2; ni++)
              Kb[krow * 96 + ni * 32 + (lane & 31)] = f2bf(acc[mi][ni][r] * rs);
          }
      } else {
        bf16_t* vb = Vt + ((size_t)si.s0 * 8 + (size_t)h * si.S) * 64;
#pragma unroll
        for (int mi = 0; mi < 2; mi++)
#pragma unroll
          for (int rg = 0; rg < 4; rg++) {
            const int t4 = mt * 128 + wm * 64 + mi * 32 + 8 * rg + 4 * (lane >> 5);
            const float r0 = rkv[t4], r1 = rkv[t4 + 1], r2 = rkv[t4 + 2], r3 = rkv[t4 + 3];
#pragma unroll
            for (int ni = 0; ni < 2; ni++) {
              const int dv = ni * 32 + (lane & 31);
              uint2 pk = make_uint2(pack2(acc[mi][ni][rg * 4 + 0] * r0, acc[mi][ni][rg * 4 + 1] * r1),
                                    pack2(acc[mi][ni][rg * 4 + 2] * r2, acc[mi][ni][rg * 4 + 3] * r3));
              *(uint2*)(vb + (size_t)dv * si.S + (t4 - si.s0)) = pk;
            }
          }
      }
    } else {
      const int j = it - 7168;
      const int mt = j >> 4, hd = j & 15, h = hd >> 1, d = hd & 1;
      gemm_tile(XC + (size_t)mt * 128 * 512 + h * 64, 512, (const bf16_t*)(p.ws + OFF_WGATE) + hd * 128 * 64, 64, 64, acc, sm);
      const int c = h * 64 + wn * 32 + (lane & 31);
      const float ba = p.in[12][d * 512 + c], bx = p.in[14][d * 512 + c], cc8 = c8[d * 512 + c];
#pragma unroll
      for (int mi = 0; mi < 2; mi++)
#pragma unroll
        for (int r = 0; r < 16; r++) {
          const int row = mt * 128 + EPI_ROW(wm, mi, r, lane);
          const float rg = sigmoid_f(acc[mi][0][r] + ba);
          const float ig = sigmoid_f(acc[mi][1][r] + bx);
          const float l2a = -rg * cc8;
          const float a2 = exp2f(2.f * l2a);
          const float xv = bf2f(XC[(size_t)row * 512 + c]);
          const float bb = sqrtf(fmaxf(1.f - a2, 0.f)) * ig * xv;
          AB[((size_t)d * T_TOK + row) * 512 + c] = pack2(l2a, bb);
        }
    }
  }
}

__device__ __forceinline__ void unpack8(uint4 v, float* f) {
  f[0] = lo2f(v.x); f[1] = hi2f(v.x); f[2] = lo2f(v.y); f[3] = hi2f(v.y);
  f[4] = lo2f(v.z); f[5] = hi2f(v.z); f[6] = lo2f(v.w); f[7] = hi2f(v.w);
}
__device__ __forceinline__ uint4 pack8(const float* f) {
  return make_uint4(pack2(f[0], f[1]), pack2(f[2], f[3]), pack2(f[4], f[5]), pack2(f[6], f[7]));
}
__device__ __forceinline__ float sumsq8(uint4 v) {
  float a0 = lo2f(v.x), a1 = hi2f(v.x), a2 = lo2f(v.y), a3 = hi2f(v.y), a4 = lo2f(v.z), a5 = hi2f(v.z), a6 = lo2f(v.w), a7 = hi2f(v.w);
  return a0 * a0 + a1 * a1 + a2 * a2 + a3 * a3 + a4 * a4 + a5 * a5 + a6 * a6 + a7 * a7;
}
__device__ __forceinline__ void norm_rope96(uint4 (&v)[12], const float* __restrict__ gain, float outscale, const float (&cs)[16], const float (&sn)[16]) {
  float ss = 0.f;
#pragma unroll
  for (int i = 0; i < 12; i++) ss += sumsq8(v[i]);
  const float rstd = rsqrtf(ss * (1.f / 96.f) + EPSN);
#pragma unroll
  for (int i = 0; i < 8; i++) {
    float f[8]; unpack8(v[i], f);
#pragma unroll
    for (int j = 0; j < 8; j++) f[j] = f[j] * rstd * gain[i * 8 + j] * outscale;
    v[i] = pack8(f);
  }
#pragma unroll
  for (int q = 0; q < 2; q++) {
    float f1[8], f2[8]; unpack8(v[8 + q], f1); unpack8(v[10 + q], f2);
#pragma unroll
    for (int j = 0; j < 8; j++) {
      const float r1 = f1[j] * rstd * gain[64 + q * 8 + j];
      const float r2 = f2[j] * rstd * gain[80 + q * 8 + j];
      const float c = cs[q * 8 + j], s = sn[q * 8 + j];
      f1[j] = (r1 * c - r2 * s) * outscale;
      f2[j] = (r2 * c + r1 * s) * outscale;
    }
    v[8 + q] = pack8(f1); v[10 + q] = pack8(f2);
  }
}

#define QSCALE (0.10206207261596575f * 1.4426950408889634f)

__device__ __forceinline__ void phase_qkprep_scan1(const Params& p) {
  const int tid = threadIdx.x;
  bf16_t* QR = (bf16_t*)(p.ws + OFF_H);
  bf16_t* Kb = (bf16_t*)(p.ws + OFF_B);
  const bf16_t* Z2 = (const bf16_t*)(p.ws + OFF_Z2);
  const unsigned* AB = (const unsigned*)p.out;
  float* aggA = (float*)(p.ws + OFF_AGGA);
  float* aggB = (float*)(p.ws + OFF_AGGB);
  for (int it = blockIdx.x; it < 4096; it += gridDim.x) {
    if (it < 2048) {
      const int i = it * 256 + tid;
      const int t = i >> 3, h = i & 7;
      SeqInfo si = seq_of(t);
      const float pos = (float)(t - si.s0);
      float cs[16], sn[16];
#pragma unroll
      for (int k = 0; k < 16; k++) {
        const float inv = exp2f(-(float)k * (13.287712379549449f / 16.f));
        float rev = pos * inv * 0.15915494309189535f;
        rev = rev - floorf(rev);
        cs[k] = __builtin_amdgcn_cosf(rev);
        sn[k] = __builtin_amdgcn_sinf(rev);
      }
      uint4 v[12];
      bf16_t* qp = QR + (size_t)t * 768 + h * 96;
#pragma unroll
      for (int k = 0; k < 12; k++) v[k] = *(const uint4*)(qp + k * 8);
      norm_rope96(v, p.in[20], QSCALE, cs, sn);
#pragma unroll
      for (int k = 0; k < 12; k++) *(uint4*)(qp + k * 8) = v[k];
      bf16_t* kp = Kb + ((size_t)si.s0 * 8 + (size_t)h * si.S + (t - si.s0)) * 96;
#pragma unroll
      for (int k = 0; k < 8; k++) v[k] = *(const uint4*)(kp + k * 8);
#pragma unroll
      for (int k = 0; k < 4; k++) v[8 + k] = *(const uint4*)(Z2 + (size_t)t * 416 + 384 + k * 8);
      norm_rope96(v, p.in[21], 1.f, cs, sn);
#pragma unroll
      for (int k = 0; k < 12; k++) *(uint4*)(kp + k * 8) = v[k];
    } else {
      const int i = (it - 2048) * 256 + tid;
      const int c = i & 511, ch = (i >> 9) & 511, d = i >> 18;
      const unsigned* ab = AB + ((size_t)d * T_TOK + (size_t)ch * 128) * 512 + c;
      float A = 1.f, Bv = 0.f;
      if (d == 0) {
        for (int s = 0; s < 128; s++) { unsigned u = ab[(size_t)s * 512]; float a = exp2f(lo2f(u)); Bv = a * Bv + hi2f(u); A *= a; }
      } else {
        for (int s = 127; s >= 0; s--) { unsigned u = ab[(size_t)s * 512]; float a = exp2f(lo2f(u)); Bv = a * Bv + hi2f(u); A *= a; }
      }
      aggA[i] = A; aggB[i] = Bv;
    }
  }
}

__device__ __forceinline__ void phase_scan2(const Params& p) {
  const int gtid = blockIdx.x * 256 + threadIdx.x, gsz = gridDim.x * 256;
  const float* aggA = (const float*)(p.ws + OFF_AGGA);
  const float* aggB = (const float*)(p.ws + OFF_AGGB);
  float* carry = (float*)(p.ws + OFF_CARRY);
  for (int i = gtid; i < 10240; i += gsz) {
    const int d = i / 5120, rem = i % 5120, seq = rem >> 9, c = rem & 511;
    const int ch0 = seq < 2 ? seq * 128 : 256 + (seq - 2) * 32;
    const int nch = seq < 2 ? 128 : 32;
    float cr = 0.f;
    if (d == 0) {
      for (int j = 0; j < nch; j++) { const int o = ((d * 512) + ch0 + j) * 512 + c; carry[o] = cr; cr = aggA[o] * cr + aggB[o]; }
    } else {
      for (int j = nch - 1; j >= 0; j--) { const int o = ((d * 512) + ch0 + j) * 512 + c; carry[o] = cr; cr = aggA[o] * cr + aggB[o]; }
    }
  }
}

__device__ __forceinline__ void scan3_item(const Params& p, int it) {
  const int i = it * 256 + threadIdx.x;
  const int c = i & 511, ch = i >> 9;
  unsigned* AB = (unsigned*)p.out;
  const float* carry = (const float*)(p.ws + OFF_CARRY);
  bf16_t* Z1 = (bf16_t*)(p.ws + OFF_R1);
  unsigned* abf = AB + ((size_t)ch * 128) * 512 + c;
  unsigned* abb = AB + ((size_t)T_TOK + (size_t)ch * 128) * 512 + c;
  float hst = carry[ch * 512 + c];
  for (int s = 0; s < 128; s++) {
    unsigned u = abf[(size_t)s * 512];
    hst = exp2f(lo2f(u)) * hst + hi2f(u);
    abf[(size_t)s * 512] = __float_as_uint(hst);
  }
  hst = carry[(512 + ch) * 512 + c];
  bf16_t* zp = Z1 + ((size_t)ch * 128) * 1024 + 512 + c;
  for (int s = 127; s >= 0; s--) {
    unsigned u = abb[(size_t)s * 512];
    hst = exp2f(lo2f(u)) * hst + hi2f(u);
    const float tot = hst + __uint_as_float(abf[(size_t)s * 512]);
    const float yr = bf2f(zp[(size_t)s * 1024]);
    zp[(size_t)s * 1024] = f2bf(tot * gelu_t(yr));
  }
}

#define KS_STRIDE 104
#define VS_STRIDE 72
#define ATT_BUF (64 * KS_STRIDE + 64 * VS_STRIDE)
__device__ __forceinline__ void attn_item(const Params& p, int seq, int h, int qt, bf16_t* sm) {
  const int tid = threadIdx.x, lane = tid & 63, w = tid >> 6, hh = lane >> 5, l31 = lane & 31;
  int s0, S;
  if (seq < 2) { s0 = seq << 14; S = 16384; } else { s0 = 32768 + ((seq - 2) << 12); S = 4096; }
  const bf16_t* Q = (const bf16_t*)(p.ws + OFF_H) + ((size_t)(s0 + qt * 128)) * 768 + h * 96;
  const bf16_t* Kp = (const bf16_t*)(p.ws + OFF_B) + ((size_t)s0 * 8 + (size_t)h * S) * 96;
  const bf16_t* Vp = (const bf16_t*)(p.ws + OFF_VT) + ((size_t)s0 * 8 + (size_t)h * S) * 64;
  bf16_t* Z1 = (bf16_t*)(p.ws + OFF_R1);
  bf16x8 qf[6];
#pragma unroll
  for (int kk = 0; kk < 6; kk++) qf[kk] = *(const bf16x8*)(Q + (size_t)(w * 32 + l31) * 768 + kk * 16 + hh * 8);
  f32x16 o[2];
#pragma unroll
  for (int r = 0; r < 16; r++) { o[0][r] = 0.f; o[1][r] = 0.f; }
  float m = -1e30f, l = 0.f;
  const int kr0 = tid / 12, kc0 = (tid % 12) * 8;
  const int kr1 = (tid + 256) / 12, kc1 = ((tid + 256) % 12) * 8;
  const int kr2 = (tid + 512) / 12, kc2 = ((tid + 512) % 12) * 8;
  const int vr0 = tid >> 3, vc0 = (tid & 7) * 8;
  const int vr1 = (tid + 256) >> 3, vc1 = vc0;
  const int ko0 = kr0 * KS_STRIDE + kc0, ko1 = kr1 * KS_STRIDE + kc1, ko2 = kr2 * KS_STRIDE + kc2;
  const int vo0 = 64 * KS_STRIDE + vr0 * VS_STRIDE + vc0, vo1 = 64 * KS_STRIDE + vr1 * VS_STRIDE + vc1;
  const bf16_t* kg0 = Kp + (size_t)kr0 * 96 + kc0;
  const bf16_t* kg1 = Kp + (size_t)kr1 * 96 + kc1;
  const bf16_t* kg2 = Kp + (size_t)kr2 * 96 + kc2;
  const bf16_t* vg0 = Vp + (size_t)vr0 * S + vc0;
  const bf16_t* vg1 = Vp + (size_t)vr1 * S + vc1;
  uint4 rk0 = *(const uint4*)kg0, rk1 = *(const uint4*)kg1, rk2 = *(const uint4*)kg2;
  uint4 rv0 = *(const uint4*)vg0, rv1 = *(const uint4*)vg1;
  __syncthreads();
  *(uint4*)(sm + ko0) = rk0; *(uint4*)(sm + ko1) = rk1; *(uint4*)(sm + ko2) = rk2;
  *(uint4*)(sm + vo0) = rv0; *(uint4*)(sm + vo1) = rv1;
  __syncthreads();
  const int nt = S >> 6;
  for (int kt = 0; kt < nt; ++kt) {
    const bf16_t* Ks = sm + (kt & 1) * ATT_BUF;
    const bf16_t* Vs = Ks + 64 * KS_STRIDE;
    if (kt + 1 < nt) {
      const size_t k0 = (size_t)(kt + 1) * 64;
      rk0 = *(const uint4*)(kg0 + k0 * 96); rk1 = *(const uint4*)(kg1 + k0 * 96); rk2 = *(const uint4*)(kg2 + k0 * 96);
      rv0 = *(const uint4*)(vg0 + k0); rv1 = *(const uint4*)(vg1 + k0);
    }
    f32x16 s[2];
#pragma unroll
    for (int sub = 0; sub < 2; sub++) {
#pragma unroll
      for (int r = 0; r < 16; r++) s[sub][r] = 0.f;
#pragma unroll
      for (int kk = 0; kk < 6; kk++) {
        bf16x8 kf = *(const bf16x8*)(Ks + (sub * 32 + l31) * KS_STRIDE + kk * 16 + hh * 8);
        s[sub] = __builtin_amdgcn_mfma_f32_32x32x16_bf16(kf, qf[kk], s[sub], 0, 0, 0);
      }
    }
    float mx = s[0][0];
#pragma unroll
    for (int r = 0; r < 16; r++) { mx = fmaxf(mx, s[0][r]); mx = fmaxf(mx, s[1][r]); }
    mx = fmaxf(mx, __shfl_xor(mx, 32));
    const float mn = fmaxf(m, mx);
    const float alpha = exp2f(m - mn);
    m = mn;
    float ps = 0.f;
#pragma unroll
    for (int sub = 0; sub < 2; sub++)
#pragma unroll
      for (int r = 0; r < 16; r++) { float pv = exp2f(s[sub][r] - mn); ps += pv; s[sub][r] = pv; }
    l = l * alpha + ps;
#pragma unroll
    for (int r = 0; r < 16; r++) { o[0][r] *= alpha; o[1][r] *= alpha; }
#pragma unroll
    for (int sub = 0; sub < 2; sub++)
#pragma unroll
      for (int st = 0; st < 2; st++) {
        union { bf16x8 v; unsigned u[4]; } pf;
#pragma unroll
        for (int j = 0; j < 4; j++) pf.u[j] = pack2(s[sub][8 * st + 2 * j], s[sub][8 * st + 2 * j + 1]);
#pragma unroll
        for (int dvt = 0; dvt < 2; dvt++) {
          const bf16_t* vp = Vs + (dvt * 32 + l31) * VS_STRIDE + sub * 32 + 16 * st + 4 * hh;
          union { bf16x8 v; uint2 u[2]; } vf;
          vf.u[0] = *(const uint2*)(vp);
          vf.u[1] = *(const uint2*)(vp + 8);
          o[dvt] = __builtin_amdgcn_mfma_f32_32x32x16_bf16(vf.v, pf.v, o[dvt], 0, 0, 0);
        }
      }
    if (kt + 1 < nt) {
      bf16_t* nK = sm + ((kt + 1) & 1) * ATT_BUF;
      *(uint4*)(nK + ko0) = rk0; *(uint4*)(nK + ko1) = rk1; *(uint4*)(nK + ko2) = rk2;
      *(uint4*)(nK + vo0) = rv0; *(uint4*)(nK + vo1) = rv1;
    }
    __syncthreads();
  }
  const float lt = l + __shfl_xor(l, 32);
  const float inv = 1.f / lt;
  const size_t trow = (size_t)(s0 + qt * 128 + w * 32 + l31);
#pragma unroll
  for (int dvt = 0; dvt < 2; dvt++)
#pragma unroll
    for (int rg = 0; rg < 4; rg++) {
      const int dv = dvt * 32 + 8 * rg + 4 * hh;
      uint2 pk = make_uint2(pack2(o[dvt][rg * 4 + 0] * inv, o[dvt][rg * 4 + 1] * inv), pack2(o[dvt][rg * 4 + 2] * inv, o[dvt][rg * 4 + 3] * inv));
      *(uint2*)(Z1 + trow * 1024 + h * 64 + dv) = pk;
    }
}

__device__ __forceinline__ void phase_attn_scan3(const Params& p, bf16_t* sm) {
  __shared__ int s_item;
  int* cnt = (int*)(p.ws + OFF_CNT);
  const int tid = threadIdx.x;
  for (int dq = 0; dq < 8; ++dq) {
    const int q = (blockIdx.x + dq) & 7;
    while (true) {
      __syncthreads();
      if (tid == 0) s_item = atomicAdd(&cnt[q], 1);
      __syncthreads();
      const int it = s_item;
      if (it >= 512) break;
      int seq, h, qt;
      if (it < 256) { const int pair = q + 8 * (it >> 7); seq = pair >> 3; h = pair & 7; qt = it & 127; }
      else { const int j = it - 256; const int pair = q + 8 * (j >> 5); seq = 2 + (pair >> 3); h = pair & 7; qt = j & 31; }
      attn_item(p, seq, h, qt, sm);
    }
  }
  while (true) {
    __syncthreads();
    if (tid == 0) s_item = atomicAdd(&cnt[8], 1);
    __syncthreads();
    const int it = s_item;
    if (it >= 1024) break;
    scan3_item(p, it);
  }
}

__device__ __forceinline__ void phase_gres(const Params& p, const bf16_t* A, const bf16_t* W, int layer, bool res_from_input, bf16_t* sm) {
  const int lane = threadIdx.x & 63, wave = threadIdx.x >> 6, wm = wave >> 1, wn = wave & 1;
  const float* mod = (const float*)(p.ws + OFF_MOD);
  for (int it = blockIdx.x; it < 512 * 8; it += gridDim.x) {
    const int mt = it >> 3, nt = it & 7;
    f32x16 acc[2][2];
    gemm_tile(A + (size_t)mt * 128 * 1024, 1024, W + (size_t)nt * 128 * 1024, 1024, 1024, acc, sm);
    SeqInfo si = seq_of(mt * 128);
    const float* g1 = mod + (layer * 10 + si.b) * 6144 + 2 * 1024;
#pragma unroll
    for (int ni = 0; ni < 2; ni++) {
      const int col = nt * 128 + EPI_COL(wn, ni, lane);
      const float gg = g1[col];
#pragma unroll
      for (int mi = 0; mi < 2; mi++)
#pragma unroll
        for (int r = 0; r < 16; r++) {
          const int row = mt * 128 + EPI_ROW(wm, mi, r, lane);
          const float xr = res_from_input ? xin_row(p, row)[col] : p.out[(size_t)row * 1024 + col];
          p.out[(size_t)row * 1024 + col] = xr + gg * acc[mi][ni][r];
        }
    }
  }
}

__device__ __forceinline__ void phase_pq(const Params& p, int layer, bf16_t* sm) {
  const int lane = threadIdx.x & 63, wave = threadIdx.x >> 6, wm = wave >> 1, wn = wave & 1;
  const bf16_t* H = (const bf16_t*)(p.ws + OFF_H);
  const bf16_t* W = (const bf16_t*)(p.ws + OFF_WPQ) + (size_t)layer * 2048 * 1024;
  bf16_t* PQ = (bf16_t*)(p.ws + OFF_R1);
  for (int it = blockIdx.x; it < 512 * 16; it += gridDim.x) {
    const int mt = it >> 4, nt = it & 15;
    f32x16 acc[2][2];
    gemm_tile(H + (size_t)mt * 128 * 1024, 1024, W + (size_t)nt * 128 * 1024, 1024, 1024, acc, sm);
#pragma unroll
    for (int mi = 0; mi < 2; mi++)
#pragma unroll
      for (int ni = 0; ni < 2; ni++) {
        const int col = nt * 128 + EPI_COL(wn, ni, lane);
#pragma unroll
        for (int r = 0; r < 16; r++) {
          const int row = mt * 128 + EPI_ROW(wm, mi, r, lane);
          PQ[(size_t)row * 2048 + col] = f2bf(acc[mi][ni][r]);
        }
      }
  }
}

#define TK_INSERT(v, ix, xv, xi)                                  \
  {                                                               \
    float cx_ = (xv); int ci_ = (xi);                             \
    _Pragma("unroll") for (int k_ = 0; k_ < 16; k_++) {           \
      const bool gt_ = cx_ > v[k_];                               \
      const float tv_ = gt_ ? v[k_] : cx_;                        \
      const int ti_ = gt_ ? ix[k_] : ci_;                         \
      v[k_] = gt_ ? cx_ : v[k_];                                  \
      ix[k_] = gt_ ? ci_ : ix[k_];                                \
      cx_ = tv_; ci_ = ti_;                                       \
    }                                                             \
  }

__device__ __forceinline__ void phase_topk(const Params& p, int layer, bf16_t* sm) {
  const int tid = threadIdx.x, lane = tid & 63, wave = tid >> 6, wm = wave >> 1, wn = wave & 1;
  const bf16_t* PQ = (const bf16_t*)(p.ws + OFF_R1);
  const bf16_t* KEYS = (const bf16_t*)(p.ws + OFF_KEYS) + (size_t)layer * 2 * 16384;
  int* IDX = (int*)(p.ws + OFF_IDX);
  float* GW = (float*)(p.ws + OFF_GW);
  float* sc = (float*)sm;
  for (int it = blockIdx.x; it < 512 * 8; it += gridDim.x) {
    const int mt = it >> 3, h = it & 7;
    float v1[16], v2[16]; int i1[16], i2[16];
#pragma unroll
    for (int k = 0; k < 16; k++) { v1[k] = -3.0e38f; v2[k] = -3.0e38f; i1[k] = 0; i2[k] = 0; }
#pragma unroll
    for (int pp = 0; pp < 2; pp++) {
      f32x16 acc[2][2];
      gemm_tile(PQ + (size_t)mt * 128 * 2048 + h * 256 + pp * 128, 2048, KEYS + pp * 16384, 128, 128, acc, sm);
#pragma unroll
      for (int mi = 0; mi < 2; mi++)
#pragma unroll
        for (int ni = 0; ni < 2; ni++)
#pragma unroll
          for (int r = 0; r < 16; r++)
            sc[EPI_ROW(wm, mi, r, lane) * 129 + EPI_COL(wn, ni, lane)] = acc[mi][ni][r];
      __syncthreads();
      if (tid < 128) {
        const float* rowp = sc + tid * 129;
        if (pp == 0) { for (int j = 0; j < 128; j++) { const float x = rowp[j]; TK_INSERT(v1, i1, x, j); } }
        else { for (int j = 0; j < 128; j++) { const float x = rowp[j]; TK_INSERT(v2, i2, x, j); } }
      }
      __syncthreads();
    }
    if (tid < 128) {
      float fv[16]; int fi[16];
#pragma unroll
      for (int k = 0; k < 16; k++) { fv[k] = -3.0e38f; fi[k] = 0; }
#pragma unroll
      for (int a = 0; a < 16; a++)
#pragma unroll
        for (int b = 0; b < 16; b++)
          if ((a + 1) * (b + 1) <= 16) { TK_INSERT(fv, fi, v1[a] + v2[b], i1[a] * 128 + i2[b]); }
      float e[16], se = 0.f;
#pragma unroll
      for (int k = 0; k < 16; k++) { e[k] = __expf(fv[k] - fv[0]); se += e[k]; }
      const float inv = 1.f / se;
      const size_t o = ((size_t)(mt * 128 + tid)) * 128 + h * 16;
#pragma unroll
      for (int k = 0; k < 4; k++) {
        *(int4*)(IDX + o + k * 4) = make_int4(fi[k * 4], fi[k * 4 + 1], fi[k * 4 + 2], fi[k * 4 + 3]);
        *(float4*)(GW + o + k * 4) = make_float4(e[k * 4] * inv, e[k * 4 + 1] * inv, e[k * 4 + 2] * inv, e[k * 4 + 3] * inv);
      }
    }
  }
}

__device__ __forceinline__ float dot8(uint4 u, const float* hf) {
  return lo2f(u.x) * hf[0] + hi2f(u.x) * hf[1] + lo2f(u.y) * hf[2] + hi2f(u.y) * hf[3] +
         lo2f(u.z) * hf[4] + hi2f(u.z) * hf[5] + lo2f(u.w) * hf[6] + hi2f(u.w) * hf[7];
}
__device__ __forceinline__ void fma8(float* o, uint4 u, float a) {
  o[0] += a * lo2f(u.x); o[1] += a * hi2f(u.x); o[2] += a * lo2f(u.y); o[3] += a * hi2f(u.y);
  o[4] += a * lo2f(u.z); o[5] += a * hi2f(u.z); o[6] += a * lo2f(u.w); o[7] += a * hi2f(u.w);
}
__device__ __forceinline__ void phase_gather(const Params& p, int layer) {
  const int lane = threadIdx.x & 63;
  const int gw = (blockIdx.x * 256 + threadIdx.x) >> 6, nw = gridDim.x * 4;
  const bf16_t* H = (const bf16_t*)(p.ws + OFF_H);
  const bf16_t* UT = (const bf16_t*)(p.ws + OFF_UT);
  const bf16_t* VT = (const bf16_t*)(p.ws + OFF_VTAB);
  const int* IDX = (const int*)(p.ws + OFF_IDX);
  const float* GW = (const float*)(p.ws + OFF_GW);
  const float* mod = (const float*)(p.ws + OFF_MOD);
  for (int t = gw; t < T_TOK; t += nw) {
    float hf[16];
    {
      uint4 h0 = *(const uint4*)(H + (size_t)t * 1024 + lane * 8);
      uint4 h1 = *(const uint4*)(H + (size_t)t * 1024 + 512 + lane * 8);
      unpack8(h0, hf); unpack8(h1, hf + 8);
    }
    const int id0 = IDX[(size_t)t * 128 + lane], id1 = IDX[(size_t)t * 128 + 64 + lane];
    const float g0 = GW[(size_t)t * 128 + lane], g1 = GW[(size_t)t * 128 + 64 + lane];
    float o[16];
#pragma unroll
    for (int j = 0; j < 16; j++) o[j] = 0.f;
    for (int grp = 0; grp < 16; grp++) {
      const int idv = grp < 8 ? id0 : id1;
      const float gv = grp < 8 ? g0 : g1;
      const int lbase = (grp & 7) * 8;
      int ex[8]; float ge[8];
      uint4 ua[8], ub[8];
#pragma unroll
      for (int e = 0; e < 8; e++) {
        ex[e] = __shfl(idv, lbase + e);
        ge[e] = __shfl(gv, lbase + e);
        const bf16_t* ur = UT + (size_t)ex[e] * 1024;
        ua[e] = *(const uint4*)(ur + lane * 8);
        ub[e] = *(const uint4*)(ur + 512 + lane * 8);
      }
      float d[8];
#pragma unroll
      for (int e = 0; e < 8; e++) d[e] = dot8(ua[e], hf) + dot8(ub[e], hf + 8);
#pragma unroll
      for (int e = 0; e < 8; e++) {
        const bf16_t* vr = VT + (size_t)ex[e] * 1024;
        ua[e] = *(const uint4*)(vr + lane * 8);
        ub[e] = *(const uint4*)(vr + 512 + lane * 8);
      }
#pragma unroll
      for (int e = 0; e < 8; e++) d[e] = gelu_t(wave_sum(d[e])) * ge[e];
#pragma unroll
      for (int e = 0; e < 8; e++) { fma8(o, ua[e], d[e]); fma8(o + 8, ub[e], d[e]); }
    }
    SeqInfo si = seq_of(t);
    const float* g2 = mod + (layer * 10 + si.b) * 6144 + 5 * 1024;
    float* orow = p.out + (size_t)t * 1024;
#pragma unroll
    for (int q = 0; q < 2; q++)
#pragma unroll
      for (int j = 0; j < 2; j++) {
        const int idx = q * 512 + lane * 8 + j * 4;
        float4 xv = *(float4*)(orow + idx);
        float4 gg = *(const float4*)(g2 + idx);
        xv.x += gg.x * o[q * 8 + j * 4 + 0]; xv.y += gg.y * o[q * 8 + j * 4 + 1];
        xv.z += gg.z * o[q * 8 + j * 4 + 2]; xv.w += gg.w * o[q * 8 + j * 4 + 3];
        *(float4*)(orow + idx) = xv;
      }
  }
}

__device__ __forceinline__ void phase_g8(const Params& p, bf16_t* sm) {
  const int lane = threadIdx.x & 63, wave = threadIdx.x >> 6, wm = wave >> 1, wn = wave & 1;
  const bf16_t* H = (const bf16_t*)(p.ws + OFF_H);
  const bf16_t* W = (const bf16_t*)(p.ws + OFF_WCIN);
  bf16_t* BG = (bf16_t*)(p.ws + OFF_R1);
  bf16_t* U1 = (bf16_t*)(p.ws + OFF_R1 + 128 * MBY);
  for (int it = blockIdx.x; it < 512 * 24; it += gridDim.x) {
    const int mt = it / 24, nt = it % 24;
    f32x16 acc[2][2];
    gemm_tile(H + (size_t)mt * 128 * 1024, 1024, W + (size_t)nt * 128 * 1024, 1024, 1024, acc, sm);
    if (nt < 8) {
#pragma unroll
      for (int mi = 0; mi < 2; mi++)
#pragma unroll
        for (int ni = 0; ni < 2; ni++) {
          const int col = nt * 128 + EPI_COL(wn, ni, lane);
#pragma unroll
          for (int r = 0; r < 16; r++) {
            const int row = mt * 128 + EPI_ROW(wm, mi, r, lane);
            BG[(size_t)row * 1024 + col] = f2bf(acc[mi][ni][r]);
          }
        }
    } else {
      const int ch = (nt - 8) * 64 + wn * 32 + (lane & 31);
#pragma unroll
      for (int mi = 0; mi < 2; mi++)
#pragma unroll
        for (int r = 0; r < 16; r++) {
          const int row = mt * 128 + EPI_ROW(wm, mi, r, lane);
          U1[(size_t)row * 1024 + ch] = f2bf(acc[mi][0][r] * acc[mi][1][r]);
        }
    }
  }
}

__device__ __forceinline__ void phase_conv1(const Params& p) {
  const int gtid = blockIdx.x * 256 + threadIdx.x, gsz = gridDim.x * 256;
  const bf16_t* BG = (const bf16_t*)(p.ws + OFF_R1);
  const bf16_t* U1 = (const bf16_t*)(p.ws + OFF_R1 + 128 * MBY);
  bf16_t* Y = (bf16_t*)(p.ws + OFF_H);
  const float* cw = p.in[24];
  for (int i = gtid; i < T_TOK * 128; i += gsz) {
    const int t = i >> 7, c = (i & 127) * 8;
    SeqInfo si = seq_of(t);
    float acc[8];
#pragma unroll
    for (int j = 0; j < 8; j++) acc[j] = 0.f;
#pragma unroll
    for (int k = 0; k < 3; k++) {
      const int tt = t + k - 1;
      if (tt >= si.s0 && tt < si.s0 + si.S) {
        uint4 v = *(const uint4*)(U1 + (size_t)tt * 1024 + c);
        const float* w = cw + k * 1024 + c;
        acc[0] += w[0] * lo2f(v.x); acc[1] += w[1] * hi2f(v.x);
        acc[2] += w[2] * lo2f(v.y); acc[3] += w[3] * hi2f(v.y);
        acc[4] += w[4] * lo2f(v.z); acc[5] += w[5] * hi2f(v.z);
        acc[6] += w[6] * lo2f(v.w); acc[7] += w[7] * hi2f(v.w);
      }
    }
    uint4 b = *(const uint4*)(BG + (size_t)t * 1024 + c);
    float bf[8]; unpack8(b, bf);
#pragma unroll
    for (int j = 0; j < 8; j++) acc[j] *= bf[j];
    *(uint4*)(Y + (size_t)t * 1024 + c) = pack8(acc);
  }
}

__global__ void __launch_bounds__(256, 2) mega_fwd(Params p) {
  extern __shared__ __attribute__((aligned(16))) unsigned char smem[];
  cg::grid_group grid = cg::this_grid();
  bf16_t* sm = (bf16_t*)smem;
  unsigned char* ws = p.ws;

  phase_prep(p, smem);
  grid.sync();
  phase_norm(p, 0, 1, true);
  grid.sync();
  phase_g1(p, sm);
  grid.sync();
  phase_conv0(p);
  grid.sync();
  phase_g234(p, sm);
  grid.sync();
  phase_qkprep_scan1(p);
  grid.sync();
  phase_scan2(p);
  grid.sync();
  phase_attn_scan3(p, sm);
  grid.sync();
  phase_gres(p, (const bf16_t*)(ws + OFF_R1), (const bf16_t*)(ws + OFF_WOUT), 0, true, sm);
  grid.sync();
  phase_norm(p, 0, 2, false);
  phase_uvconv(p, 0);
  grid.sync();
  phase_pq(p, 0, sm);
  grid.sync();
  phase_topk(p, 0, sm);
  grid.sync();
  phase_gather(p, 0);
  grid.sync();
  phase_norm(p, 1, 1, false);
  grid.sync();
  phase_g8(p, sm);
  grid.sync();
  phase_conv1(p);
  grid.sync();
  phase_gres(p, (const bf16_t*)(ws + OFF_H), (const bf16_t*)(ws + OFF_WCOUT), 1, false, sm);
  grid.sync();
  phase_norm(p, 1, 2, false);
  phase_uvconv(p, 1);
  grid.sync();
  phase_pq(p, 1, sm);
  grid.sync();
  phase_topk(p, 1, sm);
  grid.sync();
  phase_gather(p, 1);
}

extern "C" void kernel_launch(void* const* d_in, const int* in_sizes, int n_in, void* d_out, int out_size, void* d_ws,
                              size_t ws_size, hipStream_t stream) {
  static int grid_blocks = 0;
  if (grid_blocks == 0) {
    if (n_in != 31 || ws_size < WS_NEED) {
      fprintf(stderr, "kernel_launch: unexpected n_in %d or ws_size %zu (< %zu)\n", n_in, ws_size, (size_t)WS_NEED);
      grid_blocks = -1;
      return;
    }
    int dev = 0, cus = 0, per_cu = 0;
    hipGetDevice(&dev);
    hipDeviceGetAttribute(&cus, hipDeviceAttributeMultiprocessorCount, dev);
    if (hipFuncSetAttribute((const void*)mega_fwd, hipFuncAttributeMaxDynamicSharedMemorySize, LDS_BYTES) != hipSuccess) {
      fprintf(stderr, "kernel_launch: hipFuncSetAttribute failed\n");
      grid_blocks = -1;
      return;
    }
    hipOccupancyMaxActiveBlocksPerMultiprocessor(&per_cu, (const void*)mega_fwd, 256, LDS_BYTES);
    if (per_cu < 1) per_cu = 1;
    if (per_cu > 2) per_cu = 2;
    grid_blocks = cus * per_cu;
    fprintf(stderr, "kernel_launch: cus %d per_cu %d grid %d ws %zu\n", cus, per_cu, grid_blocks, ws_size);
  }
  if (grid_blocks < 0) return;
  Params p{};
  for (int i = 0; i < 31; i++) p.in[i] = (const float*)d_in[i];
  p.out = (float*)d_out;
  p.ws = (unsigned char*)d_ws;
  void* args[] = {&p};
  hipError_t e = hipLaunchCooperativeKernel((const void*)mega_fwd, dim3(grid_blocks), dim3(256), args, LDS_BYTES, stream);
  if (e != hipSuccess) fprintf(stderr, "cooperative launch failed: %s (grid %d)\n", hipGetErrorString(e), grid_blocks);
}
```

```cpp
#include <hip/hip_runtime.h>
#include <hip/hip_cooperative_groups.h>
#include <cstdio>
#include <cstdint>
namespace cg = cooperative_groups;

typedef unsigned short bf16_t;
using bf16x8 = __attribute__((ext_vector_type(8))) short;
using bf16x4 = __attribute__((ext_vector_type(4))) short;
using f32x16 = __attribute__((ext_vector_type(16))) float;

#define T_TOK 65536
#define EPSN 1e-6f

struct Params {
  const float* in[31];
  float* out;
  unsigned char* ws;
};

constexpr size_t MBY = (size_t)1 << 20;
constexpr size_t OFF_WIN = 0;
constexpr size_t OFF_WUQ = OFF_WIN + (size_t)1536 * 1024 * 2;
constexpr size_t OFF_WUKV = OFF_WUQ + (size_t)768 * 256 * 2;
constexpr size_t OFF_WGATE = OFF_WUKV + (size_t)1024 * 128 * 2;
constexpr size_t OFF_WOUT = OFF_WGATE + (size_t)16 * 128 * 64 * 2;
constexpr size_t OFF_WCIN = OFF_WOUT + (size_t)1024 * 1024 * 2;
constexpr size_t OFF_WCOUT = OFF_WCIN + (size_t)3072 * 1024 * 2;
constexpr size_t OFF_WPQ = OFF_WCOUT + (size_t)1024 * 1024 * 2;
constexpr size_t OFF_KEYS = OFF_WPQ + (size_t)2 * 2048 * 1024 * 2;
constexpr size_t OFF_MOD = OFF_KEYS + (size_t)4 * 128 * 128 * 2;
constexpr size_t OFF_C8 = OFF_MOD + (size_t)2 * 10 * 6144 * 4;
constexpr size_t OFF_RSTDQ = OFF_C8 + 4096;
constexpr size_t OFF_RSTDKV = OFF_RSTDQ + (size_t)T_TOK * 4;
constexpr size_t OFF_AGGA = OFF_RSTDKV + (size_t)T_TOK * 4;
constexpr size_t OFF_AGGB = OFF_AGGA + 2 * MBY;
constexpr size_t OFF_CARRY = OFF_AGGB + 2 * MBY;
constexpr size_t OFF_CNT = OFF_CARRY + 2 * MBY;
static_assert(OFF_CNT + 4096 < 40 * MBY, "small region overflow");
constexpr size_t OFF_H = 40 * MBY;
constexpr size_t OFF_R1 = 168 * MBY;
constexpr size_t OFF_Z2 = OFF_R1 + 128 * MBY;
constexpr size_t OFF_XC = OFF_R1 + 180 * MBY;
constexpr size_t OFF_B = 424 * MBY;
constexpr size_t OFF_VT = OFF_B + 96 * MBY;
constexpr size_t OFF_UT = OFF_B;
constexpr size_t OFF_VTAB = OFF_B + 32 * MBY;
constexpr size_t OFF_IDX = OFF_B + 64 * MBY;
constexpr size_t OFF_GW = OFF_B + 96 * MBY;
constexpr size_t WS_NEED = 584 * MBY;

#define LDS_BYTES 73728

__device__ __forceinline__ float bf2f(unsigned short h) { return __uint_as_float(((unsigned)h) << 16); }
__device__ __forceinline__ unsigned short f2bf(float f) {
  unsigned u = __float_as_uint(f);
  u += 0x7fffu + ((u >> 16) & 1u);
  return (unsigned short)(u >> 16);
}
typedef __bf16 hwbf16x2 __attribute__((ext_vector_type(2)));
typedef float f32x2 __attribute__((ext_vector_type(2)));
__device__ __forceinline__ unsigned pack2(float a, float b) {
  f32x2 v = {a, b};
  hwbf16x2 r = __builtin_convertvector(v, hwbf16x2);
  return *(unsigned*)&r;
}
__device__ __forceinline__ float lo2f(unsigned u) { return __uint_as_float(u << 16); }
__device__ __forceinline__ float hi2f(unsigned u) { return __uint_as_float(u & 0xffff0000u); }
__device__ __forceinline__ float gelu_t(float x) {
  float u = 0.7978845608f * (x + 0.044715f * x * x * x);
  float t = 1.f - 2.f / (1.f + __expf(2.f * u));
  return 0.5f * x * (1.f + t);
}
__device__ __forceinline__ float sigmoid_f(float x) { return 1.f / (1.f + __expf(-x)); }
__device__ __forceinline__ float wave_sum(float v) {
#pragma unroll
  for (int o = 32; o > 0; o >>= 1) v += __shfl_xor(v, o);
  return v;
}
struct SeqInfo { int b, s0, S; };
__device__ __forceinline__ SeqInfo seq_of(int t) {
  SeqInfo r;
  if (t < 32768) { r.b = t >> 14; r.s0 = r.b << 14; r.S = 16384; }
  else { int u = (t - 32768) >> 12; r.b = 2 + u; r.s0 = 32768 + (u << 12); r.S = 4096; }
  return r;
}
__device__ __forceinline__ const float* xin_row(const Params& p, int t) {
  return t < 32768 ? p.in[0] + (size_t)t * 1024 : p.in[1] + (size_t)(t - 32768) * 1024;
}

__device__ __forceinline__ void gemm_tile(const bf16_t* __restrict__ A, int lda, const bf16_t* __restrict__ B, int ldb,
                                          int K, f32x16 (&acc)[2][2], bf16_t* sm) {
  const int tid = threadIdx.x, lane = tid & 63, wave = tid >> 6, wm = wave >> 1, wn = wave & 1;
  const int lr = tid >> 3, lc = (tid & 7) * 8;
  uint4 ra[4], rb[4];
  const bf16_t* Ap = A + (size_t)lr * lda + lc;
  const bf16_t* Bp = B + (size_t)lr * ldb + lc;
#pragma unroll
  for (int i = 0; i < 4; i++) {
    ra[i] = *(const uint4*)(Ap + (size_t)(i * 32) * lda);
    rb[i] = *(const uint4*)(Bp + (size_t)(i * 32) * ldb);
  }
#pragma unroll
  for (int mi = 0; mi < 2; mi++)
#pragma unroll
    for (int ni = 0; ni < 2; ni++)
#pragma unroll
      for (int r = 0; r < 16; r++) acc[mi][ni][r] = 0.f;
  {
    bf16_t* sA = sm; bf16_t* sB = sm + 128 * 72;
#pragma unroll
    for (int i = 0; i < 4; i++) {
      *(uint4*)(sA + (lr + i * 32) * 72 + lc) = ra[i];
      *(uint4*)(sB + (lr + i * 32) * 72 + lc) = rb[i];
    }
  }
  __syncthreads();
  const int nk = K >> 6;
  for (int kt = 0; kt < nk; ++kt) {
    const bf16_t* cA = sm + (kt & 1) * (2 * 128 * 72);
    const bf16_t* cB = cA + 128 * 72;
    if (kt + 1 < nk) {
#pragma unroll
      for (int i = 0; i < 4; i++) {
        ra[i] = *(const uint4*)(Ap + (size_t)(i * 32) * lda + (kt + 1) * 64);
        rb[i] = *(const uint4*)(Bp + (size_t)(i * 32) * ldb + (kt + 1) * 64);
      }
    }
#pragma unroll
    for (int kk = 0; kk < 4; ++kk) {
      bf16x8 a[2], b[2];
#pragma unroll
      for (int mi = 0; mi < 2; mi++)
        a[mi] = *(const bf16x8*)(cA + (wm * 64 + mi * 32 + (lane & 31)) * 72 + kk * 16 + (lane >> 5) * 8);
#pragma unroll
      for (int ni = 0; ni < 2; ni++)
        b[ni] = *(const bf16x8*)(cB + (wn * 64 + ni * 32 + (lane & 31)) * 72 + kk * 16 + (lane >> 5) * 8);
#pragma unroll
      for (int mi = 0; mi < 2; mi++)
#pragma unroll
        for (int ni = 0; ni < 2; ni++)
          acc[mi][ni] = __builtin_amdgcn_mfma_f32_32x32x16_bf16(a[mi], b[ni], acc[mi][ni], 0, 0, 0);
    }
    if (kt + 1 < nk) {
      bf16_t* nA = sm + ((kt + 1) & 1) * (2 * 128 * 72);
      bf16_t* nB = nA + 128 * 72;
#pragma unroll
      for (int i = 0; i < 4; i++) {
        *(uint4*)(nA + (lr + i * 32) * 72 + lc) = ra[i];
        *(uint4*)(nB + (lr + i * 32) * 72 + lc) = rb[i];
      }
    }
    __syncthreads();
  }
}

#define EPI_ROW(wm, mi, r, lane) ((wm) * 64 + (mi) * 32 + 8 * ((r) >> 2) + 4 * ((lane) >> 5) + ((r) & 3))
#define EPI_COL(wn, ni, lane) ((wn) * 64 + (ni) * 32 + ((lane) & 31))

template <class F>
__device__ __forceinline__ void tconv(bf16_t* dst, int N, int K, F src, float* tile) {
  const int tn = N >> 6, tk = K >> 6;
  for (int it = blockIdx.x; it < tn * tk; it += gridDim.x) {
    const int n0 = (it % tn) << 6, k0 = (it / tn) << 6;
    for (int i = threadIdx.x; i < 4096; i += 256) { int kk = i >> 6, nn = i & 63; tile[kk * 65 + nn] = src(k0 + kk, n0 + nn); }
    __syncthreads();
    for (int i = threadIdx.x; i < 4096; i += 256) { int nn = i >> 6, kk = i & 63; dst[(size_t)(n0 + nn) * K + k0 + kk] = f2bf(tile[kk * 65 + nn]); }
    __syncthreads();
  }
}

__device__ __forceinline__ void phase_prep(const Params& p, unsigned char* smem) {
  unsigned char* ws = p.ws;
  float* tile = (float*)smem;
  const int tid = threadIdx.x;
  const int gtid = blockIdx.x * 256 + tid, gsz = gridDim.x * 256;
  {
    const float* w_in = p.in[8];
    tconv((bf16_t*)(ws + OFF_WIN), 1536, 1024, [=](int k, int n) { return n < 1440 ? w_in[(size_t)k * 1440 + n] : 0.f; }, tile);
    const float* w_uq = p.in[17]; const float* qn = p.in[16];
    tconv((bf16_t*)(ws + OFF_WUQ), 768, 256, [=](int k, int n) { return w_uq[k * 768 + n] * qn[k]; }, tile);
    const float* w_ukv = p.in[19]; const float* kvn = p.in[18];
    tconv((bf16_t*)(ws + OFF_WUKV), 1024, 128, [=](int k, int n) { return w_ukv[k * 1024 + n] * kvn[k]; }, tile);
    const float* wa = p.in[11]; const float* wx = p.in[13];
    for (int hd = 0; hd < 16; ++hd) {
      const int h = hd >> 1, d = hd & 1;
      tconv((bf16_t*)(ws + OFF_WGATE) + hd * 128 * 64, 128, 64, [=](int k, int n) {
        int wn = n >> 6, ty = (n >> 5) & 1, j = n & 31; int c = wn * 32 + j;
        const float* W = ty ? wx : wa;
        return W[((d * 8 + h) * 64 + k) * 64 + c]; }, tile);
    }
    const float* w_out = p.in[22];
    tconv((bf16_t*)(ws + OFF_WOUT), 1024, 1024, [=](int k, int n) { return w_out[((k + 512) & 1023) * 1024 + n]; }, tile);
    const float* c_w_in = p.in[23];
    tconv((bf16_t*)(ws + OFF_WCIN), 3072, 1024, [=](int k, int n) {
      int col;
      if (n < 1024) col = n;
      else { int q = n - 1024; int tl = q >> 7, wi = q & 127; int wn = wi >> 6, ty = (wi >> 5) & 1, j = wi & 31; col = 1024 + ty * 1024 + tl * 64 + wn * 32 + j; }
      return c_w_in[(size_t)k * 3072 + col]; }, tile);
    const float* c_w_out = p.in[25];
    tconv((bf16_t*)(ws + OFF_WCOUT), 1024, 1024, [=](int k, int n) { return c_w_out[k * 1024 + n]; }, tile);
    const float* wq = p.in[26];
    for (int l = 0; l < 2; ++l)
      tconv((bf16_t*)(ws + OFF_WPQ) + (size_t)l * 2048 * 1024, 2048, 1024, [=](int k, int n) { return wq[((size_t)(l * 1024 + k)) * 2048 + n]; }, tile);
  }
  {
    bf16_t* keys = (bf16_t*)(ws + OFF_KEYS);
    const float* k1 = p.in[27]; const float* k2 = p.in[28];
    for (int i = gtid; i < 65536; i += gsz) {
      int l = i >> 15, pp = (i >> 14) & 1, r = i & 16383;
      keys[i] = f2bf((pp ? k2 : k1)[l * 16384 + r]);
    }
    float* c8 = (float*)(ws + OFF_C8);
    const float* lam = p.in[15];
    for (int i = gtid; i < 1024; i += gsz) c8[i] = 8.f * log1pf(__expf(-lam[i])) * 1.44269504f;
    if (gtid < 16) ((int*)(ws + OFF_CNT))[gtid] = 0;
  }
  {
    float* silu_s = (float*)smem;
    float* red = silu_s + 10240;
    float* mod = (float*)(ws + OFF_MOD);
    const float* cp = p.in[2]; const float* cs = p.in[3];
    const float* ada_w = p.in[4]; const float* ada_b = p.in[5];
    __syncthreads();
    for (int i = tid; i < 10240; i += 256) {
      int b = i >> 10, k = i & 1023;
      float c = b < 2 ? cp[b * 1024 + k] : cs[(b - 2) * 1024 + k];
      silu_s[i] = c / (1.f + __expf(-c));
    }
    __syncthreads();
    for (int it = blockIdx.x; it < 192; it += gridDim.x) {
      const int l = it / 96, n = (it % 96) * 64 + (tid & 63), kq = tid >> 6;
      float acc[10];
#pragma unroll
      for (int b = 0; b < 10; b++) acc[b] = 0.f;
      for (int k = kq * 256; k < kq * 256 + 256; ++k) {
        float w = ada_w[((size_t)(l * 1024 + k)) * 6144 + n];
#pragma unroll
        for (int b = 0; b < 10; b++) acc[b] += silu_s[b * 1024 + k] * w;
      }
#pragma unroll
      for (int b = 0; b < 10; b++) red[(kq * 10 + b) * 64 + (tid & 63)] = acc[b];
      __syncthreads();
      if (tid < 64) {
#pragma unroll
        for (int b = 0; b < 10; b++)
          mod[(l * 10 + b) * 6144 + n] = ada_b[l * 6144 + n] + red[(0 * 10 + b) * 64 + tid] + red[(1 * 10 + b) * 64 + tid] +
                                         red[(2 * 10 + b) * 64 + tid] + red[(3 * 10 + b) * 64 + tid];
      }
      __syncthreads();
    }
  }
}

#define U_SCALE 64.f
#define V_SCALE 8.f
__device__ __forceinline__ unsigned pack_fp8x4(float4 a, float sc) {
  int pk = __builtin_amdgcn_cvt_pk_fp8_f32(a.x * sc, a.y * sc, 0, false);
  pk = __builtin_amdgcn_cvt_pk_fp8_f32(a.z * sc, a.w * sc, pk, true);
  return (unsigned)pk;
}
__device__ __forceinline__ void phase_uvconv(const Params& p, int l) {
  const int gtid = blockIdx.x * 256 + threadIdx.x, gsz = gridDim.x * 256;
  const float4* us = (const float4*)(p.in[29] + (size_t)l * 16384 * 1024);
  const float4* vs = (const float4*)(p.in[30] + (size_t)l * 16384 * 1024);
  unsigned* ud = (unsigned*)(p.ws + OFF_UT);
  unsigned* vd = (unsigned*)(p.ws + OFF_VTAB);
  for (int i = gtid; i < 16384 * 256; i += gsz) {
    ud[i] = pack_fp8x4(us[i], U_SCALE);
    vd[i] = pack_fp8x4(vs[i], V_SCALE);
  }
}

__device__ __forceinline__ void phase_norm(const Params& p, int layer, int which, bool from_input) {
  const int lane = threadIdx.x & 63;
  const int gw = (blockIdx.x * 256 + threadIdx.x) >> 6, nw = gridDim.x * 4;
  const float* g = (which == 1 ? p.in[6] : p.in[7]) + layer * 1024;
  const float* mod = (const float*)(p.ws + OFF_MOD);
  bf16_t* H = (bf16_t*)(p.ws + OFF_H);
  for (int t = gw; t < T_TOK; t += nw) {
    SeqInfo si = seq_of(t);
    const float* x = from_input ? xin_row(p, t) : p.out + (size_t)t * 1024;
    const float* md = mod + (layer * 10 + si.b) * 6144 + (which == 1 ? 0 : 3 * 1024);
    float4 v[4];
    float ss = 0.f;
#pragma unroll
    for (int j = 0; j < 4; j++) {
      v[j] = *(const float4*)(x + j * 256 + lane * 4);
      ss += v[j].x * v[j].x + v[j].y * v[j].y + v[j].z * v[j].z + v[j].w * v[j].w;
    }
    ss = wave_sum(ss);
    const float rstd = rsqrtf(ss * (1.f / 1024.f) + EPSN);
#pragma unroll
    for (int j = 0; j < 4; j++) {
      const int idx = j * 256 + lane * 4;
      float4 gg = *(const float4*)(g + idx);
      float4 sh = *(const float4*)(md + idx);
      float4 sc = *(const float4*)(md + 1024 + idx);
      float y0 = v[j].x * rstd * gg.x * (1.f + sc.x) + sh.x;
      float y1 = v[j].y * rstd * gg.y * (1.f + sc.y) + sh.y;
      float y2 = v[j].z * rstd * gg.z * (1.f + sc.z) + sh.z;
      float y3 = v[j].w * rstd * gg.w * (1.f + sc.w) + sh.w;
      *(uint2*)(H + (size_t)t * 1024 + idx) = make_uint2(pack2(y0, y1), pack2(y2, y3));
    }
  }
}

__device__ __forceinline__ void phase_g1(const Params& p, bf16_t* sm) {
  const int lane = threadIdx.x & 63, wave = threadIdx.x >> 6, wm = wave >> 1, wn = wave & 1;
  const bf16_t* H = (const bf16_t*)(p.ws + OFF_H);
  const bf16_t* W = (const bf16_t*)(p.ws + OFF_WIN);
  bf16_t* Z1 = (bf16_t*)(p.ws + OFF_R1);
  bf16_t* Z2 = (bf16_t*)(p.ws + OFF_Z2);
  for (int it = blockIdx.x; it < 512 * 12; it += gridDim.x) {
    const int mt = it / 12, nt = it % 12;
    f32x16 acc[2][2];
    gemm_tile(H + (size_t)mt * 128 * 1024, 1024, W + (size_t)nt * 128 * 1024, 1024, 1024, acc, sm);
#pragma unroll
    for (int mi = 0; mi < 2; mi++)
#pragma unroll
      for (int ni = 0; ni < 2; ni++) {
        const int col = nt * 128 + EPI_COL(wn, ni, lane);
#pragma unroll
        for (int r = 0; r < 16; r++) {
          const int row = mt * 128 + EPI_ROW(wm, mi, r, lane);
          const unsigned short v = f2bf(acc[mi][ni][r]);
          if (col < 1024) Z1[(size_t)row * 1024 + col] = v;
          else if (col < 1440) Z2[(size_t)row * 416 + (col - 1024)] = v;
        }
      }
  }
}

__device__ __forceinline__ void phase_conv0(const Params& p) {
  const int gtid = blockIdx.x * 256 + threadIdx.x, gsz = gridDim.x * 256;
  const bf16_t* Z1 = (const bf16_t*)(p.ws + OFF_R1);
  const bf16_t* Z2 = (const bf16_t*)(p.ws + OFF_Z2);
  bf16_t* XC = (bf16_t*)(p.ws + OFF_XC);
  const float* cw = p.in[9]; const float* cb = p.in[10];
  for (int i = gtid; i < T_TOK * 64; i += gsz) {
    const int t = i >> 6, c = (i & 63) * 8;
    SeqInfo si = seq_of(t);
    float acc[8];
#pragma unroll
    for (int j = 0; j < 8; j++) acc[j] = cb[c + j];
#pragma unroll
    for (int k = 0; k < 4; k++) {
      const int tt = t + k - 2;
      if (tt >= si.s0 && tt < si.s0 + si.S) {
        uint4 v = *(const uint4*)(Z1 + (size_t)tt * 1024 + c);
        const float* w = cw + k * 512 + c;
        acc[0] += w[0] * lo2f(v.x); acc[1] += w[1] * hi2f(v.x);
        acc[2] += w[2] * lo2f(v.y); acc[3] += w[3] * hi2f(v.y);
        acc[4] += w[4] * lo2f(v.z); acc[5] += w[5] * hi2f(v.z);
        acc[6] += w[6] * lo2f(v.w); acc[7] += w[7] * hi2f(v.w);
      }
    }
    *(uint4*)(XC + (size_t)t * 512 + c) = make_uint4(pack2(acc[0], acc[1]), pack2(acc[2], acc[3]), pack2(acc[4], acc[5]), pack2(acc[6], acc[7]));
  }
  const int lane = threadIdx.x & 63;
  const int gw = gtid >> 6, nw = gsz >> 6;
  float* rq = (float*)(p.ws + OFF_RSTDQ);
  float* rkv = (float*)(p.ws + OFF_RSTDKV);
  for (int t = gw; t < T_TOK; t += nw) {
    const bf16_t* z = Z2 + (size_t)t * 416;
    uint2 a = *(const uint2*)(z + lane * 4);
    unsigned b = *(const unsigned*)(z + 256 + lane * 2);
    float ssq = lo2f(a.x) * lo2f(a.x) + hi2f(a.x) * hi2f(a.x) + lo2f(a.y) * lo2f(a.y) + hi2f(a.y) * hi2f(a.y);
    float ssk = lo2f(b) * lo2f(b) + hi2f(b) * hi2f(b);
    ssq = wave_sum(ssq); ssk = wave_sum(ssk);
    if (lane == 0) { rq[t] = rsqrtf(ssq * (1.f / 256.f) + EPSN); rkv[t] = rsqrtf(ssk * (1.f / 128.f) + EPSN); }
  }
}

__device__ __forceinline__ void phase_g234(const Params& p, bf16_t* sm) {
  const int lane = threadIdx.x & 63, wave = threadIdx.x >> 6, wm = wave >> 1, wn = wave & 1;
  const bf16_t* Z2 = (const bf16_t*)(p.ws + OFF_Z2);
  const bf16_t* XC = (const bf16_t*)(p.ws + OFF_XC);
  bf16_t* QR = (bf16_t*)(p.ws + OFF_H);
  bf16_t* Kb = (bf16_t*)(p.ws + OFF_B);
  bf16_t* Vt = (bf16_t*)(p.ws + OFF_VT);
  unsigned* AB = (unsigned*)p.out;
  const float* rq = (const float*)(p.ws + OFF_RSTDQ);
  const float* rkv = (const float*)(p.ws + OFF_RSTDKV);
  const float* c8 = (const float*)(p.ws + OFF_C8);
  for (int it = blockIdx.x; it < 15360; it += gridDim.x) {
    f32x16 acc[2][2];
    if (it < 3072) {
      const int mt = it / 6, nt = it % 6;
      gemm_tile(Z2 + (size_t)mt * 128 * 416, 416, (const bf16_t*)(p.ws + OFF_WUQ) + nt * 128 * 256, 256, 256, acc, sm);
#pragma unroll
      for (int mi = 0; mi < 2; mi++)
#pragma unroll
        for (int r = 0; r < 16; r++) {
          const int row = mt * 128 + EPI_ROW(wm, mi, r, lane);
          const float rs = rq[row];
#pragma unroll
          for (int ni = 0; ni < 2; ni++) {
            const int col = nt * 128 + EPI_COL(wn, ni, lane);
            QR[(size_t)row * 768 + col] = f2bf(acc[mi][ni][r] * rs);
          }
        }
    } else if (it < 7168) {
      const int j = it - 3072;
      const int mt = j >> 3, h = j & 7;
      gemm_tile(Z2 + (size_t)mt * 128 * 416 + 256, 416, (const bf16_t*)(p.ws + OFF_WUKV) + h * 128 * 128, 128, 128, acc, sm);
      SeqInfo si = seq_of(mt * 128);
      if (wn == 0) {
#pragma unroll
        for (int mi = 0; mi < 2; mi++)
#pragma unroll
          for (int r = 0; r < 16; r++) {
            const int row = mt * 128 + EPI_ROW(wm, mi, r, lane);
            const float rs = rkv[row];
            const size_t krow = (size_t)si.s0 * 8 + (size_t)h * si.S + (row - si.s0);
#pragma unroll
            for (int ni = 0; ni < 2; ni++)
              Kb[krow * 96 + ni * 32 + (lane & 31)] = f2bf(acc[mi][ni][r] * rs);
          }
      } else {
        bf16_t* vb = Vt + ((size_t)si.s0 * 8 + (size_t)h * si.S) * 64;
#pragma unroll
        for (int mi = 0; mi < 2; mi++)
#pragma unroll
          for (int rg = 0; rg < 4; rg++) {
            const int t4 = mt * 128 + wm * 64 + mi * 32 + 8 * rg + 4 * (lane >> 5);
            const float r0 = rkv[t4], r1 = rkv[t4 + 1], r2 = rkv[t4 + 2], r3 = rkv[t4 + 3];
#pragma unroll
            for (int ni = 0; ni < 2; ni++) {
              const int dv = ni * 32 + (lane & 31);
              uint2 pk = make_uint2(pack2(acc[mi][ni][rg * 4 + 0] * r0, acc[mi][ni][rg * 4 + 1] * r1),
                                    pack2(acc[mi][ni][rg * 4 + 2] * r2, acc[mi][ni][rg * 4 + 3] * r3));
              *(uint2*)(vb + (size_t)dv * si.S + (t4 - si.s0)) = pk;
            }
          }
      }
    } else {
      const int j = it - 7168;
      const int mt = j >> 4, hd = j & 15, h = hd >> 1, d = hd & 1;
      gemm_tile(XC + (size_t)mt * 128 * 512 + h * 64, 512, (const bf16_t*)(p.ws + OFF_WGATE) + hd * 128 * 64, 64, 64, acc, sm);
      const int c = h * 64 + wn * 32 + (lane & 31);
      const float ba = p.in[12][d * 512 + c], bx = p.in[14][d * 512 + c], cc8 = c8[d * 512 + c];
#pragma unroll
      for (int mi = 0; mi < 2; mi++)
#pragma unroll
        for (int r = 0; r < 16; r++) {
          const int row = mt * 128 + EPI_ROW(wm, mi, r, lane);
          const float rg = sigmoid_f(acc[mi][0][r] + ba);
          const float ig = sigmoid_f(acc[mi][1][r] + bx);
          const float l2a = -rg * cc8;
          const float a2 = exp2f(2.f * l2a);
          const float xv = bf2f(XC[(size_t)row * 512 + c]);
          const float bb = sqrtf(fmaxf(1.f - a2, 0.f)) * ig * xv;
          AB[((size_t)d * T_TOK + row) * 512 + c] = pack2(l2a, bb);
        }
    }
  }
}

__device__ __forceinline__ void unpack8(uint4 v, float* f) {
  f[0] = lo2f(v.x); f[1] = hi2f(v.x); f[2] = lo2f(v.y); f[3] = hi2f(v.y);
  f[4] = lo2f(v.z); f[5] = hi2f(v.z); f[6] = lo2f(v.w); f[7] = hi2f(v.w);
}
__device__ __forceinline__ uint4 pack8(const float* f) {
  return make_uint4(pack2(f[0], f[1]), pack2(f[2], f[3]), pack2(f[4], f[5]), pack2(f[6], f[7]));
}
__device__ __forceinline__ float sumsq8(uint4 v) {
  float a0 = lo2f(v.x), a1 = hi2f(v.x), a2 = lo2f(v.y), a3 = hi2f(v.y), a4 = lo2f(v.z), a5 = hi2f(v.z), a6 = lo2f(v.w), a7 = hi2f(v.w);
  return a0 * a0 + a1 * a1 + a2 * a2 + a3 * a3 + a4 * a4 + a5 * a5 + a6 * a6 + a7 * a7;
}
__device__ __forceinline__ void norm_rope96(uint4 (&v)[12], const float* __restrict__ gain, float outscale, const float (&cs)[16], const float (&sn)[16]) {
  float ss = 0.f;
#pragma unroll
  for (int i = 0; i < 12; i++) ss += sumsq8(v[i]);
  const float rstd = rsqrtf(ss * (1.f / 96.f) + EPSN);
#pragma unroll
  for (int i = 0; i < 8; i++) {
    float f[8]; unpack8(v[i], f);
#pragma unroll
    for (int j = 0; j < 8; j++) f[j] = f[j] * rstd * gain[i * 8 + j] * outscale;
    v[i] = pack8(f);
  }
#pragma unroll
  for (int q = 0; q < 2; q++) {
    float f1[8], f2[8]; unpack8(v[8 + q], f1); unpack8(v[10 + q], f2);
#pragma unroll
    for (int j = 0; j < 8; j++) {
      const float r1 = f1[j] * rstd * gain[64 + q * 8 + j];
      const float r2 = f2[j] * rstd * gain[80 + q * 8 + j];
      const float c = cs[q * 8 + j], s = sn[q * 8 + j];
      f1[j] = (r1 * c - r2 * s) * outscale;
      f2[j] = (r2 * c + r1 * s) * outscale;
    }
    v[8 + q] = pack8(f1); v[10 + q] = pack8(f2);
  }
}

#define QSCALE (0.10206207261596575f * 1.4426950408889634f)

__device__ __forceinline__ void phase_qkprep_scan1(const Params& p) {
  const int tid = threadIdx.x;
  bf16_t* QR = (bf16_t*)(p.ws + OFF_H);
  bf16_t* Kb = (bf16_t*)(p.ws + OFF_B);
  const bf16_t* Z2 = (const bf16_t*)(p.ws + OFF_Z2);
  const unsigned* AB = (const unsigned*)p.out;
  float* aggA = (float*)(p.ws + OFF_AGGA);
  float* aggB = (float*)(p.ws + OFF_AGGB);
  for (int it = blockIdx.x; it < 4096; it += gridDim.x) {
    if (it < 2048) {
      const int i = it * 256 + tid;
      const int t = i >> 3, h = i & 7;
      SeqInfo si = seq_of(t);
      const float pos = (float)(t - si.s0);
      float cs[16], sn[16];
#pragma unroll
      for (int k = 0; k < 16; k++) {
        const float inv = exp2f(-(float)k * (13.287712379549449f / 16.f));
        float rev = pos * inv * 0.15915494309189535f;
        rev = rev - floorf(rev);
        cs[k] = __builtin_amdgcn_cosf(rev);
        sn[k] = __builtin_amdgcn_sinf(rev);
      }
      uint4 v[12];
      bf16_t* qp = QR + (size_t)t * 768 + h * 96;
#pragma unroll
      for (int k = 0; k < 12; k++) v[k] = *(const uint4*)(qp + k * 8);
      norm_rope96(v, p.in[20], QSCALE, cs, sn);
#pragma unroll
      for (int k = 0; k < 12; k++) *(uint4*)(qp + k * 8) = v[k];
      bf16_t* kp = Kb + ((size_t)si.s0 * 8 + (size_t)h * si.S + (t - si.s0)) * 96;
#pragma unroll
      for (int k = 0; k < 8; k++) v[k] = *(const uint4*)(kp + k * 8);
#pragma unroll
      for (int k = 0; k < 4; k++) v[8 + k] = *(const uint4*)(Z2 + (size_t)t * 416 + 384 + k * 8);
      norm_rope96(v, p.in[21], 1.f, cs, sn);
#pragma unroll
      for (int k = 0; k < 12; k++) *(uint4*)(kp + k * 8) = v[k];
    } else {
      const int i = (it - 2048) * 256 + tid;
      const int c = i & 511, ch = (i >> 9) & 511, d = i >> 18;
      const unsigned* ab = AB + ((size_t)d * T_TOK + (size_t)ch * 128) * 512 + c;
      float A = 1.f, Bv = 0.f;
      if (d == 0) {
        for (int s = 0; s < 128; s++) { unsigned u = ab[(size_t)s * 512]; float a = exp2f(lo2f(u)); Bv = a * Bv + hi2f(u); A *= a; }
      } else {
        for (int s = 127; s >= 0; s--) { unsigned u = ab[(size_t)s * 512]; float a = exp2f(lo2f(u)); Bv = a * Bv + hi2f(u); A *= a; }
      }
      aggA[i] = A; aggB[i] = Bv;
    }
  }
}

__device__ __forceinline__ void phase_scan2(const Params& p) {
  const int gtid = blockIdx.x * 256 + threadIdx.x, gsz = gridDim.x * 256;
  const float* aggA = (const float*)(p.ws + OFF_AGGA);
  const float* aggB = (const float*)(p.ws + OFF_AGGB);
  float* carry = (float*)(p.ws + OFF_CARRY);
  for (int i = gtid; i < 10240; i += gsz) {
    const int d = i / 5120, rem = i % 5120, seq = rem >> 9, c = rem & 511;
    const int ch0 = seq < 2 ? seq * 128 : 256 + (seq - 2) * 32;
    const int nch = seq < 2 ? 128 : 32;
    float cr = 0.f;
    if (d == 0) {
      for (int j = 0; j < nch; j++) { const int o = ((d * 512) + ch0 + j) * 512 + c; carry[o] = cr; cr = aggA[o] * cr + aggB[o]; }
    } else {
      for (int j = nch - 1; j >= 0; j--) { const int o = ((d * 512) + ch0 + j) * 512 + c; carry[o] = cr; cr = aggA[o] * cr + aggB[o]; }
    }
  }
}

__device__ __forceinline__ void scan3_item(const Params& p, int it) {
  const int i = it * 256 + threadIdx.x;
  const int c = i & 511, ch = i >> 9;
  unsigned* AB = (unsigned*)p.out;
  const float* carry = (const float*)(p.ws + OFF_CARRY);
  bf16_t* Z1 = (bf16_t*)(p.ws + OFF_R1);
  unsigned* abf = AB + ((size_t)ch * 128) * 512 + c;
  unsigned* abb = AB + ((size_t)T_TOK + (size_t)ch * 128) * 512 + c;
  float hst = carry[ch * 512 + c];
  for (int s = 0; s < 128; s++) {
    unsigned u = abf[(size_t)s * 512];
    hst = exp2f(lo2f(u)) * hst + hi2f(u);
    abf[(size_t)s * 512] = __float_as_uint(hst);
  }
  hst = carry[(512 + ch) * 512 + c];
  bf16_t* zp = Z1 + ((size_t)ch * 128) * 1024 + 512 + c;
  for (int s = 127; s >= 0; s--) {
    unsigned u = abb[(size_t)s * 512];
    hst = exp2f(lo2f(u)) * hst + hi2f(u);
    const float tot = hst + __uint_as_float(abf[(size_t)s * 512]);
    const float yr = bf2f(zp[(size_t)s * 1024]);
    zp[(size_t)s * 1024] = f2bf(tot * gelu_t(yr));
  }
}

#define KS_STRIDE 104
#define VS_STRIDE 72
#define ATT_BUF (64 * KS_STRIDE + 64 * VS_STRIDE)
__device__ __forceinline__ void attn_item(const Params& p, int seq, int h, int qt, bf16_t* sm) {
  const int tid = threadIdx.x, lane = tid & 63, w = tid >> 6, hh = lane >> 5, l31 = lane & 31;
  int s0, S;
  if (seq < 2) { s0 = seq << 14; S = 16384; } else { s0 = 32768 + ((seq - 2) << 12); S = 4096; }
  const bf16_t* Q = (const bf16_t*)(p.ws + OFF_H) + ((size_t)(s0 + qt * 128)) * 768 + h * 96;
  const bf16_t* Kp = (const bf16_t*)(p.ws + OFF_B) + ((size_t)s0 * 8 + (size_t)h * S) * 96;
  const bf16_t* Vp = (const bf16_t*)(p.ws + OFF_VT) + ((size_t)s0 * 8 + (size_t)h * S) * 64;
  bf16_t* Z1 = (bf16_t*)(p.ws + OFF_R1);
  bf16x8 qf[6];
#pragma unroll
  for (int kk = 0; kk < 6; kk++) qf[kk] = *(const bf16x8*)(Q + (size_t)(w * 32 + l31) * 768 + kk * 16 + hh * 8);
  f32x16 o[2];
#pragma unroll
  for (int r = 0; r < 16; r++) { o[0][r] = 0.f; o[1][r] = 0.f; }
  float m = -1e30f, l = 0.f;
  const int kr0 = tid / 12, kc0 = (tid % 12) * 8;
  const int kr1 = (tid + 256) / 12, kc1 = ((tid + 256) % 12) * 8;
  const int kr2 = (tid + 512) / 12, kc2 = ((tid + 512) % 12) * 8;
  const int vr0 = tid >> 3, vc0 = (tid & 7) * 8;
  const int vr1 = (tid + 256) >> 3, vc1 = vc0;
  const int ko0 = kr0 * KS_STRIDE + kc0, ko1 = kr1 * KS_STRIDE + kc1, ko2 = kr2 * KS_STRIDE + kc2;
  const int vo0 = 64 * KS_STRIDE + vr0 * VS_STRIDE + vc0, vo1 = 64 * KS_STRIDE + vr1 * VS_STRIDE + vc1;
  const bf16_t* kg0 = Kp + (size_t)kr0 * 96 + kc0;
  const bf16_t* kg1 = Kp + (size_t)kr1 * 96 + kc1;
  const bf16_t* kg2 = Kp + (size_t)kr2 * 96 + kc2;
  const bf16_t* vg0 = Vp + (size_t)vr0 * S + vc0;
  const bf16_t* vg1 = Vp + (size_t)vr1 * S + vc1;
  uint4 rk0 = *(const uint4*)kg0, rk1 = *(const uint4*)kg1, rk2 = *(const uint4*)kg2;
  uint4 rv0 = *(const uint4*)vg0, rv1 = *(const uint4*)vg1;
  __syncthreads();
  *(uint4*)(sm + ko0) = rk0; *(uint4*)(sm + ko1) = rk1; *(uint4*)(sm + ko2) = rk2;
  *(uint4*)(sm + vo0) = rv0; *(uint4*)(sm + vo1) = rv1;
  __syncthreads();
  const int nt = S >> 6;
  for (int kt = 0; kt < nt; ++kt) {
    const bf16_t* Ks = sm + (kt & 1) * ATT_BUF;
    const bf16_t* Vs = Ks + 64 * KS_STRIDE;
    if (kt + 1 < nt) {
      const size_t k0 = (size_t)(kt + 1) * 64;
      rk0 = *(const uint4*)(kg0 + k0 * 96); rk1 = *(const uint4*)(kg1 + k0 * 96); rk2 = *(const uint4*)(kg2 + k0 * 96);
      rv0 = *(const uint4*)(vg0 + k0); rv1 = *(const uint4*)(vg1 + k0);
    }
    f32x16 s[2];
#pragma unroll
    for (int sub = 0; sub < 2; sub++) {
#pragma unroll
      for (int r = 0; r < 16; r++) s[sub][r] = 0.f;
#pragma unroll
      for (int kk = 0; kk < 6; kk++) {
        bf16x8 kf = *(const bf16x8*)(Ks + (sub * 32 + l31) * KS_STRIDE + kk * 16 + hh * 8);
        s[sub] = __builtin_amdgcn_mfma_f32_32x32x16_bf16(kf, qf[kk], s[sub], 0, 0, 0);
      }
    }
    float mx = s[0][0];
#pragma unroll
    for (int r = 0; r < 16; r++) { mx = fmaxf(mx, s[0][r]); mx = fmaxf(mx, s[1][r]); }
    mx = fmaxf(mx, __shfl_xor(mx, 32));
    const float mn = fmaxf(m, mx);
    const float alpha = exp2f(m - mn);
    m = mn;
    float ps = 0.f;
#pragma unroll
    for (int sub = 0; sub < 2; sub++)
#pragma unroll
      for (int r = 0; r < 16; r++) { float pv = exp2f(s[sub][r] - mn); ps += pv; s[sub][r] = pv; }
    l = l * alpha + ps;
#pragma unroll
    for (int r = 0; r < 16; r++) { o[0][r] *= alpha; o[1][r] *= alpha; }
#pragma unroll
    for (int sub = 0; sub < 2; sub++)
#pragma unroll
      for (int st = 0; st < 2; st++) {
        union { bf16x8 v; unsigned u[4]; } pf;
#pragma unroll
        for (int j = 0; j < 4; j++) pf.u[j] = pack2(s[sub][8 * st + 2 * j], s[sub][8 * st + 2 * j + 1]);
#pragma unroll
        for (int dvt = 0; dvt < 2; dvt++) {
          const bf16_t* vp = Vs + (dvt * 32 + l31) * VS_STRIDE + sub * 32 + 16 * st + 4 * hh;
          union { bf16x8 v; uint2 u[2]; } vf;
          vf.u[0] = *(const uint2*)(vp);
          vf.u[1] = *(const uint2*)(vp + 8);
          o[dvt] = __builtin_amdgcn_mfma_f32_32x32x16_bf16(vf.v, pf.v, o[dvt], 0, 0, 0);
        }
      }
    if (kt + 1 < nt) {
      bf16_t* nK = sm + ((kt + 1) & 1) * ATT_BUF;
      *(uint4*)(nK + ko0) = rk0; *(uint4*)(nK + ko1) = rk1; *(uint4*)(nK + ko2) = rk2;
      *(uint4*)(nK + vo0) = rv0; *(uint4*)(nK + vo1) = rv1;
    }
    __syncthreads();
  }
  const float lt = l + __shfl_xor(l, 32);
  const float inv = 1.f / lt;
  const size_t trow = (size_t)(s0 + qt * 128 + w * 32 + l31);
#pragma unroll
  for (int dvt = 0; dvt < 2; dvt++)
#pragma unroll
    for (int rg = 0; rg < 4; rg++) {
      const int dv = dvt * 32 + 8 * rg + 4 * hh;
      uint2 pk = make_uint2(pack2(o[dvt][rg * 4 + 0] * inv, o[dvt][rg * 4 + 1] * inv), pack2(o[dvt][rg * 4 + 2] * inv, o[dvt][rg * 4 + 3] * inv));
      *(uint2*)(Z1 + trow * 1024 + h * 64 + dv) = pk;
    }
}

__device__ __forceinline__ void phase_attn_scan3(const Params& p, bf16_t* sm) {
  __shared__ int s_item;
  int* cnt = (int*)(p.ws + OFF_CNT);
  const int tid = threadIdx.x;
  for (int dq = 0; dq < 8; ++dq) {
    const int q = (blockIdx.x + dq) & 7;
    while (true) {
      __syncthreads();
      if (tid == 0) s_item = atomicAdd(&cnt[q], 1);
      __syncthreads();
      const int it = s_item;
      if (it >= 512) break;
      int seq, h, qt;
      if (it < 256) { const int pair = q + 8 * (it >> 7); seq = pair >> 3; h = pair & 7; qt = it & 127; }
      else { const int j = it - 256; const int pair = q + 8 * (j >> 5); seq = 2 + (pair >> 3); h = pair & 7; qt = j & 31; }
      attn_item(p, seq, h, qt, sm);
    }
  }
  while (true) {
    __syncthreads();
    if (tid == 0) s_item = atomicAdd(&cnt[8], 1);
    __syncthreads();
    const int it = s_item;
    if (it >= 1024) break;
    scan3_item(p, it);
  }
}

__device__ __forceinline__ void phase_gres(const Params& p, const bf16_t* A, const bf16_t* W, int layer, bool res_from_input, bf16_t* sm) {
  const int lane = threadIdx.x & 63, wave = threadIdx.x >> 6, wm = wave >> 1, wn = wave & 1;
  const float* mod = (const float*)(p.ws + OFF_MOD);
  for (int it = blockIdx.x; it < 512 * 8; it += gridDim.x) {
    const int mt = it >> 3, nt = it & 7;
    f32x16 acc[2][2];
    gemm_tile(A + (size_t)mt * 128 * 1024, 1024, W + (size_t)nt * 128 * 1024, 1024, 1024, acc, sm);
    SeqInfo si = seq_of(mt * 128);
    const float* g1 = mod + (layer * 10 + si.b) * 6144 + 2 * 1024;
#pragma unroll
    for (int ni = 0; ni < 2; ni++) {
      const int col = nt * 128 + EPI_COL(wn, ni, lane);
      const float gg = g1[col];
#pragma unroll
      for (int mi = 0; mi < 2; mi++)
#pragma unroll
        for (int r = 0; r < 16; r++) {
          const int row = mt * 128 + EPI_ROW(wm, mi, r, lane);
          const float xr = res_from_input ? xin_row(p, row)[col] : p.out[(size_t)row * 1024 + col];
          p.out[(size_t)row * 1024 + col] = xr + gg * acc[mi][ni][r];
        }
    }
  }
}

__device__ __forceinline__ void phase_pq(const Params& p, int layer, bf16_t* sm) {
  const int lane = threadIdx.x & 63, wave = threadIdx.x >> 6, wm = wave >> 1, wn = wave & 1;
  const bf16_t* H = (const bf16_t*)(p.ws + OFF_H);
  const bf16_t* W = (const bf16_t*)(p.ws + OFF_WPQ) + (size_t)layer * 2048 * 1024;
  bf16_t* PQ = (bf16_t*)(p.ws + OFF_R1);
  for (int it = blockIdx.x; it < 512 * 16; it += gridDim.x) {
    const int mt = it >> 4, nt = it & 15;
    f32x16 acc[2][2];
    gemm_tile(H + (size_t)mt * 128 * 1024, 1024, W + (size_t)nt * 128 * 1024, 1024, 1024, acc, sm);
#pragma unroll
    for (int mi = 0; mi < 2; mi++)
#pragma unroll
      for (int ni = 0; ni < 2; ni++) {
        const int col = nt * 128 + EPI_COL(wn, ni, lane);
#pragma unroll
        for (int r = 0; r < 16; r++) {
          const int row = mt * 128 + EPI_ROW(wm, mi, r, lane);
          PQ[(size_t)row * 2048 + col] = f2bf(acc[mi][ni][r]);
        }
      }
  }
}

#define TK_INSERT(v, ix, xv, xi)                                  \
  {                                                               \
    float cx_ = (xv); int ci_ = (xi);                             \
    _Pragma("unroll") for (int k_ = 0; k_ < 16; k_++) {           \
      const bool gt_ = cx_ > v[k_];                               \
      const float tv_ = gt_ ? v[k_] : cx_;                        \
      const int ti_ = gt_ ? ix[k_] : ci_;                         \
      v[k_] = gt_ ? cx_ : v[k_];                                  \
      ix[k_] = gt_ ? ci_ : ix[k_];                                \
      cx_ = tv_; ci_ = ti_;                                       \
    }                                                             \
  }

__device__ __forceinline__ void phase_topk(const Params& p, int layer, bf16_t* sm) {
  const int tid = threadIdx.x, lane = tid & 63, wave = tid >> 6, wm = wave >> 1, wn = wave & 1;
  const bf16_t* PQ = (const bf16_t*)(p.ws + OFF_R1);
  const bf16_t* KEYS = (const bf16_t*)(p.ws + OFF_KEYS) + (size_t)layer * 2 * 16384;
  int* IDX = (int*)(p.ws + OFF_IDX);
  float* GW = (float*)(p.ws + OFF_GW);
  float* sc = (float*)sm;
  for (int it = blockIdx.x; it < 512 * 8; it += gridDim.x) {
    const int mt = it >> 3, h = it & 7;
    float v1[16], v2[16]; int i1[16], i2[16];
#pragma unroll
    for (int k = 0; k < 16; k++) { v1[k] = -3.0e38f; v2[k] = -3.0e38f; i1[k] = 0; i2[k] = 0; }
#pragma unroll
    for (int pp = 0; pp < 2; pp++) {
      f32x16 acc[2][2];
      gemm_tile(PQ + (size_t)mt * 128 * 2048 + h * 256 + pp * 128, 2048, KEYS + pp * 16384, 128, 128, acc, sm);
#pragma unroll
      for (int mi = 0; mi < 2; mi++)
#pragma unroll
        for (int ni = 0; ni < 2; ni++)
#pragma unroll
          for (int r = 0; r < 16; r++)
            sc[EPI_ROW(wm, mi, r, lane) * 129 + EPI_COL(wn, ni, lane)] = acc[mi][ni][r];
      __syncthreads();
      if (tid < 128) {
        const float* rowp = sc + tid * 129;
        if (pp == 0) { for (int j = 0; j < 128; j++) { const float x = rowp[j]; TK_INSERT(v1, i1, x, j); } }
        else { for (int j = 0; j < 128; j++) { const float x = rowp[j]; TK_INSERT(v2, i2, x, j); } }
      }
      __syncthreads();
    }
    if (tid < 128) {
      float fv[16]; int fi[16];
#pragma unroll
      for (int k = 0; k < 16; k++) { fv[k] = -3.0e38f; fi[k] = 0; }
#pragma unroll
      for (int a = 0; a < 16; a++)
#pragma unroll
        for (int b = 0; b < 16; b++)
          if ((a + 1) * (b + 1) <= 16) { TK_INSERT(fv, fi, v1[a] + v2[b], i1[a] * 128 + i2[b]); }
      float e[16], se = 0.f;
#pragma unroll
      for (int k = 0; k < 16; k++) { e[k] = __expf(fv[k] - fv[0]); se += e[k]; }
      const float inv = 1.f / se;
      const size_t o = ((size_t)(mt * 128 + tid)) * 128 + h * 16;
#pragma unroll
      for (int k = 0; k < 4; k++) {
        *(int4*)(IDX + o + k * 4) = make_int4(fi[k * 4], fi[k * 4 + 1], fi[k * 4 + 2], fi[k * 4 + 3]);
        *(float4*)(GW + o + k * 4) = make_float4(e[k * 4] * inv, e[k * 4 + 1] * inv, e[k * 4 + 2] * inv, e[k * 4 + 3] * inv);
      }
    }
  }
}

__device__ __forceinline__ float dot16_fp8(uint4 u, const f32x2* hf) {
  f32x2 a = __builtin_amdgcn_cvt_pk_f32_fp8((int)u.x, false) * hf[0];
  a += __builtin_amdgcn_cvt_pk_f32_fp8((int)u.x, true) * hf[1];
  a += __builtin_amdgcn_cvt_pk_f32_fp8((int)u.y, false) * hf[2];
  a += __builtin_amdgcn_cvt_pk_f32_fp8((int)u.y, true) * hf[3];
  a += __builtin_amdgcn_cvt_pk_f32_fp8((int)u.z, false) * hf[4];
  a += __builtin_amdgcn_cvt_pk_f32_fp8((int)u.z, true) * hf[5];
  a += __builtin_amdgcn_cvt_pk_f32_fp8((int)u.w, false) * hf[6];
  a += __builtin_amdgcn_cvt_pk_f32_fp8((int)u.w, true) * hf[7];
  return a.x + a.y;
}
__device__ __forceinline__ void fma16_fp8(f32x2* o, uint4 u, float a) {
  f32x2 aa = {a, a};
  o[0] += __builtin_amdgcn_cvt_pk_f32_fp8((int)u.x, false) * aa;
  o[1] += __builtin_amdgcn_cvt_pk_f32_fp8((int)u.x, true) * aa;
  o[2] += __builtin_amdgcn_cvt_pk_f32_fp8((int)u.y, false) * aa;
  o[3] += __builtin_amdgcn_cvt_pk_f32_fp8((int)u.y, true) * aa;
  o[4] += __builtin_amdgcn_cvt_pk_f32_fp8((int)u.z, false) * aa;
  o[5] += __builtin_amdgcn_cvt_pk_f32_fp8((int)u.z, true) * aa;
  o[6] += __builtin_amdgcn_cvt_pk_f32_fp8((int)u.w, false) * aa;
  o[7] += __builtin_amdgcn_cvt_pk_f32_fp8((int)u.w, true) * aa;
}
__device__ __forceinline__ void phase_gather(const Params& p, int layer) {
  const int lane = threadIdx.x & 63;
  const int gw = (blockIdx.x * 256 + threadIdx.x) >> 6, nw = gridDim.x * 4;
  const bf16_t* H = (const bf16_t*)(p.ws + OFF_H);
  const unsigned char* UT = (const unsigned char*)(p.ws + OFF_UT);
  const unsigned char* VT = (const unsigned char*)(p.ws + OFF_VTAB);
  const int* IDX = (const int*)(p.ws + OFF_IDX);
  const float* GW = (const float*)(p.ws + OFF_GW);
  const float* mod = (const float*)(p.ws + OFF_MOD);
  const bool b5 = (lane & 32) != 0, b4 = (lane & 16) != 0, b3 = (lane & 8) != 0;
  for (int t = gw; t < T_TOK; t += nw) {
    f32x2 hf[8];
    {
      uint4 h0 = *(const uint4*)(H + (size_t)t * 1024 + lane * 16);
      uint4 h1 = *(const uint4*)(H + (size_t)t * 1024 + lane * 16 + 8);
      hf[0] = f32x2{lo2f(h0.x), hi2f(h0.x)}; hf[1] = f32x2{lo2f(h0.y), hi2f(h0.y)};
      hf[2] = f32x2{lo2f(h0.z), hi2f(h0.z)}; hf[3] = f32x2{lo2f(h0.w), hi2f(h0.w)};
      hf[4] = f32x2{lo2f(h1.x), hi2f(h1.x)}; hf[5] = f32x2{lo2f(h1.y), hi2f(h1.y)};
      hf[6] = f32x2{lo2f(h1.z), hi2f(h1.z)}; hf[7] = f32x2{lo2f(h1.w), hi2f(h1.w)};
    }
    const int id0 = IDX[(size_t)t * 128 + lane], id1 = IDX[(size_t)t * 128 + 64 + lane];
    const float g0 = GW[(size_t)t * 128 + lane], g1 = GW[(size_t)t * 128 + 64 + lane];
    f32x2 o[8];
#pragma unroll
    for (int j = 0; j < 8; j++) o[j] = f32x2{0.f, 0.f};
    for (int grp = 0; grp < 16; grp++) {
      const int idv = grp < 8 ? id0 : id1;
      const float gv = grp < 8 ? g0 : g1;
      const int lbase = (grp & 7) * 8;
      int ex[8];
      uint4 ua[8], va[8];
#pragma unroll
      for (int e = 0; e < 8; e++) {
        ex[e] = __builtin_amdgcn_readlane(idv, lbase + e);
        ua[e] = *(const uint4*)(UT + (size_t)ex[e] * 1024 + lane * 16);
      }
#pragma unroll
      for (int e = 0; e < 8; e++) va[e] = *(const uint4*)(VT + (size_t)ex[e] * 1024 + lane * 16);
      float d[8];
#pragma unroll
      for (int e = 0; e < 8; e++) d[e] = dot16_fp8(ua[e], hf);
      float e4[4], e2[2], e1;
#pragma unroll
      for (int i = 0; i < 4; i++) {
        const float snd = b5 ? d[i] : d[i + 4];
        const float kp = b5 ? d[i + 4] : d[i];
        e4[i] = kp + __shfl_xor(snd, 32);
      }
#pragma unroll
      for (int i = 0; i < 2; i++) {
        const float snd = b4 ? e4[i] : e4[i + 2];
        const float kp = b4 ? e4[i + 2] : e4[i];
        e2[i] = kp + __shfl_xor(snd, 16);
      }
      {
        const float snd = b3 ? e2[0] : e2[1];
        const float kp = b3 ? e2[1] : e2[0];
        e1 = kp + __shfl_xor(snd, 8);
      }
      e1 += __shfl_xor(e1, 4);
      e1 += __shfl_xor(e1, 2);
      e1 += __shfl_xor(e1, 1);
      const float gE = __shfl(gv, lbase + (lane >> 3));
      const float mine = gelu_t(e1 * (1.f / U_SCALE)) * gE * (1.f / V_SCALE);
#pragma unroll
      for (int e = 0; e < 8; e++) {
        const float ae = __int_as_float(__builtin_amdgcn_readlane(__float_as_int(mine), e * 8));
        fma16_fp8(o, va[e], ae);
      }
    }
    SeqInfo si = seq_of(t);
    const float* g2 = mod + (layer * 10 + si.b) * 6144 + 5 * 1024;
    float* orow = p.out + (size_t)t * 1024 + lane * 16;
    const float* g2p = g2 + lane * 16;
#pragma unroll
    for (int j = 0; j < 4; j++) {
      float4 xv = *(float4*)(orow + j * 4);
      float4 gg = *(const float4*)(g2p + j * 4);
      xv.x += gg.x * o[2 * j].x; xv.y += gg.y * o[2 * j].y;
      xv.z += gg.z * o[2 * j + 1].x; xv.w += gg.w * o[2 * j + 1].y;
      *(float4*)(orow + j * 4) = xv;
    }
  }
}

__device__ __forceinline__ void phase_g8(const Params& p, bf16_t* sm) {
  const int lane = threadIdx.x & 63, wave = threadIdx.x >> 6, wm = wave >> 1, wn = wave & 1;
  const bf16_t* H = (const bf16_t*)(p.ws + OFF_H);
  const bf16_t* W = (const bf16_t*)(p.ws + OFF_WCIN);
  bf16_t* BG = (bf16_t*)(p.ws + OFF_R1);
  bf16_t* U1 = (bf16_t*)(p.ws + OFF_R1 + 128 * MBY);
  for (int it = blockIdx.x; it < 512 * 24; it += gridDim.x) {
    const int mt = it / 24, nt = it % 24;
    f32x16 acc[2][2];
    gemm_tile(H + (size_t)mt * 128 * 1024, 1024, W + (size_t)nt * 128 * 1024, 1024, 1024, acc, sm);
    if (nt < 8) {
#pragma unroll
      for (int mi = 0; mi < 2; mi++)
#pragma unroll
        for (int ni = 0; ni < 2; ni++) {
          const int col = nt * 128 + EPI_COL(wn, ni, lane);
#pragma unroll
          for (int r = 0; r < 16; r++) {
            const int row = mt * 128 + EPI_ROW(wm, mi, r, lane);
            BG[(size_t)row * 1024 + col] = f2bf(acc[mi][ni][r]);
          }
        }
    } else {
      const int ch = (nt - 8) * 64 + wn * 32 + (lane & 31);
#pragma unroll
      for (int mi = 0; mi < 2; mi++)
#pragma unroll
        for (int r = 0; r < 16; r++) {
          const int row = mt * 128 + EPI_ROW(wm, mi, r, lane);
          U1[(size_t)row * 1024 + ch] = f2bf(acc[mi][0][r] * acc[mi][1][r]);
        }
    }
  }
}

__device__ __forceinline__ void phase_conv1(const Params& p) {
  const int gtid = blockIdx.x * 256 + threadIdx.x, gsz = gridDim.x * 256;
  const bf16_t* BG = (const bf16_t*)(p.ws + OFF_R1);
  const bf16_t* U1 = (const bf16_t*)(p.ws + OFF_R1 + 128 * MBY);
  bf16_t* Y = (bf16_t*)(p.ws + OFF_H);
  const float* cw = p.in[24];
  for (int i = gtid; i < T_TOK * 128; i += gsz) {
    const int t = i >> 7, c = (i & 127) * 8;
    SeqInfo si = seq_of(t);
    float acc[8];
#pragma unroll
    for (int j = 0; j < 8; j++) acc[j] = 0.f;
#pragma unroll
    for (int k = 0; k < 3; k++) {
      const int tt = t + k - 1;
      if (tt >= si.s0 && tt < si.s0 + si.S) {
        uint4 v = *(const uint4*)(U1 + (size_t)tt * 1024 + c);
        const float* w = cw + k * 1024 + c;
        acc[0] += w[0] * lo2f(v.x); acc[1] += w[1] * hi2f(v.x);
        acc[2] += w[2] * lo2f(v.y); acc[3] += w[3] * hi2f(v.y);
        acc[4] += w[4] * lo2f(v.z); acc[5] += w[5] * hi2f(v.z);
        acc[6] += w[6] * lo2f(v.w); acc[7] += w[7] * hi2f(v.w);
      }
    }
    uint4 b = *(const uint4*)(BG + (size_t)t * 1024 + c);
    float bf[8]; unpack8(b, bf);
#pragma unroll
    for (int j = 0; j < 8; j++) acc[j] *= bf[j];
    *(uint4*)(Y + (size_t)t * 1024 + c) = pack8(acc);
  }
}

__global__ void __launch_bounds__(256, 2) mega_fwd(Params p) {
  extern __shared__ __attribute__((aligned(16))) unsigned char smem[];
  cg::grid_group grid = cg::this_grid();
  bf16_t* sm = (bf16_t*)smem;
  unsigned char* ws = p.ws;

  phase_prep(p, smem);
  grid.sync();
  phase_norm(p, 0, 1, true);
  grid.sync();
  phase_g1(p, sm);
  grid.sync();
  phase_conv0(p);
  grid.sync();
  phase_g234(p, sm);
  grid.sync();
  phase_qkprep_scan1(p);
  grid.sync();
  phase_scan2(p);
  grid.sync();
  phase_attn_scan3(p, sm);
  grid.sync();
  phase_gres(p, (const bf16_t*)(ws + OFF_R1), (const bf16_t*)(ws + OFF_WOUT), 0, true, sm);
  grid.sync();
  phase_norm(p, 0, 2, false);
  phase_uvconv(p, 0);
  grid.sync();
  phase_pq(p, 0, sm);
  grid.sync();
  phase_topk(p, 0, sm);
  grid.sync();
  phase_gather(p, 0);
  grid.sync();
  phase_norm(p, 1, 1, false);
  grid.sync();
  phase_g8(p, sm);
  grid.sync();
  phase_conv1(p);
  grid.sync();
  phase_gres(p, (const bf16_t*)(ws + OFF_H), (const bf16_t*)(ws + OFF_WCOUT), 1, false, sm);
  grid.sync();
  phase_norm(p, 1, 2, false);
  phase_uvconv(p, 1);
  grid.sync();
  phase_pq(p, 1, sm);
  grid.sync();
  phase_topk(p, 1, sm);
  grid.sync();
  phase_gather(p, 1);
}

extern "C" void kernel_launch(void* const* d_in, const int* in_sizes, int n_in, void* d_out, int out_size, void* d_ws,
                              size_t ws_size, hipStream_t stream) {
  static int grid_blocks = 0;
  if (grid_blocks == 0) {
    if (n_in != 31 || ws_size < WS_NEED) {
      fprintf(stderr, "kernel_launch: unexpected n_in %d or ws_size %zu (< %zu)\n", n_in, ws_size, (size_t)WS_NEED);
      grid_blocks = -1;
      return;
    }
    int dev = 0, cus = 0, per_cu = 0;
    hipGetDevice(&dev);
    hipDeviceGetAttribute(&cus, hipDeviceAttributeMultiprocessorCount, dev);
    if (hipFuncSetAttribute((const void*)mega_fwd, hipFuncAttributeMaxDynamicSharedMemorySize, LDS_BYTES) != hipSuccess) {
      fprintf(stderr, "kernel_launch: hipFuncSetAttribute failed\n");
      grid_blocks = -1;
      return;
    }
    hipOccupancyMaxActiveBlocksPerMultiprocessor(&per_cu, (const void*)mega_fwd, 256, LDS_BYTES);
    if (per_cu < 1) per_cu = 1;
    if (per_cu > 2) per_cu = 2;
    grid_blocks = cus * per_cu;
    fprintf(stderr, "kernel_launch: cus %d per_cu %d grid %d ws %zu\n", cus, per_cu, grid_blocks, ws_size);
  }
  if (grid_blocks < 0) return;
  Params p{};
  for (int i = 0; i < 31; i++) p.in[i] = (const float*)d_in[i];
  p.out = (float*)d_out;
  p.ws = (unsigned char*)d_ws;
  void* args[] = {&p};
  hipError_t e = hipLaunchCooperativeKernel((const void*)mega_fwd, dim3(grid_blocks), dim3(256), args, LDS_BYTES, stream);
  if (e != hipSuccess) fprintf(stderr, "cooperative launch failed: %s (grid %d)\n", hipGetErrorString(e), grid_blocks);
}
```

```cpp
#include <hip/hip_runtime.h>
#include <hip/hip_cooperative_groups.h>
#include <cstdio>
#include <cstdint>
namespace cg = cooperative_groups;

typedef unsigned short bf16_t;
using bf16x8 = __attribute__((ext_vector_type(8))) short;
using bf16x4 = __attribute__((ext_vector_type(4))) short;
using f32x16 = __attribute__((ext_vector_type(16))) float;

#define T_TOK 65536
#define EPSN 1e-6f

struct Params {
  const float* in[31];
  float* out;
  unsigned char* ws;
};

constexpr size_t MBY = (size_t)1 << 20;
constexpr size_t OFF_WIN = 0;
constexpr size_t OFF_WUQ = OFF_WIN + (size_t)1536 * 1024 * 2;
constexpr size_t OFF_WUKV = OFF_WUQ + (size_t)768 * 256 * 2;
constexpr size_t OFF_WGATE = OFF_WUKV + (size_t)1024 * 128 * 2;
constexpr size_t OFF_WOUT = OFF_WGATE + (size_t)16 * 128 * 64 * 2;
constexpr size_t OFF_WCIN = OFF_WOUT + (size_t)1024 * 1024 * 2;
constexpr size_t OFF_WCOUT = OFF_WCIN + (size_t)3072 * 1024 * 2;
constexpr size_t OFF_WPQ = OFF_WCOUT + (size_t)1024 * 1024 * 2;
constexpr size_t OFF_KEYS = OFF_WPQ + (size_t)2 * 2048 * 1024 * 2;
constexpr size_t OFF_MOD = OFF_KEYS + (size_t)4 * 128 * 128 * 2;
constexpr size_t OFF_C8 = OFF_MOD + (size_t)2 * 10 * 6144 * 4;
constexpr size_t OFF_RSTDQ = OFF_C8 + 4096;
constexpr size_t OFF_RSTDKV = OFF_RSTDQ + (size_t)T_TOK * 4;
constexpr size_t OFF_AGGA = OFF_RSTDKV + (size_t)T_TOK * 4;
constexpr size_t OFF_AGGB = OFF_AGGA + 2 * MBY;
constexpr size_t OFF_CARRY = OFF_AGGB + 2 * MBY;
constexpr size_t OFF_CNT = OFF_CARRY + 2 * MBY;
static_assert(OFF_CNT + 4096 < 40 * MBY, "small region overflow");
constexpr size_t OFF_H = 40 * MBY;
constexpr size_t OFF_R1 = 168 * MBY;
constexpr size_t OFF_Z2 = OFF_R1 + 128 * MBY;
constexpr size_t OFF_XC = OFF_R1 + 180 * MBY;
constexpr size_t OFF_B = 424 * MBY;
constexpr size_t OFF_VT = OFF_B + 96 * MBY;
constexpr size_t OFF_UT = OFF_B;
constexpr size_t OFF_VTAB = OFF_B + 32 * MBY;
constexpr size_t OFF_IDX = OFF_B + 64 * MBY;
constexpr size_t OFF_GW = OFF_B + 96 * MBY;
constexpr size_t WS_NEED = 584 * MBY;

#define LDS_BYTES 73728

__device__ __forceinline__ float bf2f(unsigned short h) { return __uint_as_float(((unsigned)h) << 16); }
__device__ __forceinline__ unsigned short f2bf(float f) {
  unsigned u = __float_as_uint(f);
  u += 0x7fffu + ((u >> 16) & 1u);
  return (unsigned short)(u >> 16);
}
typedef __bf16 hwbf16x2 __attribute__((ext_vector_type(2)));
typedef float f32x2 __attribute__((ext_vector_type(2)));
__device__ __forceinline__ unsigned pack2(float a, float b) {
  f32x2 v = {a, b};
  hwbf16x2 r = __builtin_convertvector(v, hwbf16x2);
  return *(unsigned*)&r;
}
__device__ __forceinline__ float lo2f(unsigned u) { return __uint_as_float(u << 16); }
__device__ __forceinline__ float hi2f(unsigned u) { return __uint_as_float(u & 0xffff0000u); }
__device__ __forceinline__ float fexp2(float x) { return __builtin_amdgcn_exp2f(x); }
__device__ __forceinline__ float frcp(float x) { return __builtin_amdgcn_rcpf(x); }
__device__ __forceinline__ float gelu_t(float x) {
  float u = 0.7978845608f * (x + 0.044715f * x * x * x);
  float t = 1.f - 2.f * frcp(1.f + fexp2(u * 2.8853900817779268f));
  return 0.5f * x * (1.f + t);
}
__device__ __forceinline__ float sigmoid_f(float x) { return frcp(1.f + fexp2(-1.4426950408889634f * x)); }
__device__ __forceinline__ float wave_sum(float v) {
#pragma unroll
  for (int o = 32; o > 0; o >>= 1) v += __shfl_xor(v, o);
  return v;
}
struct SeqInfo { int b, s0, S; };
__device__ __forceinline__ SeqInfo seq_of(int t) {
  SeqInfo r;
  if (t < 32768) { r.b = t >> 14; r.s0 = r.b << 14; r.S = 16384; }
  else { int u = (t - 32768) >> 12; r.b = 2 + u; r.s0 = 32768 + (u << 12); r.S = 4096; }
  return r;
}
__device__ __forceinline__ const float* xin_row(const Params& p, int t) {
  return t < 32768 ? p.in[0] + (size_t)t * 1024 : p.in[1] + (size_t)(t - 32768) * 1024;
}

__device__ __forceinline__ void gemm_tile(const bf16_t* __restrict__ A, int lda, const bf16_t* __restrict__ B, int ldb,
                                          int K, f32x16 (&acc)[2][2], bf16_t* sm) {
  const int tid = threadIdx.x, lane = tid & 63, wave = tid >> 6, wm = wave >> 1, wn = wave & 1;
  const int lr = tid >> 3, lc = (tid & 7) * 8;
  uint4 ra[4], rb[4];
  const bf16_t* Ap = A + (size_t)lr * lda + lc;
  const bf16_t* Bp = B + (size_t)lr * ldb + lc;
#pragma unroll
  for (int i = 0; i < 4; i++) {
    ra[i] = *(const uint4*)(Ap + (size_t)(i * 32) * lda);
    rb[i] = *(const uint4*)(Bp + (size_t)(i * 32) * ldb);
  }
#pragma unroll
  for (int mi = 0; mi < 2; mi++)
#pragma unroll
    for (int ni = 0; ni < 2; ni++)
#pragma unroll
      for (int r = 0; r < 16; r++) acc[mi][ni][r] = 0.f;
  {
    bf16_t* sA = sm; bf16_t* sB = sm + 128 * 72;
#pragma unroll
    for (int i = 0; i < 4; i++) {
      *(uint4*)(sA + (lr + i * 32) * 72 + lc) = ra[i];
      *(uint4*)(sB + (lr + i * 32) * 72 + lc) = rb[i];
    }
  }
  __syncthreads();
  const int nk = K >> 6;
  for (int kt = 0; kt < nk; ++kt) {
    const bf16_t* cA = sm + (kt & 1) * (2 * 128 * 72);
    const bf16_t* cB = cA + 128 * 72;
    if (kt + 1 < nk) {
#pragma unroll
      for (int i = 0; i < 4; i++) {
        ra[i] = *(const uint4*)(Ap + (size_t)(i * 32) * lda + (kt + 1) * 64);
        rb[i] = *(const uint4*)(Bp + (size_t)(i * 32) * ldb + (kt + 1) * 64);
      }
    }
#pragma unroll
    for (int kk = 0; kk < 4; ++kk) {
      bf16x8 a[2], b[2];
#pragma unroll
      for (int mi = 0; mi < 2; mi++)
        a[mi] = *(const bf16x8*)(cA + (wm * 64 + mi * 32 + (lane & 31)) * 72 + kk * 16 + (lane >> 5) * 8);
#pragma unroll
      for (int ni = 0; ni < 2; ni++)
        b[ni] = *(const bf16x8*)(cB + (wn * 64 + ni * 32 + (lane & 31)) * 72 + kk * 16 + (lane >> 5) * 8);
#pragma unroll
      for (int mi = 0; mi < 2; mi++)
#pragma unroll
        for (int ni = 0; ni < 2; ni++)
          acc[mi][ni] = __builtin_amdgcn_mfma_f32_32x32x16_bf16(a[mi], b[ni], acc[mi][ni], 0, 0, 0);
    }
    if (kt + 1 < nk) {
      bf16_t* nA = sm + ((kt + 1) & 1) * (2 * 128 * 72);
      bf16_t* nB = nA + 128 * 72;
#pragma unroll
      for (int i = 0; i < 4; i++) {
        *(uint4*)(nA + (lr + i * 32) * 72 + lc) = ra[i];
        *(uint4*)(nB + (lr + i * 32) * 72 + lc) = rb[i];
      }
    }
    __syncthreads();
  }
}

#define EPI_ROW(wm, mi, r, lane) ((wm) * 64 + (mi) * 32 + 8 * ((r) >> 2) + 4 * ((lane) >> 5) + ((r) & 3))
#define EPI_COL(wn, ni, lane) ((wn) * 64 + (ni) * 32 + ((lane) & 31))

template <class F>
__device__ __forceinline__ void tconv(bf16_t* dst, int N, int K, F src, float* tile) {
  const int tn = N >> 6, tk = K >> 6;
  for (int it = blockIdx.x; it < tn * tk; it += gridDim.x) {
    const int n0 = (it % tn) << 6, k0 = (it / tn) << 6;
    for (int i = threadIdx.x; i < 4096; i += 256) { int kk = i >> 6, nn = i & 63; tile[kk * 65 + nn] = src(k0 + kk, n0 + nn); }
    __syncthreads();
    for (int i = threadIdx.x; i < 4096; i += 256) { int nn = i >> 6, kk = i & 63; dst[(size_t)(n0 + nn) * K + k0 + kk] = f2bf(tile[kk * 65 + nn]); }
    __syncthreads();
  }
}

__device__ __forceinline__ void phase_prep(const Params& p, unsigned char* smem) {
  unsigned char* ws = p.ws;
  float* tile = (float*)smem;
  const int tid = threadIdx.x;
  const int gtid = blockIdx.x * 256 + tid, gsz = gridDim.x * 256;
  {
    const float* w_in = p.in[8];
    tconv((bf16_t*)(ws + OFF_WIN), 1536, 1024, [=](int k, int n) { return n < 1440 ? w_in[(size_t)k * 1440 + n] : 0.f; }, tile);
    const float* w_uq = p.in[17]; const float* qn = p.in[16];
    tconv((bf16_t*)(ws + OFF_WUQ), 768, 256, [=](int k, int n) { return w_uq[k * 768 + n] * qn[k]; }, tile);
    const float* w_ukv = p.in[19]; const float* kvn = p.in[18];
    tconv((bf16_t*)(ws + OFF_WUKV), 1024, 128, [=](int k, int n) { return w_ukv[k * 1024 + n] * kvn[k]; }, tile);
    const float* wa = p.in[11]; const float* wx = p.in[13];
    for (int hd = 0; hd < 16; ++hd) {
      const int h = hd >> 1, d = hd & 1;
      tconv((bf16_t*)(ws + OFF_WGATE) + hd * 128 * 64, 128, 64, [=](int k, int n) {
        int wn = n >> 6, ty = (n >> 5) & 1, j = n & 31; int c = wn * 32 + j;
        const float* W = ty ? wx : wa;
        return W[((d * 8 + h) * 64 + k) * 64 + c]; }, tile);
    }
    const float* w_out = p.in[22];
    tconv((bf16_t*)(ws + OFF_WOUT), 1024, 1024, [=](int k, int n) { return w_out[((k + 512) & 1023) * 1024 + n]; }, tile);
    const float* c_w_in = p.in[23];
    tconv((bf16_t*)(ws + OFF_WCIN), 3072, 1024, [=](int k, int n) {
      int col;
      if (n < 1024) col = n;
      else { int q = n - 1024; int tl = q >> 7, wi = q & 127; int wn = wi >> 6, ty = (wi >> 5) & 1, j = wi & 31; col = 1024 + ty * 1024 + tl * 64 + wn * 32 + j; }
      return c_w_in[(size_t)k * 3072 + col]; }, tile);
    const float* c_w_out = p.in[25];
    tconv((bf16_t*)(ws + OFF_WCOUT), 1024, 1024, [=](int k, int n) { return c_w_out[k * 1024 + n]; }, tile);
    const float* wq = p.in[26];
    for (int l = 0; l < 2; ++l)
      tconv((bf16_t*)(ws + OFF_WPQ) + (size_t)l * 2048 * 1024, 2048, 1024, [=](int k, int n) { return wq[((size_t)(l * 1024 + k)) * 2048 + n]; }, tile);
  }
  {
    bf16_t* keys = (bf16_t*)(ws + OFF_KEYS);
    const float* k1 = p.in[27]; const float* k2 = p.in[28];
    for (int i = gtid; i < 65536; i += gsz) {
      int l = i >> 15, pp = (i >> 14) & 1, r = i & 16383;
      keys[i] = f2bf((pp ? k2 : k1)[l * 16384 + r]);
    }
    float* c8 = (float*)(ws + OFF_C8);
    const float* lam = p.in[15];
    for (int i = gtid; i < 1024; i += gsz) c8[i] = 8.f * log1pf(__expf(-lam[i])) * 1.44269504f;
    if (gtid < 16) ((int*)(ws + OFF_CNT))[gtid] = 0;
  }
  {
    float* silu_s = (float*)smem;
    float* red = silu_s + 10240;
    float* mod = (float*)(ws + OFF_MOD);
    const float* cp = p.in[2]; const float* cs = p.in[3];
    const float* ada_w = p.in[4]; const float* ada_b = p.in[5];
    __syncthreads();
    for (int i = tid; i < 10240; i += 256) {
      int b = i >> 10, k = i & 1023;
      float c = b < 2 ? cp[b * 1024 + k] : cs[(b - 2) * 1024 + k];
      silu_s[i] = c / (1.f + __expf(-c));
    }
    __syncthreads();
    for (int it = blockIdx.x; it < 192; it += gridDim.x) {
      const int l = it / 96, n = (it % 96) * 64 + (tid & 63), kq = tid >> 6;
      float acc[10];
#pragma unroll
      for (int b = 0; b < 10; b++) acc[b] = 0.f;
      for (int k = kq * 256; k < kq * 256 + 256; ++k) {
        float w = ada_w[((size_t)(l * 1024 + k)) * 6144 + n];
#pragma unroll
        for (int b = 0; b < 10; b++) acc[b] += silu_s[b * 1024 + k] * w;
      }
#pragma unroll
      for (int b = 0; b < 10; b++) red[(kq * 10 + b) * 64 + (tid & 63)] = acc[b];
      __syncthreads();
      if (tid < 64) {
#pragma unroll
        for (int b = 0; b < 10; b++)
          mod[(l * 10 + b) * 6144 + n] = ada_b[l * 6144 + n] + red[(0 * 10 + b) * 64 + tid] + red[(1 * 10 + b) * 64 + tid] +
                                         red[(2 * 10 + b) * 64 + tid] + red[(3 * 10 + b) * 64 + tid];
      }
      __syncthreads();
    }
  }
}

#define U_SCALE 64.f
#define V_SCALE 8.f
__device__ __forceinline__ unsigned pack_fp8x4(float4 a, float sc) {
  int pk = __builtin_amdgcn_cvt_pk_fp8_f32(a.x * sc, a.y * sc, 0, false);
  pk = __builtin_amdgcn_cvt_pk_fp8_f32(a.z * sc, a.w * sc, pk, true);
  return (unsigned)pk;
}
__device__ __forceinline__ void phase_uvconv(const Params& p, int l) {
  const int gtid = blockIdx.x * 256 + threadIdx.x, gsz = gridDim.x * 256;
  const float4* us = (const float4*)(p.in[29] + (size_t)l * 16384 * 1024);
  const float4* vs = (const float4*)(p.in[30] + (size_t)l * 16384 * 1024);
  unsigned* ud = (unsigned*)(p.ws + OFF_UT);
  unsigned* vd = (unsigned*)(p.ws + OFF_VTAB);
  for (int i = gtid; i < 16384 * 256; i += gsz) {
    ud[i] = pack_fp8x4(us[i], U_SCALE);
    vd[i] = pack_fp8x4(vs[i], V_SCALE);
  }
}

__device__ __forceinline__ void phase_norm(const Params& p, int layer, int which, bool from_input) {
  const int lane = threadIdx.x & 63;
  const int gw = (blockIdx.x * 256 + threadIdx.x) >> 6, nw = gridDim.x * 4;
  const float* g = (which == 1 ? p.in[6] : p.in[7]) + layer * 1024;
  const float* mod = (const float*)(p.ws + OFF_MOD);
  bf16_t* H = (bf16_t*)(p.ws + OFF_H);
  for (int t = gw; t < T_TOK; t += nw) {
    SeqInfo si = seq_of(t);
    const float* x = from_input ? xin_row(p, t) : p.out + (size_t)t * 1024;
    const float* md = mod + (layer * 10 + si.b) * 6144 + (which == 1 ? 0 : 3 * 1024);
    float4 v[4];
    float ss = 0.f;
#pragma unroll
    for (int j = 0; j < 4; j++) {
      v[j] = *(const float4*)(x + j * 256 + lane * 4);
      ss += v[j].x * v[j].x + v[j].y * v[j].y + v[j].z * v[j].z + v[j].w * v[j].w;
    }
    ss = wave_sum(ss);
    const float rstd = rsqrtf(ss * (1.f / 1024.f) + EPSN);
#pragma unroll
    for (int j = 0; j < 4; j++) {
      const int idx = j * 256 + lane * 4;
      float4 gg = *(const float4*)(g + idx);
      float4 sh = *(const float4*)(md + idx);
      float4 sc = *(const float4*)(md + 1024 + idx);
      float y0 = v[j].x * rstd * gg.x * (1.f + sc.x) + sh.x;
      float y1 = v[j].y * rstd * gg.y * (1.f + sc.y) + sh.y;
      float y2 = v[j].z * rstd * gg.z * (1.f + sc.z) + sh.z;
      float y3 = v[j].w * rstd * gg.w * (1.f + sc.w) + sh.w;
      *(uint2*)(H + (size_t)t * 1024 + idx) = make_uint2(pack2(y0, y1), pack2(y2, y3));
    }
  }
}

__device__ __forceinline__ void phase_g1(const Params& p, bf16_t* sm) {
  const int lane = threadIdx.x & 63, wave = threadIdx.x >> 6, wm = wave >> 1, wn = wave & 1;
  const bf16_t* H = (const bf16_t*)(p.ws + OFF_H);
  const bf16_t* W = (const bf16_t*)(p.ws + OFF_WIN);
  bf16_t* Z1 = (bf16_t*)(p.ws + OFF_R1);
  bf16_t* Z2 = (bf16_t*)(p.ws + OFF_Z2);
  for (int it = blockIdx.x; it < 512 * 12; it += gridDim.x) {
    const int mt = it / 12, nt = it % 12;
    f32x16 acc[2][2];
    gemm_tile(H + (size_t)mt * 128 * 1024, 1024, W + (size_t)nt * 128 * 1024, 1024, 1024, acc, sm);
#pragma unroll
    for (int mi = 0; mi < 2; mi++)
#pragma unroll
      for (int ni = 0; ni < 2; ni++) {
        const int col = nt * 128 + EPI_COL(wn, ni, lane);
#pragma unroll
        for (int r = 0; r < 16; r++) {
          const int row = mt * 128 + EPI_ROW(wm, mi, r, lane);
          const unsigned short v = f2bf(acc[mi][ni][r]);
          if (col < 1024) Z1[(size_t)row * 1024 + col] = v;
          else if (col < 1440) Z2[(size_t)row * 416 + (col - 1024)] = v;
        }
      }
  }
}

__device__ __forceinline__ void phase_conv0(const Params& p) {
  const int gtid = blockIdx.x * 256 + threadIdx.x, gsz = gridDim.x * 256;
  const bf16_t* Z1 = (const bf16_t*)(p.ws + OFF_R1);
  const bf16_t* Z2 = (const bf16_t*)(p.ws + OFF_Z2);
  bf16_t* XC = (bf16_t*)(p.ws + OFF_XC);
  const float* cw = p.in[9]; const float* cb = p.in[10];
  for (int i = gtid; i < T_TOK * 64; i += gsz) {
    const int t = i >> 6, c = (i & 63) * 8;
    SeqInfo si = seq_of(t);
    float acc[8];
#pragma unroll
    for (int j = 0; j < 8; j++) acc[j] = cb[c + j];
#pragma unroll
    for (int k = 0; k < 4; k++) {
      const int tt = t + k - 2;
      if (tt >= si.s0 && tt < si.s0 + si.S) {
        uint4 v = *(const uint4*)(Z1 + (size_t)tt * 1024 + c);
        const float* w = cw + k * 512 + c;
        acc[0] += w[0] * lo2f(v.x); acc[1] += w[1] * hi2f(v.x);
        acc[2] += w[2] * lo2f(v.y); acc[3] += w[3] * hi2f(v.y);
        acc[4] += w[4] * lo2f(v.z); acc[5] += w[5] * hi2f(v.z);
        acc[6] += w[6] * lo2f(v.w); acc[7] += w[7] * hi2f(v.w);
      }
    }
    *(uint4*)(XC + (size_t)t * 512 + c) = make_uint4(pack2(acc[0], acc[1]), pack2(acc[2], acc[3]), pack2(acc[4], acc[5]), pack2(acc[6], acc[7]));
  }
  const int lane = threadIdx.x & 63;
  const int gw = gtid >> 6, nw = gsz >> 6;
  float* rq = (float*)(p.ws + OFF_RSTDQ);
  float* rkv = (float*)(p.ws + OFF_RSTDKV);
  for (int t = gw; t < T_TOK; t += nw) {
    const bf16_t* z = Z2 + (size_t)t * 416;
    uint2 a = *(const uint2*)(z + lane * 4);
    unsigned b = *(const unsigned*)(z + 256 + lane * 2);
    float ssq = lo2f(a.x) * lo2f(a.x) + hi2f(a.x) * hi2f(a.x) + lo2f(a.y) * lo2f(a.y) + hi2f(a.y) * hi2f(a.y);
    float ssk = lo2f(b) * lo2f(b) + hi2f(b) * hi2f(b);
    ssq = wave_sum(ssq); ssk = wave_sum(ssk);
    if (lane == 0) { rq[t] = rsqrtf(ssq * (1.f / 256.f) + EPSN); rkv[t] = rsqrtf(ssk * (1.f / 128.f) + EPSN); }
  }
}

__device__ __forceinline__ void phase_g234(const Params& p, bf16_t* sm) {
  const int lane = threadIdx.x & 63, wave = threadIdx.x >> 6, wm = wave >> 1, wn = wave & 1;
  const bf16_t* Z2 = (const bf16_t*)(p.ws + OFF_Z2);
  const bf16_t* XC = (const bf16_t*)(p.ws + OFF_XC);
  bf16_t* QR = (bf16_t*)(p.ws + OFF_H);
  bf16_t* Kb = (bf16_t*)(p.ws + OFF_B);
  bf16_t* Vt = (bf16_t*)(p.ws + OFF_VT);
  unsigned* AB = (unsigned*)p.out;
  const float* rq = (const float*)(p.ws + OFF_RSTDQ);
  const float* rkv = (const float*)(p.ws + OFF_RSTDKV);
  const float* c8 = (const float*)(p.ws + OFF_C8);
  for (int it = blockIdx.x; it < 15360; it += gridDim.x) {
    f32x16 acc[2][2];
    if (it < 3072) {
      const int mt = it / 6, nt = it % 6;
      gemm_tile(Z2 + (size_t)mt * 128 * 416, 416, (const bf16_t*)(p.ws + OFF_WUQ) + nt * 128 * 256, 256, 256, acc, sm);
#pragma unroll
      for (int mi = 0; mi < 2; mi++)
#pragma unroll
        for (int r = 0; r < 16; r++) {
          const int row = mt * 128 + EPI_ROW(wm, mi, r, lane);
          const float rs = rq[row];
#pragma unroll
          for (int ni = 0; ni < 2; ni++) {
            const int col = nt * 128 + EPI_COL(wn, ni, lane);
            QR[(size_t)row * 768 + col] = f2bf(acc[mi][ni][r] * rs);
          }
        }
    } else if (it < 7168) {
      const int j = it - 3072;
      const int mt = j >> 3, h = j & 7;
      gemm_tile(Z2 + (size_t)mt * 128 * 416 + 256, 416, (const bf16_t*)(p.ws + OFF_WUKV) + h * 128 * 128, 128, 128, acc, sm);
      SeqInfo si = seq_of(mt * 128);
      if (wn == 0) {
#pragma unroll
        for (int mi = 0; mi < 2; mi++)
#pragma unroll
          for (int r = 0; r < 16; r++) {
            const int row = mt * 128 + EPI_ROW(wm, mi, r, lane);
            const float rs = rkv[row];
            const size_t krow = (size_t)si.s0 * 8 + (size_t)h * si.S + (row - si.s0);
#pragma unroll
            for (int ni = 0; ni < 2; ni++)
              Kb[krow * 96 + ni * 32 + (lane & 31)] = f2bf(acc[mi][ni][r] * rs);
          }
      } else {
        bf16_t* vb = Vt + ((size_t)si.s0 * 8 + (size_t)h * si.S) * 64;
#pragma unroll
        for (int mi = 0; mi < 2; mi++)
#pragma unroll
          for (int rg = 0; rg < 4; rg++) {
            const int t4 = mt * 128 + wm * 64 + mi * 32 + 8 * rg + 4 * (lane >> 5);
            const float r0 = rkv[t4], r1 = rkv[t4 + 1], r2 = rkv[t4 + 2], r3 = rkv[t4 + 3];
#pragma unroll
            for (int ni = 0; ni < 2; ni++) {
              const int dv = ni * 32 + (lane & 31);
              uint2 pk = make_uint2(pack2(acc[mi][ni][rg * 4 + 0] * r0, acc[mi][ni][rg * 4 + 1] * r1),
                                    pack2(acc[mi][ni][rg * 4 + 2] * r2, acc[mi][ni][rg * 4 + 3] * r3));
              *(uint2*)(vb + (size_t)dv * si.S + (t4 - si.s0)) = pk;
            }
          }
      }
    } else {
      const int j = it - 7168;
      const int mt = j >> 4, hd = j & 15, h = hd >> 1, d = hd & 1;
      gemm_tile(XC + (size_t)mt * 128 * 512 + h * 64, 512, (const bf16_t*)(p.ws + OFF_WGATE) + hd * 128 * 64, 64, 64, acc, sm);
      const int c = h * 64 + wn * 32 + (lane & 31);
      const float ba = p.in[12][d * 512 + c], bx = p.in[14][d * 512 + c], cc8 = c8[d * 512 + c];
#pragma unroll
      for (int mi = 0; mi < 2; mi++)
#pragma unroll
        for (int r = 0; r < 16; r++) {
          const int row = mt * 128 + EPI_ROW(wm, mi, r, lane);
          const float rg = sigmoid_f(acc[mi][0][r] + ba);
          const float ig = sigmoid_f(acc[mi][1][r] + bx);
          const float l2a = -rg * cc8;
          const float a2 = fexp2(2.f * l2a);
          const float xv = bf2f(XC[(size_t)row * 512 + c]);
          const float bb = __builtin_amdgcn_sqrtf(fmaxf(1.f - a2, 0.f)) * ig * xv;
          AB[((size_t)d * T_TOK + row) * 512 + c] = pack2(l2a, bb);
        }
    }
  }
}

__device__ __forceinline__ void unpack8(uint4 v, float* f) {
  f[0] = lo2f(v.x); f[1] = hi2f(v.x); f[2] = lo2f(v.y); f[3] = hi2f(v.y);
  f[4] = lo2f(v.z); f[5] = hi2f(v.z); f[6] = lo2f(v.w); f[7] = hi2f(v.w);
}
__device__ __forceinline__ uint4 pack8(const float* f) {
  return make_uint4(pack2(f[0], f[1]), pack2(f[2], f[3]), pack2(f[4], f[5]), pack2(f[6], f[7]));
}
__device__ __forceinline__ float sumsq8(uint4 v) {
  float a0 = lo2f(v.x), a1 = hi2f(v.x), a2 = lo2f(v.y), a3 = hi2f(v.y), a4 = lo2f(v.z), a5 = hi2f(v.z), a6 = lo2f(v.w), a7 = hi2f(v.w);
  return a0 * a0 + a1 * a1 + a2 * a2 + a3 * a3 + a4 * a4 + a5 * a5 + a6 * a6 + a7 * a7;
}
__device__ __forceinline__ void norm_rope96(uint4 (&v)[12], const float* __restrict__ gain, float outscale, const float (&cs)[16], const float (&sn)[16]) {
  float ss = 0.f;
#pragma unroll
  for (int i = 0; i < 12; i++) ss += sumsq8(v[i]);
  const float rstd = rsqrtf(ss * (1.f / 96.f) + EPSN);
#pragma unroll
  for (int i = 0; i < 8; i++) {
    float f[8]; unpack8(v[i], f);
#pragma unroll
    for (int j = 0; j < 8; j++) f[j] = f[j] * rstd * gain[i * 8 + j] * outscale;
    v[i] = pack8(f);
  }
#pragma unroll
  for (int q = 0; q < 2; q++) {
    float f1[8], f2[8]; unpack8(v[8 + q], f1); unpack8(v[10 + q], f2);
#pragma unroll
    for (int j = 0; j < 8; j++) {
      const float r1 = f1[j] * rstd * gain[64 + q * 8 + j];
      const float r2 = f2[j] * rstd * gain[80 + q * 8 + j];
      const float c = cs[q * 8 + j], s = sn[q * 8 + j];
      f1[j] = (r1 * c - r2 * s) * outscale;
      f2[j] = (r2 * c + r1 * s) * outscale;
    }
    v[8 + q] = pack8(f1); v[10 + q] = pack8(f2);
  }
}

#define QSCALE (0.10206207261596575f * 1.4426950408889634f)

__device__ __forceinline__ void phase_qkprep_scan1(const Params& p) {
  const int tid = threadIdx.x;
  bf16_t* QR = (bf16_t*)(p.ws + OFF_H);
  bf16_t* Kb = (bf16_t*)(p.ws + OFF_B);
  const bf16_t* Z2 = (const bf16_t*)(p.ws + OFF_Z2);
  const unsigned* AB = (const unsigned*)p.out;
  float* aggA = (float*)(p.ws + OFF_AGGA);
  float* aggB = (float*)(p.ws + OFF_AGGB);
  for (int it = blockIdx.x; it < 4096; it += gridDim.x) {
    if (it < 2048) {
      const int i = it * 256 + tid;
      const int t = i >> 3, h = i & 7;
      SeqInfo si = seq_of(t);
      const float pos = (float)(t - si.s0);
      float cs[16], sn[16];
#pragma unroll
      for (int k = 0; k < 16; k++) {
        const float inv = exp2f(-(float)k * (13.287712379549449f / 16.f));
        float rev = pos * inv * 0.15915494309189535f;
        rev = rev - floorf(rev);
        cs[k] = __builtin_amdgcn_cosf(rev);
        sn[k] = __builtin_amdgcn_sinf(rev);
      }
      uint4 v[12];
      bf16_t* qp = QR + (size_t)t * 768 + h * 96;
#pragma unroll
      for (int k = 0; k < 12; k++) v[k] = *(const uint4*)(qp + k * 8);
      norm_rope96(v, p.in[20], QSCALE, cs, sn);
#pragma unroll
      for (int k = 0; k < 12; k++) *(uint4*)(qp + k * 8) = v[k];
      bf16_t* kp = Kb + ((size_t)si.s0 * 8 + (size_t)h * si.S + (t - si.s0)) * 96;
#pragma unroll
      for (int k = 0; k < 8; k++) v[k] = *(const uint4*)(kp + k * 8);
#pragma unroll
      for (int k = 0; k < 4; k++) v[8 + k] = *(const uint4*)(Z2 + (size_t)t * 416 + 384 + k * 8);
      norm_rope96(v, p.in[21], 1.f, cs, sn);
#pragma unroll
      for (int k = 0; k < 12; k++) *(uint4*)(kp + k * 8) = v[k];
    } else {
      const int i = (it - 2048) * 256 + tid;
      const int c = i & 511, ch = (i >> 9) & 511, d = i >> 18;
      const unsigned* ab = AB + ((size_t)d * T_TOK + (size_t)ch * 128) * 512 + c;
      float A = 1.f, Bv = 0.f;
      if (d == 0) {
        for (int sb = 0; sb < 128; sb += 16) {
          unsigned u[16];
#pragma unroll
          for (int j = 0; j < 16; j++) u[j] = ab[(size_t)(sb + j) * 512];
#pragma unroll
          for (int j = 0; j < 16; j++) { float a = fexp2(lo2f(u[j])); Bv = a * Bv + hi2f(u[j]); A *= a; }
        }
      } else {
        for (int sb = 112; sb >= 0; sb -= 16) {
          unsigned u[16];
#pragma unroll
          for (int j = 0; j < 16; j++) u[j] = ab[(size_t)(sb + j) * 512];
#pragma unroll
          for (int j = 15; j >= 0; j--) { float a = fexp2(lo2f(u[j])); Bv = a * Bv + hi2f(u[j]); A *= a; }
        }
      }
      aggA[i] = A; aggB[i] = Bv;
    }
  }
}

__device__ __forceinline__ void phase_scan2(const Params& p) {
  const int gtid = blockIdx.x * 256 + threadIdx.x, gsz = gridDim.x * 256;
  const float* aggA = (const float*)(p.ws + OFF_AGGA);
  const float* aggB = (const float*)(p.ws + OFF_AGGB);
  float* carry = (float*)(p.ws + OFF_CARRY);
  for (int i = gtid; i < 10240; i += gsz) {
    const int d = i / 5120, rem = i % 5120, seq = rem >> 9, c = rem & 511;
    const int ch0 = seq < 2 ? seq * 128 : 256 + (seq - 2) * 32;
    const int nch = seq < 2 ? 128 : 32;
    float cr = 0.f;
    const int ob = ((d * 512) + ch0) * 512 + c;
    if (d == 0) {
      for (int jb = 0; jb < nch; jb += 16) {
        float av[16], bv[16];
#pragma unroll
        for (int j = 0; j < 16; j++) { av[j] = aggA[ob + (jb + j) * 512]; bv[j] = aggB[ob + (jb + j) * 512]; }
#pragma unroll
        for (int j = 0; j < 16; j++) { carry[ob + (jb + j) * 512] = cr; cr = av[j] * cr + bv[j]; }
      }
    } else {
      for (int jb = nch - 16; jb >= 0; jb -= 16) {
        float av[16], bv[16];
#pragma unroll
        for (int j = 0; j < 16; j++) { av[j] = aggA[ob + (jb + j) * 512]; bv[j] = aggB[ob + (jb + j) * 512]; }
#pragma unroll
        for (int j = 15; j >= 0; j--) { carry[ob + (jb + j) * 512] = cr; cr = av[j] * cr + bv[j]; }
      }
    }
  }
}

__device__ __forceinline__ void scan3_item(const Params& p, int it) {
  const int i = it * 256 + threadIdx.x;
  const int c = i & 511, ch = i >> 9;
  unsigned* AB = (unsigned*)p.out;
  const float* carry = (const float*)(p.ws + OFF_CARRY);
  bf16_t* Z1 = (bf16_t*)(p.ws + OFF_R1);
  unsigned* abf = AB + ((size_t)ch * 128) * 512 + c;
  unsigned* abb = AB + ((size_t)T_TOK + (size_t)ch * 128) * 512 + c;
  float hst = carry[ch * 512 + c];
  for (int sb = 0; sb < 128; sb += 16) {
    unsigned u[16];
#pragma unroll
    for (int j = 0; j < 16; j++) u[j] = abf[(size_t)(sb + j) * 512];
#pragma unroll
    for (int j = 0; j < 16; j++) { hst = fexp2(lo2f(u[j])) * hst + hi2f(u[j]); u[j] = __float_as_uint(hst); }
#pragma unroll
    for (int j = 0; j < 16; j++) abf[(size_t)(sb + j) * 512] = u[j];
  }
  hst = carry[(512 + ch) * 512 + c];
  bf16_t* zp = Z1 + ((size_t)ch * 128) * 1024 + 512 + c;
  for (int sb = 112; sb >= 0; sb -= 16) {
    unsigned u[16]; float fw[16]; unsigned short yv[16];
#pragma unroll
    for (int j = 0; j < 16; j++) { u[j] = abb[(size_t)(sb + j) * 512]; fw[j] = __uint_as_float(abf[(size_t)(sb + j) * 512]); yv[j] = zp[(size_t)(sb + j) * 1024]; }
#pragma unroll
    for (int j = 15; j >= 0; j--) {
      hst = fexp2(lo2f(u[j])) * hst + hi2f(u[j]);
      const float tot = hst + fw[j];
      yv[j] = f2bf(tot * gelu_t(bf2f(yv[j])));
    }
#pragma unroll
    for (int j = 0; j < 16; j++) zp[(size_t)(sb + j) * 1024] = yv[j];
  }
}

#define KS_STRIDE 104
#define VS_STRIDE 72
#define ATT_BUF (64 * KS_STRIDE + 64 * VS_STRIDE)
__device__ __forceinline__ void attn_item(const Params& p, int seq, int h, int qt, bf16_t* sm) {
  const int tid = threadIdx.x, lane = tid & 63, w = tid >> 6, hh = lane >> 5, l31 = lane & 31;
  int s0, S;
  if (seq < 2) { s0 = seq << 14; S = 16384; } else { s0 = 32768 + ((seq - 2) << 12); S = 4096; }
  const bf16_t* Q = (const bf16_t*)(p.ws + OFF_H) + ((size_t)(s0 + qt * 128)) * 768 + h * 96;
  const bf16_t* Kp = (const bf16_t*)(p.ws + OFF_B) + ((size_t)s0 * 8 + (size_t)h * S) * 96;
  const bf16_t* Vp = (const bf16_t*)(p.ws + OFF_VT) + ((size_t)s0 * 8 + (size_t)h * S) * 64;
  bf16_t* Z1 = (bf16_t*)(p.ws + OFF_R1);
  bf16x8 qf[6];
#pragma unroll
  for (int kk = 0; kk < 6; kk++) qf[kk] = *(const bf16x8*)(Q + (size_t)(w * 32 + l31) * 768 + kk * 16 + hh * 8);
  f32x16 o[2];
#pragma unroll
  for (int r = 0; r < 16; r++) { o[0][r] = 0.f; o[1][r] = 0.f; }
  float m = -1e30f, l = 0.f;
  const int kr0 = tid / 12, kc0 = (tid % 12) * 8;
  const int kr1 = (tid + 256) / 12, kc1 = ((tid + 256) % 12) * 8;
  const int kr2 = (tid + 512) / 12, kc2 = ((tid + 512) % 12) * 8;
  const int vr0 = tid >> 3, vc0 = (tid & 7) * 8;
  const int vr1 = (tid + 256) >> 3, vc1 = vc0;
  const int ko0 = kr0 * KS_STRIDE + kc0, ko1 = kr1 * KS_STRIDE + kc1, ko2 = kr2 * KS_STRIDE + kc2;
  const int vo0 = 64 * KS_STRIDE + vr0 * VS_STRIDE + vc0, vo1 = 64 * KS_STRIDE + vr1 * VS_STRIDE + vc1;
  const bf16_t* kg0 = Kp + (size_t)kr0 * 96 + kc0;
  const bf16_t* kg1 = Kp + (size_t)kr1 * 96 + kc1;
  const bf16_t* kg2 = Kp + (size_t)kr2 * 96 + kc2;
  const bf16_t* vg0 = Vp + (size_t)vr0 * S + vc0;
  const bf16_t* vg1 = Vp + (size_t)vr1 * S + vc1;
  uint4 rk0 = *(const uint4*)kg0, rk1 = *(const uint4*)kg1, rk2 = *(const uint4*)kg2;
  uint4 rv0 = *(const uint4*)vg0, rv1 = *(const uint4*)vg1;
  __syncthreads();
  *(uint4*)(sm + ko0) = rk0; *(uint4*)(sm + ko1) = rk1; *(uint4*)(sm + ko2) = rk2;
  *(uint4*)(sm + vo0) = rv0; *(uint4*)(sm + vo1) = rv1;
  __syncthreads();
  const int nt = S >> 6;
  for (int kt = 0; kt < nt; ++kt) {
    const bf16_t* Ks = sm + (kt & 1) * ATT_BUF;
    const bf16_t* Vs = Ks + 64 * KS_STRIDE;
    if (kt + 1 < nt) {
      const size_t k0 = (size_t)(kt + 1) * 64;
      rk0 = *(const uint4*)(kg0 + k0 * 96); rk1 = *(const uint4*)(kg1 + k0 * 96); rk2 = *(const uint4*)(kg2 + k0 * 96);
      rv0 = *(const uint4*)(vg0 + k0); rv1 = *(const uint4*)(vg1 + k0);
    }
    f32x16 s[2];
#pragma unroll
    for (int sub = 0; sub < 2; sub++) {
#pragma unroll
      for (int r = 0; r < 16; r++) s[sub][r] = 0.f;
#pragma unroll
      for (int kk = 0; kk < 6; kk++) {
        bf16x8 kf = *(const bf16x8*)(Ks + (sub * 32 + l31) * KS_STRIDE + kk * 16 + hh * 8);
        s[sub] = __builtin_amdgcn_mfma_f32_32x32x16_bf16(kf, qf[kk], s[sub], 0, 0, 0);
      }
    }
    float mx = s[0][0];
#pragma unroll
    for (int r = 0; r < 16; r++) { mx = fmaxf(mx, s[0][r]); mx = fmaxf(mx, s[1][r]); }
    mx = fmaxf(mx, __shfl_xor(mx, 32));
    const float mn = fmaxf(m, mx);
    const float alpha = fexp2(m - mn);
    const bool changed = mn > m;
    m = mn;
    float ps = 0.f;
#pragma unroll
    for (int sub = 0; sub < 2; sub++)
#pragma unroll
      for (int r = 0; r < 16; r++) { float pv = fexp2(s[sub][r] - mn); ps += pv; s[sub][r] = pv; }
    l = l * alpha + ps;
    if (__any(changed)) {
#pragma unroll
      for (int r = 0; r < 16; r++) { o[0][r] *= alpha; o[1][r] *= alpha; }
    }
#pragma unroll
    for (int sub = 0; sub < 2; sub++)
#pragma unroll
      for (int st = 0; st < 2; st++) {
        union { bf16x8 v; unsigned u[4]; } pf;
#pragma unroll
        for (int j = 0; j < 4; j++) pf.u[j] = pack2(s[sub][8 * st + 2 * j], s[sub][8 * st + 2 * j + 1]);
#pragma unroll
        for (int dvt = 0; dvt < 2; dvt++) {
          const bf16_t* vp = Vs + (dvt * 32 + l31) * VS_STRIDE + sub * 32 + 16 * st + 4 * hh;
          union { bf16x8 v; uint2 u[2]; } vf;
          vf.u[0] = *(const uint2*)(vp);
          vf.u[1] = *(const uint2*)(vp + 8);
          o[dvt] = __builtin_amdgcn_mfma_f32_32x32x16_bf16(vf.v, pf.v, o[dvt], 0, 0, 0);
        }
      }
    if (kt + 1 < nt) {
      bf16_t* nK = sm + ((kt + 1) & 1) * ATT_BUF;
      *(uint4*)(nK + ko0) = rk0; *(uint4*)(nK + ko1) = rk1; *(uint4*)(nK + ko2) = rk2;
      *(uint4*)(nK + vo0) = rv0; *(uint4*)(nK + vo1) = rv1;
    }
    __syncthreads();
  }
  const float lt = l + __shfl_xor(l, 32);
  const float inv = 1.f / lt;
  const size_t trow = (size_t)(s0 + qt * 128 + w * 32 + l31);
#pragma unroll
  for (int dvt = 0; dvt < 2; dvt++)
#pragma unroll
    for (int rg = 0; rg < 4; rg++) {
      const int dv = dvt * 32 + 8 * rg + 4 * hh;
      uint2 pk = make_uint2(pack2(o[dvt][rg * 4 + 0] * inv, o[dvt][rg * 4 + 1] * inv), pack2(o[dvt][rg * 4 + 2] * inv, o[dvt][rg * 4 + 3] * inv));
      *(uint2*)(Z1 + trow * 1024 + h * 64 + dv) = pk;
    }
}

__device__ __forceinline__ void phase_attn_scan3(const Params& p, bf16_t* sm) {
  __shared__ int s_item;
  int* cnt = (int*)(p.ws + OFF_CNT);
  const int tid = threadIdx.x;
  for (int dq = 0; dq < 8; ++dq) {
    const int q = (blockIdx.x + dq) & 7;
    while (true) {
      __syncthreads();
      if (tid == 0) s_item = atomicAdd(&cnt[q], 1);
      __syncthreads();
      const int it = s_item;
      if (it >= 512) break;
      int seq, h, qt;
      if (it < 256) { const int pair = q + 8 * (it >> 7); seq = pair >> 3; h = pair & 7; qt = it & 127; }
      else { const int j = it - 256; const int pair = q + 8 * (j >> 5); seq = 2 + (pair >> 3); h = pair & 7; qt = j & 31; }
      attn_item(p, seq, h, qt, sm);
    }
  }
  while (true) {
    __syncthreads();
    if (tid == 0) s_item = atomicAdd(&cnt[8], 1);
    __syncthreads();
    const int it = s_item;
    if (it >= 1024) break;
    scan3_item(p, it);
  }
}

__device__ __forceinline__ void phase_gres(const Params& p, const bf16_t* A, const bf16_t* W, int layer, bool res_from_input, bf16_t* sm) {
  const int lane = threadIdx.x & 63, wave = threadIdx.x >> 6, wm = wave >> 1, wn = wave & 1;
  const float* mod = (const float*)(p.ws + OFF_MOD);
  for (int it = blockIdx.x; it < 512 * 8; it += gridDim.x) {
    const int mt = it >> 3, nt = it & 7;
    f32x16 acc[2][2];
    gemm_tile(A + (size_t)mt * 128 * 1024, 1024, W + (size_t)nt * 128 * 1024, 1024, 1024, acc, sm);
    SeqInfo si = seq_of(mt * 128);
    const float* g1 = mod + (layer * 10 + si.b) * 6144 + 2 * 1024;
#pragma unroll
    for (int ni = 0; ni < 2; ni++) {
      const int col = nt * 128 + EPI_COL(wn, ni, lane);
      const float gg = g1[col];
#pragma unroll
      for (int mi = 0; mi < 2; mi++)
#pragma unroll
        for (int r = 0; r < 16; r++) {
          const int row = mt * 128 + EPI_ROW(wm, mi, r, lane);
          const float xr = res_from_input ? xin_row(p, row)[col] : p.out[(size_t)row * 1024 + col];
          p.out[(size_t)row * 1024 + col] = xr + gg * acc[mi][ni][r];
        }
    }
  }
}

__device__ __forceinline__ void phase_pq(const Params& p, int layer, bf16_t* sm) {
  const int lane = threadIdx.x & 63, wave = threadIdx.x >> 6, wm = wave >> 1, wn = wave & 1;
  const bf16_t* H = (const bf16_t*)(p.ws + OFF_H);
  const bf16_t* W = (const bf16_t*)(p.ws + OFF_WPQ) + (size_t)layer * 2048 * 1024;
  bf16_t* PQ = (bf16_t*)(p.ws + OFF_R1);
  for (int it = blockIdx.x; it < 512 * 16; it += gridDim.x) {
    const int mt = it >> 4, nt = it & 15;
    f32x16 acc[2][2];
    gemm_tile(H + (size_t)mt * 128 * 1024, 1024, W + (size_t)nt * 128 * 1024, 1024, 1024, acc, sm);
#pragma unroll
    for (int mi = 0; mi < 2; mi++)
#pragma unroll
      for (int ni = 0; ni < 2; ni++) {
        const int col = nt * 128 + EPI_COL(wn, ni, lane);
#pragma unroll
        for (int r = 0; r < 16; r++) {
          const int row = mt * 128 + EPI_ROW(wm, mi, r, lane);
          PQ[(size_t)row * 2048 + col] = f2bf(acc[mi][ni][r]);
        }
      }
  }
}

#define TK_INSERT(v, ix, xv, xi)                                  \
  {                                                               \
    float cx_ = (xv); int ci_ = (xi);                             \
    _Pragma("unroll") for (int k_ = 0; k_ < 16; k_++) {           \
      const bool gt_ = cx_ > v[k_];                               \
      const float tv_ = gt_ ? v[k_] : cx_;                        \
      const int ti_ = gt_ ? ix[k_] : ci_;                         \
      v[k_] = gt_ ? cx_ : v[k_];                                  \
      ix[k_] = gt_ ? ci_ : ix[k_];                                \
      cx_ = tv_; ci_ = ti_;                                       \
    }                                                             \
  }

__device__ __forceinline__ void phase_topk(const Params& p, int layer, bf16_t* sm) {
  const int tid = threadIdx.x, lane = tid & 63, wave = tid >> 6, wm = wave >> 1, wn = wave & 1;
  const bf16_t* PQ = (const bf16_t*)(p.ws + OFF_R1);
  const bf16_t* KEYS = (const bf16_t*)(p.ws + OFF_KEYS) + (size_t)layer * 2 * 16384;
  int* IDX = (int*)(p.ws + OFF_IDX);
  float* GW = (float*)(p.ws + OFF_GW);
  float* sc = (float*)sm;
  for (int it = blockIdx.x; it < 512 * 8; it += gridDim.x) {
    const int mt = it >> 3, h = it & 7;
    float v1[16], v2[16]; int i1[16], i2[16];
#pragma unroll
    for (int k = 0; k < 16; k++) { v1[k] = -3.0e38f; v2[k] = -3.0e38f; i1[k] = 0; i2[k] = 0; }
#pragma unroll
    for (int pp = 0; pp < 2; pp++) {
      f32x16 acc[2][2];
      gemm_tile(PQ + (size_t)mt * 128 * 2048 + h * 256 + pp * 128, 2048, KEYS + pp * 16384, 128, 128, acc, sm);
#pragma unroll
      for (int mi = 0; mi < 2; mi++)
#pragma unroll
        for (int ni = 0; ni < 2; ni++)
#pragma unroll
          for (int r = 0; r < 16; r++)
            sc[EPI_ROW(wm, mi, r, lane) * 129 + EPI_COL(wn, ni, lane)] = acc[mi][ni][r];
      __syncthreads();
      if (tid < 128) {
        const float* rowp = sc + tid * 129;
        if (pp == 0) { for (int j = 0; j < 128; j++) { const float x = rowp[j]; TK_INSERT(v1, i1, x, j); } }
        else { for (int j = 0; j < 128; j++) { const float x = rowp[j]; TK_INSERT(v2, i2, x, j); } }
      }
      __syncthreads();
    }
    if (tid < 128) {
      float fv[16]; int fi[16];
#pragma unroll
      for (int k = 0; k < 16; k++) { fv[k] = -3.0e38f; fi[k] = 0; }
#pragma unroll
      for (int a = 0; a < 16; a++)
#pragma unroll
        for (int b = 0; b < 16; b++)
          if ((a + 1) * (b + 1) <= 16) { TK_INSERT(fv, fi, v1[a] + v2[b], i1[a] * 128 + i2[b]); }
      float e[16], se = 0.f;
#pragma unroll
      for (int k = 0; k < 16; k++) { e[k] = __expf(fv[k] - fv[0]); se += e[k]; }
      const float inv = 1.f / se;
      const size_t o = ((size_t)(mt * 128 + tid)) * 128 + h * 16;
#pragma unroll
      for (int k = 0; k < 4; k++) {
        *(int4*)(IDX + o + k * 4) = make_int4(fi[k * 4], fi[k * 4 + 1], fi[k * 4 + 2], fi[k * 4 + 3]);
        *(float4*)(GW + o + k * 4) = make_float4(e[k * 4] * inv, e[k * 4 + 1] * inv, e[k * 4 + 2] * inv, e[k * 4 + 3] * inv);
      }
    }
  }
}

__device__ __forceinline__ float dot16_fp8(uint4 u, const f32x2* hf) {
  f32x2 a = __builtin_amdgcn_cvt_pk_f32_fp8((int)u.x, false) * hf[0];
  a += __builtin_amdgcn_cvt_pk_f32_fp8((int)u.x, true) * hf[1];
  a += __builtin_amdgcn_cvt_pk_f32_fp8((int)u.y, false) * hf[2];
  a += __builtin_amdgcn_cvt_pk_f32_fp8((int)u.y, true) * hf[3];
  a += __builtin_amdgcn_cvt_pk_f32_fp8((int)u.z, false) * hf[4];
  a += __builtin_amdgcn_cvt_pk_f32_fp8((int)u.z, true) * hf[5];
  a += __builtin_amdgcn_cvt_pk_f32_fp8((int)u.w, false) * hf[6];
  a += __builtin_amdgcn_cvt_pk_f32_fp8((int)u.w, true) * hf[7];
  return a.x + a.y;
}
__device__ __forceinline__ void fma16_fp8(f32x2* o, uint4 u, float a) {
  f32x2 aa = {a, a};
  o[0] += __builtin_amdgcn_cvt_pk_f32_fp8((int)u.x, false) * aa;
  o[1] += __builtin_amdgcn_cvt_pk_f32_fp8((int)u.x, true) * aa;
  o[2] += __builtin_amdgcn_cvt_pk_f32_fp8((int)u.y, false) * aa;
  o[3] += __builtin_amdgcn_cvt_pk_f32_fp8((int)u.y, true) * aa;
  o[4] += __builtin_amdgcn_cvt_pk_f32_fp8((int)u.z, false) * aa;
  o[5] += __builtin_amdgcn_cvt_pk_f32_fp8((int)u.z, true) * aa;
  o[6] += __builtin_amdgcn_cvt_pk_f32_fp8((int)u.w, false) * aa;
  o[7] += __builtin_amdgcn_cvt_pk_f32_fp8((int)u.w, true) * aa;
}
__device__ __forceinline__ void phase_gather(const Params& p, int layer) {
  const int lane = threadIdx.x & 63;
  const int gw = (blockIdx.x * 256 + threadIdx.x) >> 6, nw = gridDim.x * 4;
  const bf16_t* H = (const bf16_t*)(p.ws + OFF_H);
  const unsigned char* UT = (const unsigned char*)(p.ws + OFF_UT);
  const unsigned char* VT = (const unsigned char*)(p.ws + OFF_VTAB);
  const int* IDX = (const int*)(p.ws + OFF_IDX);
  const float* GW = (const float*)(p.ws + OFF_GW);
  const float* mod = (const float*)(p.ws + OFF_MOD);
  const bool b5 = (lane & 32) != 0, b4 = (lane & 16) != 0, b3 = (lane & 8) != 0;
  for (int t = gw; t < T_TOK; t += nw) {
    f32x2 hf[8];
    {
      uint4 h0 = *(const uint4*)(H + (size_t)t * 1024 + lane * 16);
      uint4 h1 = *(const uint4*)(H + (size_t)t * 1024 + lane * 16 + 8);
      hf[0] = f32x2{lo2f(h0.x), hi2f(h0.x)}; hf[1] = f32x2{lo2f(h0.y), hi2f(h0.y)};
      hf[2] = f32x2{lo2f(h0.z), hi2f(h0.z)}; hf[3] = f32x2{lo2f(h0.w), hi2f(h0.w)};
      hf[4] = f32x2{lo2f(h1.x), hi2f(h1.x)}; hf[5] = f32x2{lo2f(h1.y), hi2f(h1.y)};
      hf[6] = f32x2{lo2f(h1.z), hi2f(h1.z)}; hf[7] = f32x2{lo2f(h1.w), hi2f(h1.w)};
    }
    const int id0 = IDX[(size_t)t * 128 + lane], id1 = IDX[(size_t)t * 128 + 64 + lane];
    const float g0 = GW[(size_t)t * 128 + lane], g1 = GW[(size_t)t * 128 + 64 + lane];
    f32x2 o[8];
#pragma unroll
    for (int j = 0; j < 8; j++) o[j] = f32x2{0.f, 0.f};
    for (int grp = 0; grp < 16; grp++) {
      const int idv = grp < 8 ? id0 : id1;
      const float gv = grp < 8 ? g0 : g1;
      const int lbase = (grp & 7) * 8;
      int ex[8];
      uint4 ua[8], va[8];
#pragma unroll
      for (int e = 0; e < 8; e++) {
        ex[e] = __builtin_amdgcn_readlane(idv, lbase + e);
        ua[e] = *(const uint4*)(UT + (size_t)ex[e] * 1024 + lane * 16);
      }
#pragma unroll
      for (int e = 0; e < 8; e++) va[e] = *(const uint4*)(VT + (size_t)ex[e] * 1024 + lane * 16);
      float d[8];
#pragma unroll
      for (int e = 0; e < 8; e++) d[e] = dot16_fp8(ua[e], hf);
      float e4[4], e2[2], e1;
#pragma unroll
      for (int i = 0; i < 4; i++) {
        const float snd = b5 ? d[i] : d[i + 4];
        const float kp = b5 ? d[i + 4] : d[i];
        e4[i] = kp + __shfl_xor(snd, 32);
      }
#pragma unroll
      for (int i = 0; i < 2; i++) {
        const float snd = b4 ? e4[i] : e4[i + 2];
        const float kp = b4 ? e4[i + 2] : e4[i];
        e2[i] = kp + __shfl_xor(snd, 16);
      }
      {
        const float snd = b3 ? e2[0] : e2[1];
        const float kp = b3 ? e2[1] : e2[0];
        e1 = kp + __shfl_xor(snd, 8);
      }
      e1 += __shfl_xor(e1, 4);
      e1 += __shfl_xor(e1, 2);
      e1 += __shfl_xor(e1, 1);
      const float gE = __shfl(gv, lbase + (lane >> 3));
      const float mine = gelu_t(e1 * (1.f / U_SCALE)) * gE * (1.f / V_SCALE);
#pragma unroll
      for (int e = 0; e < 8; e++) {
        const float ae = __int_as_float(__builtin_amdgcn_readlane(__float_as_int(mine), e * 8));
        fma16_fp8(o, va[e], ae);
      }
    }
    SeqInfo si = seq_of(t);
    const float* g2 = mod + (layer * 10 + si.b) * 6144 + 5 * 1024;
    float* orow = p.out + (size_t)t * 1024 + lane * 16;
    const float* g2p = g2 + lane * 16;
#pragma unroll
    for (int j = 0; j < 4; j++) {
      float4 xv = *(float4*)(orow + j * 4);
      float4 gg = *(const float4*)(g2p + j * 4);
      xv.x += gg.x * o[2 * j].x; xv.y += gg.y * o[2 * j].y;
      xv.z += gg.z * o[2 * j + 1].x; xv.w += gg.w * o[2 * j + 1].y;
      *(float4*)(orow + j * 4) = xv;
    }
  }
}

__device__ __forceinline__ void phase_g8(const Params& p, bf16_t* sm) {
  const int lane = threadIdx.x & 63, wave = threadIdx.x >> 6, wm = wave >> 1, wn = wave & 1;
  const bf16_t* H = (const bf16_t*)(p.ws + OFF_H);
  const bf16_t* W = (const bf16_t*)(p.ws + OFF_WCIN);
  bf16_t* BG = (bf16_t*)(p.ws + OFF_R1);
  bf16_t* U1 = (bf16_t*)(p.ws + OFF_R1 + 128 * MBY);
  for (int it = blockIdx.x; it < 512 * 24; it += gridDim.x) {
    const int mt = it / 24, nt = it % 24;
    f32x16 acc[2][2];
    gemm_tile(H + (size_t)mt * 128 * 1024, 1024, W + (size_t)nt * 128 * 1024, 1024, 1024, acc, sm);
    if (nt < 8) {
#pragma unroll
      for (int mi = 0; mi < 2; mi++)
#pragma unroll
        for (int ni = 0; ni < 2; ni++) {
          const int col = nt * 128 + EPI_COL(wn, ni, lane);
#pragma unroll
          for (int r = 0; r < 16; r++) {
            const int row = mt * 128 + EPI_ROW(wm, mi, r, lane);
            BG[(size_t)row * 1024 + col] = f2bf(acc[mi][ni][r]);
          }
        }
    } else {
      const int ch = (nt - 8) * 64 + wn * 32 + (lane & 31);
#pragma unroll
      for (int mi = 0; mi < 2; mi++)
#pragma unroll
        for (int r = 0; r < 16; r++) {
          const int row = mt * 128 + EPI_ROW(wm, mi, r, lane);
          U1[(size_t)row * 1024 + ch] = f2bf(acc[mi][0][r] * acc[mi][1][r]);
        }
    }
  }
}

__device__ __forceinline__ void phase_conv1(const Params& p) {
  const int gtid = blockIdx.x * 256 + threadIdx.x, gsz = gridDim.x * 256;
  const bf16_t* BG = (const bf16_t*)(p.ws + OFF_R1);
  const bf16_t* U1 = (const bf16_t*)(p.ws + OFF_R1 + 128 * MBY);
  bf16_t* Y = (bf16_t*)(p.ws + OFF_H);
  const float* cw = p.in[24];
  for (int i = gtid; i < T_TOK * 128; i += gsz) {
    const int t = i >> 7, c = (i & 127) * 8;
    SeqInfo si = seq_of(t);
    float acc[8];
#pragma unroll
    for (int j = 0; j < 8; j++) acc[j] = 0.f;
#pragma unroll
    for (int k = 0; k < 3; k++) {
      const int tt = t + k - 1;
      if (tt >= si.s0 && tt < si.s0 + si.S) {
        uint4 v = *(const uint4*)(U1 + (size_t)tt * 1024 + c);
        const float* w = cw + k * 1024 + c;
        acc[0] += w[0] * lo2f(v.x); acc[1] += w[1] * hi2f(v.x);
        acc[2] += w[2] * lo2f(v.y); acc[3] += w[3] * hi2f(v.y);
        acc[4] += w[4] * lo2f(v.z); acc[5] += w[5] * hi2f(v.z);
        acc[6] += w[6] * lo2f(v.w); acc[7] += w[7] * hi2f(v.w);
      }
    }
    uint4 b = *(const uint4*)(BG + (size_t)t * 1024 + c);
    float bf[8]; unpack8(b, bf);
#pragma unroll
    for (int j = 0; j < 8; j++) acc[j] *= bf[j];
    *(uint4*)(Y + (size_t)t * 1024 + c) = pack8(acc);
  }
}

__global__ void __launch_bounds__(256, 2) mega_fwd(Params p) {
  extern __shared__ __attribute__((aligned(16))) unsigned char smem[];
  cg::grid_group grid = cg::this_grid();
  bf16_t* sm = (bf16_t*)smem;
  unsigned char* ws = p.ws;

  phase_prep(p, smem);
  grid.sync();
  phase_norm(p, 0, 1, true);
  grid.sync();
  phase_g1(p, sm);
  grid.sync();
  phase_conv0(p);
  grid.sync();
  phase_g234(p, sm);
  grid.sync();
  phase_qkprep_scan1(p);
  grid.sync();
  phase_scan2(p);
  grid.sync();
  phase_attn_scan3(p, sm);
  grid.sync();
  phase_gres(p, (const bf16_t*)(ws + OFF_R1), (const bf16_t*)(ws + OFF_WOUT), 0, true, sm);
  grid.sync();
  phase_norm(p, 0, 2, false);
  phase_uvconv(p, 0);
  grid.sync();
  phase_pq(p, 0, sm);
  grid.sync();
  phase_topk(p, 0, sm);
  grid.sync();
  phase_gather(p, 0);
  grid.sync();
  phase_norm(p, 1, 1, false);
  grid.sync();
  phase_g8(p, sm);
  grid.sync();
  phase_conv1(p);
  grid.sync();
  phase_gres(p, (const bf16_t*)(ws + OFF_H), (const bf16_t*)(ws + OFF_WCOUT), 1, false, sm);
  grid.sync();
  phase_norm(p, 1, 2, false);
  phase_uvconv(p, 1);
  grid.sync();
  phase_pq(p, 1, sm);
  grid.sync();
  phase_topk(p, 1, sm);
  grid.sync();
  phase_gather(p, 1);
}

extern "C" void kernel_launch(void* const* d_in, const int* in_sizes, int n_in, void* d_out, int out_size, void* d_ws,
                              size_t ws_size, hipStream_t stream) {
  static int grid_blocks = 0;
  if (grid_blocks == 0) {
    if (n_in != 31 || ws_size < WS_NEED) {
      fprintf(stderr, "kernel_launch: unexpected n_in %d or ws_size %zu (< %zu)\n", n_in, ws_size, (size_t)WS_NEED);
      grid_blocks = -1;
      return;
    }
    int dev = 0, cus = 0, per_cu = 0;
    hipGetDevice(&dev);
    hipDeviceGetAttribute(&cus, hipDeviceAttributeMultiprocessorCount, dev);
    if (hipFuncSetAttribute((const void*)mega_fwd, hipFuncAttributeMaxDynamicSharedMemorySize, LDS_BYTES) != hipSuccess) {
      fprintf(stderr, "kernel_launch: hipFuncSetAttribute failed\n");
      grid_blocks = -1;
      return;
    }
    hipOccupancyMaxActiveBlocksPerMultiprocessor(&per_cu, (const void*)mega_fwd, 256, LDS_BYTES);
    if (per_cu < 1) per_cu = 1;
    if (per_cu > 2) per_cu = 2;
    grid_blocks = cus * per_cu;
    fprintf(stderr, "kernel_launch: cus %d per_cu %d grid %d ws %zu\n", cus, per_cu, grid_blocks, ws_size);
  }
  if (grid_blocks < 0) return;
  Params p{};
  for (int i = 0; i < 31; i++) p.in[i] = (const float*)d_in[i];
  p.out = (float*)d_out;
  p.ws = (unsigned char*)d_ws;
  void* args[] = {&p};
  hipError_t e = hipLaunchCooperativeKernel((const void*)mega_fwd, dim3(grid_blocks), dim3(256), args, LDS_BYTES, stream);
  if (e != hipSuccess) fprintf(stderr, "cooperative launch failed: %s (grid %d)\n", hipGetErrorString(e), grid_blocks);
}
```

```cpp
#include <hip/hip_runtime.h>
#include <hip/hip_cooperative_groups.h>
#include <cstdio>
#include <cstdint>
namespace cg = cooperative_groups;

typedef unsigned short bf16_t;
using bf16x8 = __attribute__((ext_vector_type(8))) short;
using bf16x4 = __attribute__((ext_vector_type(4))) short;
using f32x16 = __attribute__((ext_vector_type(16))) float;

#define T_TOK 65536
#define EPSN 1e-6f

struct Params {
  const float* in[31];
  float* out;
  unsigned char* ws;
};

constexpr size_t MBY = (size_t)1 << 20;
constexpr size_t OFF_WIN = 0;
constexpr size_t OFF_WUQ = OFF_WIN + (size_t)1536 * 1024 * 2;
constexpr size_t OFF_WUKV = OFF_WUQ + (size_t)768 * 256 * 2;
constexpr size_t OFF_WGATE = OFF_WUKV + (size_t)1024 * 128 * 2;
constexpr size_t OFF_WOUT = OFF_WGATE + (size_t)16 * 128 * 64 * 2;
constexpr size_t OFF_WCIN = OFF_WOUT + (size_t)1024 * 1024 * 2;
constexpr size_t OFF_WCOUT = OFF_WCIN + (size_t)3072 * 1024 * 2;
constexpr size_t OFF_WPQ = OFF_WCOUT + (size_t)1024 * 1024 * 2;
constexpr size_t OFF_KEYS = OFF_WPQ + (size_t)2 * 2048 * 1024 * 2;
constexpr size_t OFF_MOD = OFF_KEYS + (size_t)4 * 128 * 128 * 2;
constexpr size_t OFF_C8 = OFF_MOD + (size_t)2 * 10 * 6144 * 4;
constexpr size_t OFF_RSTDQ = OFF_C8 + 4096;
constexpr size_t OFF_RSTDKV = OFF_RSTDQ + (size_t)T_TOK * 4;
constexpr size_t OFF_AGGA = OFF_RSTDKV + (size_t)T_TOK * 4;
constexpr size_t OFF_AGGB = OFF_AGGA + 2 * MBY;
constexpr size_t OFF_CARRY = OFF_AGGB + 2 * MBY;
constexpr size_t OFF_CNT = OFF_CARRY + 2 * MBY;
constexpr size_t OFF_BAR = OFF_CNT + 8192;
static_assert(OFF_BAR + 8192 < 40 * MBY, "small region overflow");
constexpr size_t OFF_H = 40 * MBY;
constexpr size_t OFF_R1 = 168 * MBY;
constexpr size_t OFF_Z2 = OFF_R1 + 128 * MBY;
constexpr size_t OFF_XC = OFF_R1 + 180 * MBY;
constexpr size_t OFF_B = 424 * MBY;
constexpr size_t OFF_VT = OFF_B + 96 * MBY;
constexpr size_t OFF_UT = OFF_B;
constexpr size_t OFF_VTAB = OFF_B + 32 * MBY;
constexpr size_t OFF_IDX = OFF_B + 64 * MBY;
constexpr size_t OFF_GW = OFF_B + 96 * MBY;
constexpr size_t WS_NEED = 584 * MBY;

#define LDS_BYTES 73728

__device__ __forceinline__ float bf2f(unsigned short h) { return __uint_as_float(((unsigned)h) << 16); }
__device__ __forceinline__ unsigned short f2bf(float f) {
  unsigned u = __float_as_uint(f);
  u += 0x7fffu + ((u >> 16) & 1u);
  return (unsigned short)(u >> 16);
}
typedef __bf16 hwbf16x2 __attribute__((ext_vector_type(2)));
typedef float f32x2 __attribute__((ext_vector_type(2)));
__device__ __forceinline__ unsigned pack2(float a, float b) {
  f32x2 v = {a, b};
  hwbf16x2 r = __builtin_convertvector(v, hwbf16x2);
  return *(unsigned*)&r;
}
__device__ __forceinline__ float lo2f(unsigned u) { return __uint_as_float(u << 16); }
__device__ __forceinline__ float hi2f(unsigned u) { return __uint_as_float(u & 0xffff0000u); }
__device__ __forceinline__ float fexp2(float x) { return __builtin_amdgcn_exp2f(x); }
__device__ __forceinline__ float frcp(float x) { return __builtin_amdgcn_rcpf(x); }
__device__ __forceinline__ float gelu_t(float x) {
  float u = 0.7978845608f * (x + 0.044715f * x * x * x);
  float t = 1.f - 2.f * frcp(1.f + fexp2(u * 2.8853900817779268f));
  return 0.5f * x * (1.f + t);
}
__device__ __forceinline__ float sigmoid_f(float x) { return frcp(1.f + fexp2(-1.4426950408889634f * x)); }
__device__ __forceinline__ float wave_sum(float v) {
#pragma unroll
  for (int o = 32; o > 0; o >>= 1) v += __shfl_xor(v, o);
  return v;
}
__device__ __forceinline__ int opaque_tid() { int t = threadIdx.x; asm volatile("" : "+v"(t)); return t; }
struct SeqInfo { int b, s0, S; };
__device__ __forceinline__ SeqInfo seq_of(int t) {
  SeqInfo r;
  if (t < 32768) { r.b = t >> 14; r.s0 = r.b << 14; r.S = 16384; }
  else { int u = (t - 32768) >> 12; r.b = 2 + u; r.s0 = 32768 + (u << 12); r.S = 4096; }
  return r;
}
__device__ __forceinline__ const float* xin_row(const Params& p, int t) {
  return t < 32768 ? p.in[0] + (size_t)t * 1024 : p.in[1] + (size_t)(t - 32768) * 1024;
}

#define GT_BUF 16384
__device__ __forceinline__ void gemm_tile(const bf16_t* __restrict__ A, int lda, const bf16_t* __restrict__ B, int ldb,
                                          int K, f32x16 (&acc)[2][2], bf16_t* sm) {
  const int tidx_ = opaque_tid();
  const int tid = tidx_, lane = tid & 63, wave = tid >> 6, wm = wave >> 1, wn = wave & 1;
  const int nk = K >> 6;
  const bf16_t* src = wave < 2 ? A : B;
  const unsigned ld = (unsigned)(wave < 2 ? lda : ldb);
  const int i0 = (wave & 1) * 8;
  char* dbase = (char*)sm + (wave >> 1) * 16384 + i0 * 1024 + lane * 16;
#define GOFF(j_) ({ const unsigned s_ = (unsigned)((i0 + (j_)) * 64 + lane); const unsigned r_ = s_ >> 3; const unsigned c_ = (s_ & 7u) ^ ((r_ >> 1) & 7u); r_ * ld + c_ * 8u; })
  const unsigned g0 = GOFF(0), g1 = GOFF(1), g2 = GOFF(2), g3 = GOFF(3), g4 = GOFF(4), g5 = GOFF(5), g6 = GOFF(6), g7 = GOFF(7);
#undef GOFF
#define DMA1(gj_, j_, sp_, db_) __builtin_amdgcn_global_load_lds((const unsigned*)((sp_) + (gj_)), (unsigned __attribute__((address_space(3)))*)((db_) + (j_) * 1024), 16, 0, 0)
#define DMA_TILE(kt_, buf_)                                                       \
  {                                                                               \
    const bf16_t* sp_ = src + (kt_) * 64;                                         \
    char* db_ = dbase + (buf_) * (GT_BUF * 2);                                    \
    DMA1(g0, 0, sp_, db_); DMA1(g1, 1, sp_, db_); DMA1(g2, 2, sp_, db_);          \
    DMA1(g3, 3, sp_, db_); DMA1(g4, 4, sp_, db_); DMA1(g5, 5, sp_, db_);          \
    DMA1(g6, 6, sp_, db_); DMA1(g7, 7, sp_, db_);                                 \
  }
  DMA_TILE(0, 0);
#pragma unroll
  for (int mi = 0; mi < 2; mi++)
#pragma unroll
    for (int ni = 0; ni < 2; ni++)
#pragma unroll
      for (int r = 0; r < 16; r++) acc[mi][ni][r] = 0.f;
  asm volatile("s_waitcnt vmcnt(0)" ::: "memory");
  __syncthreads();
  const int sw = ((lane & 31) >> 1) & 7, hh = lane >> 5;
  const int arow = (wm * 64 + (lane & 31)) * 64;
  const int brow = 8192 + (wn * 64 + (lane & 31)) * 64;
  for (int kt = 0; kt < nk; ++kt) {
    if (kt + 1 < nk) DMA_TILE(kt + 1, (kt + 1) & 1);
    const bf16_t* cA = sm + (kt & 1) * GT_BUF;
#pragma unroll
    for (int kk = 0; kk < 4; ++kk) {
      const int pc = ((kk * 2 + hh) ^ sw) * 8;
      bf16x8 a[2], b[2];
#pragma unroll
      for (int mi = 0; mi < 2; mi++) a[mi] = *(const bf16x8*)(cA + arow + mi * 32 * 64 + pc);
#pragma unroll
      for (int ni = 0; ni < 2; ni++) b[ni] = *(const bf16x8*)(cA + brow + ni * 32 * 64 + pc);
#pragma unroll
      for (int mi = 0; mi < 2; mi++)
#pragma unroll
        for (int ni = 0; ni < 2; ni++)
          acc[mi][ni] = __builtin_amdgcn_mfma_f32_32x32x16_bf16(a[mi], b[ni], acc[mi][ni], 0, 0, 0);
    }
    asm volatile("s_waitcnt vmcnt(0)" ::: "memory");
    __syncthreads();
  }
#undef DMA1
#undef DMA_TILE
}

#define CS_LD 136
__device__ __forceinline__ void gemm_ldsA_k128(const bf16_t* __restrict__ B, f32x16 (&acc)[2][2], bf16_t* sm) {
  const int tidx_ = opaque_tid();
  const int tid = tidx_, lane = tid & 63, wave = tid >> 6, wm = wave >> 1, wn = wave & 1;
  const int lr = tid >> 3, lc = (tid & 7) * 8;
  const bf16_t* Bp = B + (size_t)lr * 128 + lc;
  bf16_t* sB = sm + 128 * CS_LD;
  uint4 b0 = *(const uint4*)(Bp), b1 = *(const uint4*)(Bp + 32 * 128), b2 = *(const uint4*)(Bp + 64 * 128), b3 = *(const uint4*)(Bp + 96 * 128);
  uint4 c0 = *(const uint4*)(Bp + 64), c1 = *(const uint4*)(Bp + 32 * 128 + 64), c2 = *(const uint4*)(Bp + 64 * 128 + 64), c3 = *(const uint4*)(Bp + 96 * 128 + 64);
  const int so = lr * 72 + lc;
  *(uint4*)(sB + so) = b0; *(uint4*)(sB + so + 32 * 72) = b1; *(uint4*)(sB + so + 64 * 72) = b2; *(uint4*)(sB + so + 96 * 72) = b3;
  *(uint4*)(sB + 128 * 72 + so) = c0; *(uint4*)(sB + 128 * 72 + so + 32 * 72) = c1;
  *(uint4*)(sB + 128 * 72 + so + 64 * 72) = c2; *(uint4*)(sB + 128 * 72 + so + 96 * 72) = c3;
#pragma unroll
  for (int mi = 0; mi < 2; mi++)
#pragma unroll
    for (int ni = 0; ni < 2; ni++)
#pragma unroll
      for (int r = 0; r < 16; r++) acc[mi][ni][r] = 0.f;
  __syncthreads();
  const int aoff = (wm * 64 + (lane & 31)) * CS_LD + (lane >> 5) * 8;
  const int boff = (wn * 64 + (lane & 31)) * 72 + (lane >> 5) * 8;
#pragma unroll
  for (int kt = 0; kt < 2; kt++)
#pragma unroll
    for (int kk = 0; kk < 4; ++kk) {
      bf16x8 a[2], b[2];
#pragma unroll
      for (int mi = 0; mi < 2; mi++) a[mi] = *(const bf16x8*)(sm + aoff + mi * 32 * CS_LD + kt * 64 + kk * 16);
#pragma unroll
      for (int ni = 0; ni < 2; ni++) b[ni] = *(const bf16x8*)(sB + kt * 128 * 72 + boff + ni * 32 * 72 + kk * 16);
#pragma unroll
      for (int mi = 0; mi < 2; mi++)
#pragma unroll
        for (int ni = 0; ni < 2; ni++)
          acc[mi][ni] = __builtin_amdgcn_mfma_f32_32x32x16_bf16(a[mi], b[ni], acc[mi][ni], 0, 0, 0);
    }
  __syncthreads();
}

#define EPI_ROW(wm, mi, r, lane) ((wm) * 64 + (mi) * 32 + 8 * ((r) >> 2) + 4 * ((lane) >> 5) + ((r) & 3))
#define EPI_COL(wn, ni, lane) ((wn) * 64 + (ni) * 32 + ((lane) & 31))

template <class F>
__device__ __forceinline__ void tconv(bf16_t* dst, int N, int K, F src, float* tile, int& rot) {
  const int tidx_ = opaque_tid();
  const int tn = N >> 6, tk = K >> 6;
  int first = (int)blockIdx.x - rot; if (first < 0) first += gridDim.x;
  rot = (rot + tn * tk) % (int)gridDim.x;
  for (int it = first; it < tn * tk; it += gridDim.x) {
    const int n0 = (it % tn) << 6, k0 = (it / tn) << 6;
    for (int i = tidx_; i < 4096; i += 256) { int kk = i >> 6, nn = i & 63; tile[kk * 65 + nn] = src(k0 + kk, n0 + nn); }
    __syncthreads();
    for (int i = tidx_; i < 4096; i += 256) { int nn = i >> 6, kk = i & 63; dst[(size_t)(n0 + nn) * K + k0 + kk] = f2bf(tile[kk * 65 + nn]); }
    __syncthreads();
  }
}

__device__ __forceinline__ void phase_prep(const Params& p, unsigned char* smem) {
  const int tidx_ = opaque_tid();
  unsigned char* ws = p.ws;
  float* tile = (float*)smem;
  int rot = 0;
  const int tid = tidx_;
  const int gtid = blockIdx.x * 256 + tid, gsz = gridDim.x * 256;
  {
    const float* w_in = p.in[8];
    tconv((bf16_t*)(ws + OFF_WIN), 1536, 1024, [=](int k, int n) { return n < 1440 ? w_in[(size_t)k * 1440 + n] : 0.f; }, tile, rot);
    const float* w_uq = p.in[17]; const float* qn = p.in[16];
    tconv((bf16_t*)(ws + OFF_WUQ), 768, 256, [=](int k, int n) { return w_uq[k * 768 + n] * qn[k]; }, tile, rot);
    const float* w_ukv = p.in[19]; const float* kvn = p.in[18];
    tconv((bf16_t*)(ws + OFF_WUKV), 1024, 128, [=](int k, int n) { return w_ukv[k * 1024 + n] * kvn[k]; }, tile, rot);
    const float* wa = p.in[11]; const float* wx = p.in[13];
    for (int hd = 0; hd < 16; ++hd) {
      const int h = hd >> 1, d = hd & 1;
      tconv((bf16_t*)(ws + OFF_WGATE) + hd * 128 * 64, 128, 64, [=](int k, int n) {
        int wn = n >> 6, ty = (n >> 5) & 1, j = n & 31; int c = wn * 32 + j;
        const float* W = ty ? wx : wa;
        return W[((d * 8 + h) * 64 + k) * 64 + c]; }, tile, rot);
    }
    const float* w_out = p.in[22];
    tconv((bf16_t*)(ws + OFF_WOUT), 1024, 1024, [=](int k, int n) { return w_out[((k + 512) & 1023) * 1024 + n]; }, tile, rot);
    const float* c_w_in = p.in[23];
    tconv((bf16_t*)(ws + OFF_WCIN), 3072, 1024, [=](int k, int n) {
      int col;
      if (n < 1024) col = n;
      else { int q = n - 1024; int tl = q >> 7, wi = q & 127; int wn = wi >> 6, ty = (wi >> 5) & 1, j = wi & 31; col = 1024 + ty * 1024 + tl * 64 + wn * 32 + j; }
      return c_w_in[(size_t)k * 3072 + col]; }, tile, rot);
    const float* c_w_out = p.in[25];
    tconv((bf16_t*)(ws + OFF_WCOUT), 1024, 1024, [=](int k, int n) { return c_w_out[k * 1024 + n]; }, tile, rot);
    const float* wq = p.in[26];
    for (int l = 0; l < 2; ++l)
      tconv((bf16_t*)(ws + OFF_WPQ) + (size_t)l * 2048 * 1024, 2048, 1024, [=](int k, int n) { return wq[((size_t)(l * 1024 + k)) * 2048 + n]; }, tile, rot);
  }
  {
    bf16_t* keys = (bf16_t*)(ws + OFF_KEYS);
    const float* k1 = p.in[27]; const float* k2 = p.in[28];
    for (int i = gtid; i < 65536; i += gsz) {
      int l = i >> 15, pp = (i >> 14) & 1, r = i & 16383;
      keys[i] = f2bf((pp ? k2 : k1)[l * 16384 + r]);
    }
    float* c8 = (float*)(ws + OFF_C8);
    const float* lam = p.in[15];
    for (int i = gtid; i < 1024; i += gsz) c8[i] = 8.f * log1pf(__expf(-lam[i])) * 1.44269504f;
    if (gtid < 16) ((int*)(ws + OFF_CNT))[gtid] = 0;
  }
  {
    float* silu_s = (float*)smem;
    float* red = silu_s + 10240;
    float* mod = (float*)(ws + OFF_MOD);
    const float* cp = p.in[2]; const float* cs = p.in[3];
    const float* ada_w = p.in[4]; const float* ada_b = p.in[5];
    __syncthreads();
    for (int i = tid; i < 10240; i += 256) {
      int b = i >> 10, k = i & 1023;
      float c = b < 2 ? cp[b * 1024 + k] : cs[(b - 2) * 1024 + k];
      silu_s[i] = c / (1.f + __expf(-c));
    }
    __syncthreads();
    for (int it = blockIdx.x; it < 192; it += gridDim.x) {
      const int l = it / 96, n = (it % 96) * 64 + (tid & 63), kq = tid >> 6;
      float acc[10];
#pragma unroll
      for (int b = 0; b < 10; b++) acc[b] = 0.f;
#pragma unroll 8
      for (int k = kq * 256; k < kq * 256 + 256; ++k) {
        float w = ada_w[((size_t)(l * 1024 + k)) * 6144 + n];
#pragma unroll
        for (int b = 0; b < 10; b++) acc[b] += silu_s[b * 1024 + k] * w;
      }
#pragma unroll
      for (int b = 0; b < 10; b++) red[(kq * 10 + b) * 64 + (tid & 63)] = acc[b];
      __syncthreads();
      if (tid < 64) {
#pragma unroll
        for (int b = 0; b < 10; b++)
          mod[(l * 10 + b) * 6144 + n] = ada_b[l * 6144 + n] + red[(0 * 10 + b) * 64 + tid] + red[(1 * 10 + b) * 64 + tid] +
                                         red[(2 * 10 + b) * 64 + tid] + red[(3 * 10 + b) * 64 + tid];
      }
      __syncthreads();
    }
  }
}

#define U_SCALE 64.f
#define V_SCALE 8.f
__device__ __forceinline__ unsigned pack_fp8x4(float4 a, float sc) {
  int pk = __builtin_amdgcn_cvt_pk_fp8_f32(a.x * sc, a.y * sc, 0, false);
  pk = __builtin_amdgcn_cvt_pk_fp8_f32(a.z * sc, a.w * sc, pk, true);
  return (unsigned)pk;
}
__device__ __forceinline__ void phase_uvconv(const Params& p, int l) {
  const int tidx_ = opaque_tid();
  const int gtid = blockIdx.x * 256 + tidx_, gsz = gridDim.x * 256;
  const float4* us = (const float4*)(p.in[29] + (size_t)l * 16384 * 1024);
  const float4* vs = (const float4*)(p.in[30] + (size_t)l * 16384 * 1024);
  unsigned* ud = (unsigned*)(p.ws + OFF_UT);
  unsigned* vd = (unsigned*)(p.ws + OFF_VTAB);
  for (int i = gtid; i < 16384 * 256; i += gsz) {
    ud[i] = pack_fp8x4(us[i], U_SCALE);
    vd[i] = pack_fp8x4(vs[i], V_SCALE);
  }
}

__device__ __forceinline__ void phase_norm(const Params& p, int layer, int which, bool from_input) {
  const int tidx_ = opaque_tid();
  const int lane = tidx_ & 63;
  const int gw = (blockIdx.x * 256 + tidx_) >> 6, nw = gridDim.x * 4;
  const float* g = (which == 1 ? p.in[6] : p.in[7]) + layer * 1024;
  const float* mod = (const float*)(p.ws + OFF_MOD);
  bf16_t* H = (bf16_t*)(p.ws + OFF_H);
  for (int t = gw; t < T_TOK; t += nw) {
    SeqInfo si = seq_of(t);
    const float* x = from_input ? xin_row(p, t) : p.out + (size_t)t * 1024;
    const float* md = mod + (layer * 10 + si.b) * 6144 + (which == 1 ? 0 : 3 * 1024);
    float4 v[4];
    float ss = 0.f;
#pragma unroll
    for (int j = 0; j < 4; j++) {
      v[j] = *(const float4*)(x + j * 256 + lane * 4);
      ss += v[j].x * v[j].x + v[j].y * v[j].y + v[j].z * v[j].z + v[j].w * v[j].w;
    }
    ss = wave_sum(ss);
    const float rstd = rsqrtf(ss * (1.f / 1024.f) + EPSN);
#pragma unroll
    for (int j = 0; j < 4; j++) {
      const int idx = j * 256 + lane * 4;
      float4 gg = *(const float4*)(g + idx);
      float4 sh = *(const float4*)(md + idx);
      float4 sc = *(const float4*)(md + 1024 + idx);
      float y0 = v[j].x * rstd * gg.x * (1.f + sc.x) + sh.x;
      float y1 = v[j].y * rstd * gg.y * (1.f + sc.y) + sh.y;
      float y2 = v[j].z * rstd * gg.z * (1.f + sc.z) + sh.z;
      float y3 = v[j].w * rstd * gg.w * (1.f + sc.w) + sh.w;
      *(uint2*)(H + (size_t)t * 1024 + idx) = make_uint2(pack2(y0, y1), pack2(y2, y3));
    }
  }
}

#define XCD_TILE_LOOP(NT_, mt_, nt_)                                                               \
  for (int li_ = (int)(blockIdx.x >> 3), mt_ = 0, nt_ = 0;                                          \
       li_ < 64 * (NT_) && ((mt_ = (li_ / (NT_)) * 8 + (int)(blockIdx.x & 7)), (nt_ = li_ % (NT_)), true); \
       li_ += (int)(gridDim.x >> 3))

__device__ __forceinline__ void tile_copy_out(const bf16_t* cs, bf16_t* dst, size_t ldd, int nchunk_log2) {
  const int tidx_ = opaque_tid();
  const int per_row = 1 << nchunk_log2;
  const int total = 128 << nchunk_log2;
  for (int c = tidx_; c < total; c += 256) {
    const int row = c >> nchunk_log2, cc = c & (per_row - 1);
    const uint4 v = *(const uint4*)(cs + row * CS_LD + cc * 8);
    *(uint4*)(dst + (size_t)row * ldd + cc * 8) = v;
  }
}

__device__ __forceinline__ void phase_g1(const Params& p, bf16_t* sm) {
  const int tidx_ = opaque_tid();
  const int lane = tidx_ & 63, wave = tidx_ >> 6, wm = wave >> 1, wn = wave & 1;
  const bf16_t* H = (const bf16_t*)(p.ws + OFF_H);
  const bf16_t* W = (const bf16_t*)(p.ws + OFF_WIN);
  bf16_t* Z1 = (bf16_t*)(p.ws + OFF_R1);
  bf16_t* Z2 = (bf16_t*)(p.ws + OFF_Z2);
  XCD_TILE_LOOP(12, mt, nt) {
    f32x16 acc[2][2];
    gemm_tile(H + (size_t)mt * 128 * 1024, 1024, W + (size_t)nt * 128 * 1024, 1024, 1024, acc, sm);
#pragma unroll
    for (int mi = 0; mi < 2; mi++)
#pragma unroll
      for (int ni = 0; ni < 2; ni++)
#pragma unroll
        for (int r = 0; r < 16; r++)
          sm[EPI_ROW(wm, mi, r, lane) * CS_LD + EPI_COL(wn, ni, lane)] = f2bf(acc[mi][ni][r]);
    __syncthreads();
    if (nt < 8) tile_copy_out(sm, Z1 + (size_t)mt * 128 * 1024 + nt * 128, 1024, 4);
    else if (nt < 11) tile_copy_out(sm, Z2 + (size_t)mt * 128 * 416 + (nt - 8) * 128, 416, 4);
    else tile_copy_out(sm, Z2 + (size_t)mt * 128 * 416 + 384, 416, 2);
    __syncthreads();
  }
}

__device__ __forceinline__ void phase_conv0(const Params& p) {
  const int tidx_ = opaque_tid();
  const int gtid = blockIdx.x * 256 + tidx_, gsz = gridDim.x * 256;
  const bf16_t* Z1 = (const bf16_t*)(p.ws + OFF_R1);
  const bf16_t* Z2 = (const bf16_t*)(p.ws + OFF_Z2);
  bf16_t* XC = (bf16_t*)(p.ws + OFF_XC);
  const float* cw = p.in[9]; const float* cb = p.in[10];
  for (int i = gtid; i < T_TOK * 64; i += gsz) {
    const int t = i >> 6, c = (i & 63) * 8;
    SeqInfo si = seq_of(t);
    float acc[8];
#pragma unroll
    for (int j = 0; j < 8; j++) acc[j] = cb[c + j];
#pragma unroll
    for (int k = 0; k < 4; k++) {
      const int tt = t + k - 2;
      if (tt >= si.s0 && tt < si.s0 + si.S) {
        uint4 v = *(const uint4*)(Z1 + (size_t)tt * 1024 + c);
        const float* w = cw + k * 512 + c;
        acc[0] += w[0] * lo2f(v.x); acc[1] += w[1] * hi2f(v.x);
        acc[2] += w[2] * lo2f(v.y); acc[3] += w[3] * hi2f(v.y);
        acc[4] += w[4] * lo2f(v.z); acc[5] += w[5] * hi2f(v.z);
        acc[6] += w[6] * lo2f(v.w); acc[7] += w[7] * hi2f(v.w);
      }
    }
    *(uint4*)(XC + (size_t)t * 512 + c) = make_uint4(pack2(acc[0], acc[1]), pack2(acc[2], acc[3]), pack2(acc[4], acc[5]), pack2(acc[6], acc[7]));
  }
  const int lane = tidx_ & 63;
  const int gw = gtid >> 6, nw = gsz >> 6;
  float* rq = (float*)(p.ws + OFF_RSTDQ);
  float* rkv = (float*)(p.ws + OFF_RSTDKV);
  for (int t = gw; t < T_TOK; t += nw) {
    const bf16_t* z = Z2 + (size_t)t * 416;
    uint2 a = *(const uint2*)(z + lane * 4);
    unsigned b = *(const unsigned*)(z + 256 + lane * 2);
    float ssq = lo2f(a.x) * lo2f(a.x) + hi2f(a.x) * hi2f(a.x) + lo2f(a.y) * lo2f(a.y) + hi2f(a.y) * hi2f(a.y);
    float ssk = lo2f(b) * lo2f(b) + hi2f(b) * hi2f(b);
    ssq = wave_sum(ssq); ssk = wave_sum(ssk);
    if (lane == 0) { rq[t] = rsqrtf(ssq * (1.f / 256.f) + EPSN); rkv[t] = rsqrtf(ssk * (1.f / 128.f) + EPSN); }
  }
}

__device__ __forceinline__ void phase_g234(const Params& p, bf16_t* sm) {
  const int tidx_ = opaque_tid();
  const int lane = tidx_ & 63, wave = tidx_ >> 6, wm = wave >> 1, wn = wave & 1;
  const bf16_t* Z2 = (const bf16_t*)(p.ws + OFF_Z2);
  const bf16_t* XC = (const bf16_t*)(p.ws + OFF_XC);
  bf16_t* QR = (bf16_t*)(p.ws + OFF_H);
  bf16_t* Kb = (bf16_t*)(p.ws + OFF_B);
  bf16_t* Vt = (bf16_t*)(p.ws + OFF_VT);
  unsigned* AB = (unsigned*)p.out;
  const float* rq = (const float*)(p.ws + OFF_RSTDQ);
  const float* rkv = (const float*)(p.ws + OFF_RSTDKV);
  const float* c8 = (const float*)(p.ws + OFF_C8);
  for (int it = blockIdx.x; it < 15360; it += gridDim.x) {
    f32x16 acc[2][2];
    if (it < 3072) {
      const int mt = it / 6, nt = it % 6;
      gemm_tile(Z2 + (size_t)mt * 128 * 416, 416, (const bf16_t*)(p.ws + OFF_WUQ) + nt * 128 * 256, 256, 256, acc, sm);
#pragma unroll
      for (int mi = 0; mi < 2; mi++)
#pragma unroll
        for (int r = 0; r < 16; r++) {
          const int rl = EPI_ROW(wm, mi, r, lane);
          const float rs = rq[mt * 128 + rl];
#pragma unroll
          for (int ni = 0; ni < 2; ni++) sm[rl * CS_LD + EPI_COL(wn, ni, lane)] = f2bf(acc[mi][ni][r] * rs);
        }
      __syncthreads();
      tile_copy_out(sm, QR + (size_t)mt * 128 * 768 + nt * 128, 768, 4);
      __syncthreads();
    } else if (it < 7168) {
      const int j = it - 3072;
      const int mt = j >> 3, h = j & 7;
      gemm_tile(Z2 + (size_t)mt * 128 * 416 + 256, 416, (const bf16_t*)(p.ws + OFF_WUKV) + h * 128 * 128, 128, 128, acc, sm);
      SeqInfo si = seq_of(mt * 128);
      if (wn == 0) {
#pragma unroll
        for (int mi = 0; mi < 2; mi++)
#pragma unroll
          for (int r = 0; r < 16; r++) {
            const int row = mt * 128 + EPI_ROW(wm, mi, r, lane);
            const float rs = rkv[row];
            const size_t krow = (size_t)si.s0 * 8 + (size_t)h * si.S + (row - si.s0);
#pragma unroll
            for (int ni = 0; ni < 2; ni++)
              Kb[krow * 96 + ni * 32 + (lane & 31)] = f2bf(acc[mi][ni][r] * rs);
          }
      } else {
        bf16_t* vb = Vt + ((size_t)si.s0 * 8 + (size_t)h * si.S) * 64;
#pragma unroll
        for (int mi = 0; mi < 2; mi++)
#pragma unroll
          for (int rg = 0; rg < 4; rg++) {
            const int t4 = mt * 128 + wm * 64 + mi * 32 + 8 * rg + 4 * (lane >> 5);
            const float r0 = rkv[t4], r1 = rkv[t4 + 1], r2 = rkv[t4 + 2], r3 = rkv[t4 + 3];
#pragma unroll
            for (int ni = 0; ni < 2; ni++) {
              const int dv = ni * 32 + (lane & 31);
              uint2 pk = make_uint2(pack2(acc[mi][ni][rg * 4 + 0] * r0, acc[mi][ni][rg * 4 + 1] * r1),
                                    pack2(acc[mi][ni][rg * 4 + 2] * r2, acc[mi][ni][rg * 4 + 3] * r3));
              const int ps_ = t4 - si.s0;
              const int pp_ = (ps_ & ~12) | ((ps_ & 4) << 1) | ((ps_ & 8) >> 1);
              *(uint2*)(vb + (size_t)dv * si.S + pp_) = pk;
            }
          }
      }
    } else {
      const int j = it - 7168;
      const int mt = j >> 4, hd = j & 15, h = hd >> 1, d = hd & 1;
      gemm_tile(XC + (size_t)mt * 128 * 512 + h * 64, 512, (const bf16_t*)(p.ws + OFF_WGATE) + hd * 128 * 64, 64, 64, acc, sm);
      const int c = h * 64 + wn * 32 + (lane & 31);
      const float ba = p.in[12][d * 512 + c], bx = p.in[14][d * 512 + c], cc8 = c8[d * 512 + c];
#pragma unroll
      for (int mi = 0; mi < 2; mi++)
#pragma unroll
        for (int r = 0; r < 16; r++) {
          const int row = mt * 128 + EPI_ROW(wm, mi, r, lane);
          const float rg = sigmoid_f(acc[mi][0][r] + ba);
          const float ig = sigmoid_f(acc[mi][1][r] + bx);
          const float l2a = -rg * cc8;
          const float a2 = fexp2(2.f * l2a);
          const float xv = bf2f(XC[(size_t)row * 512 + c]);
          const float bb = __builtin_amdgcn_sqrtf(fmaxf(1.f - a2, 0.f)) * ig * xv;
          AB[((size_t)d * T_TOK + row) * 512 + c] = pack2(l2a, bb);
        }
    }
  }
}

__device__ __forceinline__ void unpack8(uint4 v, float* f) {
  f[0] = lo2f(v.x); f[1] = hi2f(v.x); f[2] = lo2f(v.y); f[3] = hi2f(v.y);
  f[4] = lo2f(v.z); f[5] = hi2f(v.z); f[6] = lo2f(v.w); f[7] = hi2f(v.w);
}
__device__ __forceinline__ uint4 pack8(const float* f) {
  return make_uint4(pack2(f[0], f[1]), pack2(f[2], f[3]), pack2(f[4], f[5]), pack2(f[6], f[7]));
}
__device__ __forceinline__ float sumsq8(uint4 v) {
  float a0 = lo2f(v.x), a1 = hi2f(v.x), a2 = lo2f(v.y), a3 = hi2f(v.y), a4 = lo2f(v.z), a5 = hi2f(v.z), a6 = lo2f(v.w), a7 = hi2f(v.w);
  return a0 * a0 + a1 * a1 + a2 * a2 + a3 * a3 + a4 * a4 + a5 * a5 + a6 * a6 + a7 * a7;
}
__device__ __forceinline__ void norm_rope96(uint4 (&v)[12], const float* __restrict__ gain, float outscale, const float (&cs)[16], const float (&sn)[16]) {
  float ss = 0.f;
#pragma unroll
  for (int i = 0; i < 12; i++) ss += sumsq8(v[i]);
  const float rstd = rsqrtf(ss * (1.f / 96.f) + EPSN);
#pragma unroll
  for (int i = 0; i < 8; i++) {
    float f[8]; unpack8(v[i], f);
#pragma unroll
    for (int j = 0; j < 8; j++) f[j] = f[j] * rstd * gain[i * 8 + j] * outscale;
    v[i] = pack8(f);
  }
#pragma unroll
  for (int q = 0; q < 2; q++) {
    float f1[8], f2[8]; unpack8(v[8 + q], f1); unpack8(v[10 + q], f2);
#pragma unroll
    for (int j = 0; j < 8; j++) {
      const float r1 = f1[j] * rstd * gain[64 + q * 8 + j];
      const float r2 = f2[j] * rstd * gain[80 + q * 8 + j];
      const float c = cs[q * 8 + j], s = sn[q * 8 + j];
      f1[j] = (r1 * c - r2 * s) * outscale;
      f2[j] = (r2 * c + r1 * s) * outscale;
    }
    v[8 + q] = pack8(f1); v[10 + q] = pack8(f2);
  }
}

#define QSCALE (0.10206207261596575f * 1.4426950408889634f)

__device__ __forceinline__ void phase_qkprep_scan1(const Params& p) {
  const int tidx_ = opaque_tid();
  const int tid = tidx_;
  bf16_t* QR = (bf16_t*)(p.ws + OFF_H);
  bf16_t* Kb = (bf16_t*)(p.ws + OFF_B);
  const bf16_t* Z2 = (const bf16_t*)(p.ws + OFF_Z2);
  const unsigned* AB = (const unsigned*)p.out;
  float* aggA = (float*)(p.ws + OFF_AGGA);
  float* aggB = (float*)(p.ws + OFF_AGGB);
  for (int it = blockIdx.x; it < 4096; it += gridDim.x) {
    if (it < 2048) {
      const int i = it * 256 + tid;
      const int t = i >> 3, h = i & 7;
      SeqInfo si = seq_of(t);
      const float pos = (float)(t - si.s0);
      float cs[16], sn[16];
#pragma unroll
      for (int k = 0; k < 16; k++) {
        const float inv = exp2f(-(float)k * (13.287712379549449f / 16.f));
        float rev = pos * inv * 0.15915494309189535f;
        rev = rev - floorf(rev);
        cs[k] = __builtin_amdgcn_cosf(rev);
        sn[k] = __builtin_amdgcn_sinf(rev);
      }
      uint4 v[12];
      bf16_t* qp = QR + (size_t)t * 768 + h * 96;
#pragma unroll
      for (int k = 0; k < 12; k++) v[k] = *(const uint4*)(qp + k * 8);
      norm_rope96(v, p.in[20], QSCALE, cs, sn);
#pragma unroll
      for (int k = 0; k < 12; k++) *(uint4*)(qp + k * 8) = v[k];
      bf16_t* kp = Kb + ((size_t)si.s0 * 8 + (size_t)h * si.S + (t - si.s0)) * 96;
#pragma unroll
      for (int k = 0; k < 8; k++) v[k] = *(const uint4*)(kp + k * 8);
#pragma unroll
      for (int k = 0; k < 4; k++) v[8 + k] = *(const uint4*)(Z2 + (size_t)t * 416 + 384 + k * 8);
      norm_rope96(v, p.in[21], 1.f, cs, sn);
#pragma unroll
      for (int k = 0; k < 12; k++) *(uint4*)(kp + k * 8) = v[k];
    } else {
      const int i = (it - 2048) * 256 + tid;
      const int c = i & 511, ch = (i >> 9) & 511, d = i >> 18;
      const unsigned* ab = AB + ((size_t)d * T_TOK + (size_t)ch * 128) * 512 + c;
      float A = 1.f, Bv = 0.f;
      if (d == 0) {
        for (int sb = 0; sb < 128; sb += 16) {
          unsigned u[16];
#pragma unroll
          for (int j = 0; j < 16; j++) u[j] = ab[(size_t)(sb + j) * 512];
#pragma unroll
          for (int j = 0; j < 16; j++) { float a = fexp2(lo2f(u[j])); Bv = a * Bv + hi2f(u[j]); A *= a; }
        }
      } else {
        for (int sb = 112; sb >= 0; sb -= 16) {
          unsigned u[16];
#pragma unroll
          for (int j = 0; j < 16; j++) u[j] = ab[(size_t)(sb + j) * 512];
#pragma unroll
          for (int j = 15; j >= 0; j--) { float a = fexp2(lo2f(u[j])); Bv = a * Bv + hi2f(u[j]); A *= a; }
        }
      }
      aggA[i] = A; aggB[i] = Bv;
    }
  }
}

__device__ __forceinline__ void phase_scan2(const Params& p) {
  const int tidx_ = opaque_tid();
  const int gtid = blockIdx.x * 256 + tidx_, gsz = gridDim.x * 256;
  const float* aggA = (const float*)(p.ws + OFF_AGGA);
  const float* aggB = (const float*)(p.ws + OFF_AGGB);
  float* carry = (float*)(p.ws + OFF_CARRY);
  for (int i = gtid; i < 10240; i += gsz) {
    const int d = i / 5120, rem = i % 5120, seq = rem >> 9, c = rem & 511;
    const int ch0 = seq < 2 ? seq * 128 : 256 + (seq - 2) * 32;
    const int nch = seq < 2 ? 128 : 32;
    float cr = 0.f;
    const int ob = ((d * 512) + ch0) * 512 + c;
    if (d == 0) {
      for (int jb = 0; jb < nch; jb += 16) {
        float av[16], bv[16];
#pragma unroll
        for (int j = 0; j < 16; j++) { av[j] = aggA[ob + (jb + j) * 512]; bv[j] = aggB[ob + (jb + j) * 512]; }
#pragma unroll
        for (int j = 0; j < 16; j++) { carry[ob + (jb + j) * 512] = cr; cr = av[j] * cr + bv[j]; }
      }
    } else {
      for (int jb = nch - 16; jb >= 0; jb -= 16) {
        float av[16], bv[16];
#pragma unroll
        for (int j = 0; j < 16; j++) { av[j] = aggA[ob + (jb + j) * 512]; bv[j] = aggB[ob + (jb + j) * 512]; }
#pragma unroll
        for (int j = 15; j >= 0; j--) { carry[ob + (jb + j) * 512] = cr; cr = av[j] * cr + bv[j]; }
      }
    }
  }
}

__device__ __forceinline__ void scan3_item(const Params& p, int it) {
  const int tidx_ = opaque_tid();
  const int i = it * 256 + tidx_;
  const int c = i & 511, ch = i >> 9;
  unsigned* AB = (unsigned*)p.out;
  bf16_t* Z1 = (bf16_t*)(p.ws + OFF_R1);
  unsigned* abf = AB + ((size_t)ch * 128) * 512 + c;
  unsigned* abb = AB + ((size_t)T_TOK + (size_t)ch * 128) * 512 + c;
  const float* aggA = (const float*)(p.ws + OFF_AGGA);
  const float* aggB = (const float*)(p.ws + OFF_AGGB);
  const int ch0 = ch < 256 ? (ch & ~127) : (ch & ~31);
  const int nch = ch < 256 ? 128 : 32;
  float hst = 0.f;
#pragma unroll 8
  for (int j = ch0; j < ch; j++) hst = aggA[j * 512 + c] * hst + aggB[j * 512 + c];
  for (int sb = 0; sb < 128; sb += 16) {
    unsigned u[16];
#pragma unroll
    for (int j = 0; j < 16; j++) u[j] = abf[(size_t)(sb + j) * 512];
#pragma unroll
    for (int j = 0; j < 16; j++) { hst = fexp2(lo2f(u[j])) * hst + hi2f(u[j]); u[j] = __float_as_uint(hst); }
#pragma unroll
    for (int j = 0; j < 16; j++) abf[(size_t)(sb + j) * 512] = u[j];
  }
  hst = 0.f;
#pragma unroll 8
  for (int j = ch0 + nch - 1; j > ch; j--) hst = aggA[(512 + j) * 512 + c] * hst + aggB[(512 + j) * 512 + c];
  bf16_t* zp = Z1 + ((size_t)ch * 128) * 1024 + 512 + c;
  for (int sb = 112; sb >= 0; sb -= 16) {
    unsigned u[16]; float fw[16]; unsigned short yv[16];
#pragma unroll
    for (int j = 0; j < 16; j++) { u[j] = abb[(size_t)(sb + j) * 512]; fw[j] = __uint_as_float(abf[(size_t)(sb + j) * 512]); yv[j] = zp[(size_t)(sb + j) * 1024]; }
#pragma unroll
    for (int j = 15; j >= 0; j--) {
      hst = fexp2(lo2f(u[j])) * hst + hi2f(u[j]);
      const float tot = hst + fw[j];
      yv[j] = f2bf(tot * gelu_t(bf2f(yv[j])));
    }
#pragma unroll
    for (int j = 0; j < 16; j++) zp[(size_t)(sb + j) * 1024] = yv[j];
  }
}

#define KS_STRIDE 104
#define VS_STRIDE 72
#define ATT_BUF (64 * KS_STRIDE + 64 * VS_STRIDE)
__device__ __forceinline__ float xhalf_max(float x) {
  auto r = __builtin_amdgcn_permlane32_swap(__float_as_int(x), __float_as_int(x), false, false);
  return fmaxf(__int_as_float(r[0]), __int_as_float(r[1]));
}
template <bool OFFS>
__device__ __forceinline__ void attn_item(const Params& p, int seq, int h, int qt, bf16_t* sm) {
  const int tidx_ = opaque_tid();
  const int tid = tidx_, lane = tid & 63, w = tid >> 6, hh = lane >> 5, l31 = lane & 31;
  int s0, S;
  if (seq < 2) { s0 = seq << 14; S = 16384; } else { s0 = 32768 + ((seq - 2) << 12); S = 4096; }
  const bf16_t* Q = (const bf16_t*)(p.ws + OFF_H) + ((size_t)(s0 + qt * 256)) * 768 + h * 96;
  const bf16_t* Kp = (const bf16_t*)(p.ws + OFF_B) + ((size_t)s0 * 8 + (size_t)h * S) * 96;
  const bf16_t* Vp = (const bf16_t*)(p.ws + OFF_VT) + ((size_t)s0 * 8 + (size_t)h * S) * 64;
  bf16_t* Z1 = (bf16_t*)(p.ws + OFF_R1);
  bf16x8 qf[2][6];
#pragma unroll
  for (int qs = 0; qs < 2; qs++)
#pragma unroll
    for (int kk = 0; kk < 6; kk++) qf[qs][kk] = *(const bf16x8*)(Q + (size_t)(w * 64 + qs * 32 + l31) * 768 + kk * 16 + hh * 8);
  f32x16 o00, o01, o10, o11;
#pragma unroll
  for (int r = 0; r < 16; r++) { o00[r] = 0.f; o01[r] = 0.f; o10[r] = 0.f; o11[r] = 0.f; }
  float l0 = 0.f, l1 = 0.f;
  float negc0 = 0.f, negc1 = 0.f;
  if (OFFS) {
    float qa = 0.f, qb = 0.f;
#pragma unroll
    for (int kk = 0; kk < 6; kk++)
#pragma unroll
      for (int j = 0; j < 8; j++) {
        const float x = bf2f((unsigned short)qf[0][kk][j]); qa += x * x;
        const float y = bf2f((unsigned short)qf[1][kk][j]); qb += y * y;
      }
    qa += __shfl_xor(qa, 32);
    qb += __shfl_xor(qb, 32);
    const float* gk = p.in[21];
    float gm = fmaxf(fabsf(gk[lane]), lane < 32 ? fabsf(gk[64 + lane]) : 0.f);
#pragma unroll
    for (int o_ = 32; o_ > 0; o_ >>= 1) gm = fmaxf(gm, __shfl_xor(gm, o_));
    negc0 = -(sqrtf(qa) * 9.797958971f * gm * 1.01f + 1e-3f);
    negc1 = -(sqrtf(qb) * 9.797958971f * gm * 1.01f + 1e-3f);
  }
  const int kr0 = tid / 12, kc0 = (tid % 12) * 8;
  const int kr1 = (tid + 256) / 12, kc1 = ((tid + 256) % 12) * 8;
  const int kr2 = (tid + 512) / 12, kc2 = ((tid + 512) % 12) * 8;
  const int vr0 = tid >> 3, vc0 = (tid & 7) * 8;
  const int vr1 = (tid + 256) >> 3, vc1 = vc0;
  const int ko0 = kr0 * KS_STRIDE + kc0, ko1 = kr1 * KS_STRIDE + kc1, ko2 = kr2 * KS_STRIDE + kc2;
  const int vo0 = 64 * KS_STRIDE + vr0 * VS_STRIDE + vc0, vo1 = 64 * KS_STRIDE + vr1 * VS_STRIDE + vc1;
  const unsigned kq0 = (unsigned)(kr0 * 96 + kc0), kq1 = (unsigned)(kr1 * 96 + kc1), kq2 = (unsigned)(kr2 * 96 + kc2);
  const unsigned vq0 = (unsigned)(vr0 * S + vc0), vq1 = (unsigned)(vr1 * S + vc1);
  uint4 rk0 = *(const uint4*)(Kp + kq0), rk1 = *(const uint4*)(Kp + kq1), rk2 = *(const uint4*)(Kp + kq2);
  uint4 rv0 = *(const uint4*)(Vp + vq0), rv1 = *(const uint4*)(Vp + vq1);
  const int nt = S >> 6;
  __syncthreads();
  *(uint4*)(sm + ko0) = rk0; *(uint4*)(sm + ko1) = rk1; *(uint4*)(sm + ko2) = rk2;
  *(uint4*)(sm + vo0) = rv0; *(uint4*)(sm + vo1) = rv1;
  __syncthreads();
  const int koff = l31 * KS_STRIDE + hh * 8;
  const int voff = 64 * KS_STRIDE + l31 * VS_STRIDE + hh * 8;
  for (int kt = 0; kt < nt; ++kt) {
    const bf16_t* Ks = sm + (kt & 1) * ATT_BUF;
    if (kt + 1 < nt) {
      const bf16_t* Kn = Kp + (size_t)(kt + 1) * 64 * 96;
      const bf16_t* Vn = Vp + (size_t)(kt + 1) * 64;
      rk0 = *(const uint4*)(Kn + kq0); rk1 = *(const uint4*)(Kn + kq1); rk2 = *(const uint4*)(Kn + kq2);
      rv0 = *(const uint4*)(Vn + vq0); rv1 = *(const uint4*)(Vn + vq1);
    }
#pragma unroll 1
    for (int sub = 0; sub < 2; sub++) {
      f32x16 sv0, sv1;
#pragma unroll
      for (int r = 0; r < 16; r++) { sv0[r] = 0.f; sv1[r] = 0.f; }
      const bf16_t* Kr = Ks + koff + sub * 32 * KS_STRIDE;
#pragma unroll
      for (int kk = 0; kk < 6; kk++) {
        bf16x8 kf = *(const bf16x8*)(Kr + kk * 16);
        sv0 = __builtin_amdgcn_mfma_f32_32x32x16_bf16(kf, qf[0][kk], sv0, 0, 0, 0);
        sv1 = __builtin_amdgcn_mfma_f32_32x32x16_bf16(kf, qf[1][kk], sv1, 0, 0, 0);
      }
      float ps0 = 0.f, ps1 = 0.f;
#pragma unroll
      for (int r = 0; r < 16; r++) { float pv = fexp2(OFFS ? sv0[r] + negc0 : sv0[r]); ps0 += pv; sv0[r] = pv; }
#pragma unroll
      for (int r = 0; r < 16; r++) { float pv = fexp2(OFFS ? sv1[r] + negc1 : sv1[r]); ps1 += pv; sv1[r] = pv; }
      l0 += ps0; l1 += ps1;
      const bf16_t* Vr = Ks + voff + sub * 32;
#pragma unroll
      for (int st = 0; st < 2; st++) {
        union { bf16x8 v; unsigned u[4]; } pf0, pf1;
#pragma unroll
        for (int j = 0; j < 4; j++) {
          pf0.u[j] = pack2(sv0[8 * st + 2 * j], sv0[8 * st + 2 * j + 1]);
          pf1.u[j] = pack2(sv1[8 * st + 2 * j], sv1[8 * st + 2 * j + 1]);
        }
        bf16x8 vfa = *(const bf16x8*)(Vr + 16 * st);
        bf16x8 vfb = *(const bf16x8*)(Vr + 32 * VS_STRIDE + 16 * st);
        o00 = __builtin_amdgcn_mfma_f32_32x32x16_bf16(vfa, pf0.v, o00, 0, 0, 0);
        o10 = __builtin_amdgcn_mfma_f32_32x32x16_bf16(vfa, pf1.v, o10, 0, 0, 0);
        o01 = __builtin_amdgcn_mfma_f32_32x32x16_bf16(vfb, pf0.v, o01, 0, 0, 0);
        o11 = __builtin_amdgcn_mfma_f32_32x32x16_bf16(vfb, pf1.v, o11, 0, 0, 0);
      }
    }
    if (kt + 1 < nt) {
      bf16_t* nK = sm + ((kt + 1) & 1) * ATT_BUF;
      *(uint4*)(nK + ko0) = rk0; *(uint4*)(nK + ko1) = rk1; *(uint4*)(nK + ko2) = rk2;
      *(uint4*)(nK + vo0) = rv0; *(uint4*)(nK + vo1) = rv1;
    }
    __syncthreads();
  }
#pragma unroll
  for (int qs = 0; qs < 2; qs++) {
    const float lq = qs ? l1 : l0;
    const float lt = lq + __shfl_xor(lq, 32);
    const float inv = 1.f / lt;
    const size_t trow = (size_t)(s0 + qt * 256 + w * 64 + qs * 32 + l31);
#pragma unroll
    for (int dvt = 0; dvt < 2; dvt++) {
      const f32x16& oo = qs ? (dvt ? o11 : o10) : (dvt ? o01 : o00);
#pragma unroll
      for (int rg = 0; rg < 4; rg++) {
        const int dv = dvt * 32 + 8 * rg + 4 * hh;
        uint2 pk = make_uint2(pack2(oo[rg * 4 + 0] * inv, oo[rg * 4 + 1] * inv), pack2(oo[rg * 4 + 2] * inv, oo[rg * 4 + 3] * inv));
        *(uint2*)(Z1 + trow * 1024 + h * 64 + dv) = pk;
      }
    }
  }
}

__device__ __forceinline__ void phase_attn_scan3(const Params& p, bf16_t* sm) {
  const int tidx_ = opaque_tid();
  __shared__ int s_item;
  int* cnt = (int*)(p.ws + OFF_CNT);
  const int tid = tidx_;
  const int xcc = (int)(__builtin_amdgcn_s_getreg((3 << 11) | 20) & 0xFu) & 7;
  bool use_offs;
  {
    const int lane = tid & 63;
    const float* gq = p.in[20]; const float* gk = p.in[21];
    float a = fmaxf(fabsf(gq[lane]), lane < 32 ? fabsf(gq[64 + lane]) : 0.f);
    float b = fmaxf(fabsf(gk[lane]), lane < 32 ? fabsf(gk[64 + lane]) : 0.f);
#pragma unroll
    for (int o_ = 32; o_ > 0; o_ >>= 1) { a = fmaxf(a, __shfl_xor(a, o_)); b = fmaxf(b, __shfl_xor(b, o_)); }
    const float bound = 96.f * QSCALE * a * b * 1.03f;
    use_offs = !(bound < 64.f);
  }
  for (int dq = 0; dq < 8; ++dq) {
    const int q = (xcc + dq) & 7;
    while (true) {
      __syncthreads();
      if (tid == 0) s_item = atomicAdd(&cnt[q], 1);
      __syncthreads();
      const int it = s_item;
      if (it >= 256) break;
      int seq, h, qt;
      if (it < 128) { const int pair = q + 8 * (it >> 6); seq = pair >> 3; h = pair & 7; qt = it & 63; }
      else { const int j = it - 128; const int pair = q + 8 * (j >> 4); seq = 2 + (pair >> 3); h = pair & 7; qt = j & 15; }
      if (use_offs) attn_item<true>(p, seq, h, qt, sm); else attn_item<false>(p, seq, h, qt, sm);
    }
  }
  while (true) {
    __syncthreads();
    if (tid == 0) s_item = atomicAdd(&cnt[8], 1);
    __syncthreads();
    const int it = s_item;
    if (it >= 1024) break;
    scan3_item(p, it);
  }
}

__device__ __forceinline__ void phase_gres_norm(const Params& p, const bf16_t* A, const bf16_t* W, int layer, bool res_from_input, bf16_t* sm) {
  const int tidx_ = opaque_tid();
  const int lane = tidx_ & 63, wave = tidx_ >> 6, wm = wave >> 1, wn = wave & 1;
  const float* mod = (const float*)(p.ws + OFF_MOD);
  const float* g = p.in[7] + layer * 1024;
  bf16_t* H = (bf16_t*)(p.ws + OFF_H);
  for (int mt = blockIdx.x; mt < 512; mt += gridDim.x) {
    SeqInfo si = seq_of(mt * 128);
    const float* g1 = mod + (layer * 10 + si.b) * 6144 + 2 * 1024;
#pragma unroll 1
    for (int nt = 0; nt < 8; nt++) {
      f32x16 acc[2][2];
      gemm_tile(A + (size_t)mt * 128 * 1024, 1024, W + (size_t)nt * 128 * 1024, 1024, 1024, acc, sm);
      int mrow0 = mt * 128;
      asm volatile("" : "+s"(mrow0));
      const float* xb = res_from_input ? (mrow0 < 32768 ? p.in[0] : p.in[1] - (size_t)32768 * 1024) : p.out;
#pragma unroll
      for (int ni = 0; ni < 2; ni++) {
        const int col = nt * 128 + EPI_COL(wn, ni, lane);
        const float gg = g1[col];
#pragma unroll
        for (int mi = 0; mi < 2; mi++)
#pragma unroll
          for (int r = 0; r < 16; r++) {
            const unsigned off = (unsigned)((mrow0 + EPI_ROW(wm, mi, r, lane)) * 1024 + col);
            p.out[off] = xb[off] + gg * acc[mi][ni][r];
          }
      }
    }
    __syncthreads();
    const float* md = mod + (layer * 10 + si.b) * 6144 + 3 * 1024;
#pragma unroll 1
    for (int rr = wave; rr < 128; rr += 4) {
      const int t = mt * 128 + rr;
      const float* x = p.out + (size_t)t * 1024;
      float4 v[4];
      float ss = 0.f;
#pragma unroll
      for (int j = 0; j < 4; j++) {
        v[j] = *(const float4*)(x + j * 256 + lane * 4);
        ss += v[j].x * v[j].x + v[j].y * v[j].y + v[j].z * v[j].z + v[j].w * v[j].w;
      }
      ss = wave_sum(ss);
      const float rstd = rsqrtf(ss * (1.f / 1024.f) + EPSN);
#pragma unroll
      for (int j = 0; j < 4; j++) {
        const int idx = j * 256 + lane * 4;
        float4 gg = *(const float4*)(g + idx);
        float4 sh = *(const float4*)(md + idx);
        float4 sc = *(const float4*)(md + 1024 + idx);
        float y0 = v[j].x * rstd * gg.x * (1.f + sc.x) + sh.x;
        float y1 = v[j].y * rstd * gg.y * (1.f + sc.y) + sh.y;
        float y2 = v[j].z * rstd * gg.z * (1.f + sc.z) + sh.z;
        float y3 = v[j].w * rstd * gg.w * (1.f + sc.w) + sh.w;
        *(uint2*)(H + (size_t)t * 1024 + idx) = make_uint2(pack2(y0, y1), pack2(y2, y3));
      }
    }
    __syncthreads();
  }
}

__device__ __forceinline__ void phase_pq(const Params& p, int layer, bf16_t* sm) {
  const int tidx_ = opaque_tid();
  const int lane = tidx_ & 63, wave = tidx_ >> 6, wm = wave >> 1, wn = wave & 1;
  const bf16_t* H = (const bf16_t*)(p.ws + OFF_H);
  const bf16_t* W = (const bf16_t*)(p.ws + OFF_WPQ) + (size_t)layer * 2048 * 1024;
  bf16_t* PQ = (bf16_t*)(p.ws + OFF_R1);
  XCD_TILE_LOOP(16, mt, nt) {
    f32x16 acc[2][2];
    gemm_tile(H + (size_t)mt * 128 * 1024, 1024, W + (size_t)nt * 128 * 1024, 1024, 1024, acc, sm);
#pragma unroll
    for (int mi = 0; mi < 2; mi++)
#pragma unroll
      for (int ni = 0; ni < 2; ni++)
#pragma unroll
        for (int r = 0; r < 16; r++)
          sm[EPI_ROW(wm, mi, r, lane) * CS_LD + EPI_COL(wn, ni, lane)] = f2bf(acc[mi][ni][r]);
    __syncthreads();
    tile_copy_out(sm, PQ + (size_t)mt * 128 * 2048 + nt * 128, 2048, 4);
    __syncthreads();
  }
}

__device__ __forceinline__ int ordf(float x) { int b = __float_as_int(x); return b ^ ((b >> 31) & 0x7fffffff); }
__device__ __forceinline__ float unordf(int o) { return __int_as_float(o ^ ((o >> 31) & 0x7fffffff)); }
#define KEY_MIN ((int)0x80000000)
#define KINS(L, key)                                              \
  {                                                               \
    int cx_ = (key);                                              \
    _Pragma("unroll") for (int k_ = 0; k_ < 16; k_++) {           \
      const int hi_ = max(L[k_], cx_);                            \
      cx_ = min(L[k_], cx_);                                      \
      L[k_] = hi_;                                                \
    }                                                             \
  }
#define KSTAGE(c_, st_)                                                  \
  _Pragma("unroll") for (int i_ = 0; i_ < 16; i_++) {                     \
    if ((i_ & (st_)) == 0) {                                              \
      const int hi_ = max(c_[i_], c_[i_ + (st_)]);                        \
      const int lo_ = min(c_[i_], c_[i_ + (st_)]);                        \
      c_[i_] = hi_; c_[i_ + (st_)] = lo_;                                 \
    }                                                                     \
  }
#define KMERGE(L)                                                                     \
  {                                                                                   \
    int c_[16];                                                                       \
    _Pragma("unroll") for (int k_ = 0; k_ < 16; k_++) c_[k_] = max(L[k_], __shfl_xor(L[15 - k_], 1)); \
    KSTAGE(c_, 8) KSTAGE(c_, 4) KSTAGE(c_, 2) KSTAGE(c_, 1)                           \
    _Pragma("unroll") for (int k_ = 0; k_ < 16; k_++) L[k_] = c_[k_];                 \
  }

#define KSORT16(V) { \
    { const int hi_ = max(V[0], V[1]); const int lo_ = min(V[0], V[1]); V[0] = hi_; V[1] = lo_; } \
    { const int hi_ = max(V[3], V[2]); const int lo_ = min(V[3], V[2]); V[3] = hi_; V[2] = lo_; } \
    { const int hi_ = max(V[4], V[5]); const int lo_ = min(V[4], V[5]); V[4] = hi_; V[5] = lo_; } \
    { const int hi_ = max(V[7], V[6]); const int lo_ = min(V[7], V[6]); V[7] = hi_; V[6] = lo_; } \
    { const int hi_ = max(V[8], V[9]); const int lo_ = min(V[8], V[9]); V[8] = hi_; V[9] = lo_; } \
    { const int hi_ = max(V[11], V[10]); const int lo_ = min(V[11], V[10]); V[11] = hi_; V[10] = lo_; } \
    { const int hi_ = max(V[12], V[13]); const int lo_ = min(V[12], V[13]); V[12] = hi_; V[13] = lo_; } \
    { const int hi_ = max(V[15], V[14]); const int lo_ = min(V[15], V[14]); V[15] = hi_; V[14] = lo_; } \
    { const int hi_ = max(V[0], V[2]); const int lo_ = min(V[0], V[2]); V[0] = hi_; V[2] = lo_; } \
    { const int hi_ = max(V[1], V[3]); const int lo_ = min(V[1], V[3]); V[1] = hi_; V[3] = lo_; } \
    { const int hi_ = max(V[6], V[4]); const int lo_ = min(V[6], V[4]); V[6] = hi_; V[4] = lo_; } \
    { const int hi_ = max(V[7], V[5]); const int lo_ = min(V[7], V[5]); V[7] = hi_; V[5] = lo_; } \
    { const int hi_ = max(V[8], V[10]); const int lo_ = min(V[8], V[10]); V[8] = hi_; V[10] = lo_; } \
    { const int hi_ = max(V[9], V[11]); const int lo_ = min(V[9], V[11]); V[9] = hi_; V[11] = lo_; } \
    { const int hi_ = max(V[14], V[12]); const int lo_ = min(V[14], V[12]); V[14] = hi_; V[12] = lo_; } \
    { const int hi_ = max(V[15], V[13]); const int lo_ = min(V[15], V[13]); V[15] = hi_; V[13] = lo_; } \
    { const int hi_ = max(V[0], V[1]); const int lo_ = min(V[0], V[1]); V[0] = hi_; V[1] = lo_; } \
    { const int hi_ = max(V[2], V[3]); const int lo_ = min(V[2], V[3]); V[2] = hi_; V[3] = lo_; } \
    { const int hi_ = max(V[5], V[4]); const int lo_ = min(V[5], V[4]); V[5] = hi_; V[4] = lo_; } \
    { const int hi_ = max(V[7], V[6]); const int lo_ = min(V[7], V[6]); V[7] = hi_; V[6] = lo_; } \
    { const int hi_ = max(V[8], V[9]); const int lo_ = min(V[8], V[9]); V[8] = hi_; V[9] = lo_; } \
    { const int hi_ = max(V[10], V[11]); const int lo_ = min(V[10], V[11]); V[10] = hi_; V[11] = lo_; } \
    { const int hi_ = max(V[13], V[12]); const int lo_ = min(V[13], V[12]); V[13] = hi_; V[12] = lo_; } \
    { const int hi_ = max(V[15], V[14]); const int lo_ = min(V[15], V[14]); V[15] = hi_; V[14] = lo_; } \
    { const int hi_ = max(V[0], V[4]); const int lo_ = min(V[0], V[4]); V[0] = hi_; V[4] = lo_; } \
    { const int hi_ = max(V[1], V[5]); const int lo_ = min(V[1], V[5]); V[1] = hi_; V[5] = lo_; } \
    { const int hi_ = max(V[2], V[6]); const int lo_ = min(V[2], V[6]); V[2] = hi_; V[6] = lo_; } \
    { const int hi_ = max(V[3], V[7]); const int lo_ = min(V[3], V[7]); V[3] = hi_; V[7] = lo_; } \
    { const int hi_ = max(V[12], V[8]); const int lo_ = min(V[12], V[8]); V[12] = hi_; V[8] = lo_; } \
    { const int hi_ = max(V[13], V[9]); const int lo_ = min(V[13], V[9]); V[13] = hi_; V[9] = lo_; } \
    { const int hi_ = max(V[14], V[10]); const int lo_ = min(V[14], V[10]); V[14] = hi_; V[10] = lo_; } \
    { const int hi_ = max(V[15], V[11]); const int lo_ = min(V[15], V[11]); V[15] = hi_; V[11] = lo_; } \
    { const int hi_ = max(V[0], V[2]); const int lo_ = min(V[0], V[2]); V[0] = hi_; V[2] = lo_; } \
    { const int hi_ = max(V[1], V[3]); const int lo_ = min(V[1], V[3]); V[1] = hi_; V[3] = lo_; } \
    { const int hi_ = max(V[4], V[6]); const int lo_ = min(V[4], V[6]); V[4] = hi_; V[6] = lo_; } \
    { const int hi_ = max(V[5], V[7]); const int lo_ = min(V[5], V[7]); V[5] = hi_; V[7] = lo_; } \
    { const int hi_ = max(V[10], V[8]); const int lo_ = min(V[10], V[8]); V[10] = hi_; V[8] = lo_; } \
    { const int hi_ = max(V[11], V[9]); const int lo_ = min(V[11], V[9]); V[11] = hi_; V[9] = lo_; } \
    { const int hi_ = max(V[14], V[12]); const int lo_ = min(V[14], V[12]); V[14] = hi_; V[12] = lo_; } \
    { const int hi_ = max(V[15], V[13]); const int lo_ = min(V[15], V[13]); V[15] = hi_; V[13] = lo_; } \
    { const int hi_ = max(V[0], V[1]); const int lo_ = min(V[0], V[1]); V[0] = hi_; V[1] = lo_; } \
    { const int hi_ = max(V[2], V[3]); const int lo_ = min(V[2], V[3]); V[2] = hi_; V[3] = lo_; } \
    { const int hi_ = max(V[4], V[5]); const int lo_ = min(V[4], V[5]); V[4] = hi_; V[5] = lo_; } \
    { const int hi_ = max(V[6], V[7]); const int lo_ = min(V[6], V[7]); V[6] = hi_; V[7] = lo_; } \
    { const int hi_ = max(V[9], V[8]); const int lo_ = min(V[9], V[8]); V[9] = hi_; V[8] = lo_; } \
    { const int hi_ = max(V[11], V[10]); const int lo_ = min(V[11], V[10]); V[11] = hi_; V[10] = lo_; } \
    { const int hi_ = max(V[13], V[12]); const int lo_ = min(V[13], V[12]); V[13] = hi_; V[12] = lo_; } \
    { const int hi_ = max(V[15], V[14]); const int lo_ = min(V[15], V[14]); V[15] = hi_; V[14] = lo_; } \
    { const int hi_ = max(V[0], V[8]); const int lo_ = min(V[0], V[8]); V[0] = hi_; V[8] = lo_; } \
    { const int hi_ = max(V[1], V[9]); const int lo_ = min(V[1], V[9]); V[1] = hi_; V[9] = lo_; } \
    { const int hi_ = max(V[2], V[10]); const int lo_ = min(V[2], V[10]); V[2] = hi_; V[10] = lo_; } \
    { const int hi_ = max(V[3], V[11]); const int lo_ = min(V[3], V[11]); V[3] = hi_; V[11] = lo_; } \
    { const int hi_ = max(V[4], V[12]); const int lo_ = min(V[4], V[12]); V[4] = hi_; V[12] = lo_; } \
    { const int hi_ = max(V[5], V[13]); const int lo_ = min(V[5], V[13]); V[5] = hi_; V[13] = lo_; } \
    { const int hi_ = max(V[6], V[14]); const int lo_ = min(V[6], V[14]); V[6] = hi_; V[14] = lo_; } \
    { const int hi_ = max(V[7], V[15]); const int lo_ = min(V[7], V[15]); V[7] = hi_; V[15] = lo_; } \
    { const int hi_ = max(V[0], V[4]); const int lo_ = min(V[0], V[4]); V[0] = hi_; V[4] = lo_; } \
    { const int hi_ = max(V[1], V[5]); const int lo_ = min(V[1], V[5]); V[1] = hi_; V[5] = lo_; } \
    { const int hi_ = max(V[2], V[6]); const int lo_ = min(V[2], V[6]); V[2] = hi_; V[6] = lo_; } \
    { const int hi_ = max(V[3], V[7]); const int lo_ = min(V[3], V[7]); V[3] = hi_; V[7] = lo_; } \
    { const int hi_ = max(V[8], V[12]); const int lo_ = min(V[8], V[12]); V[8] = hi_; V[12] = lo_; } \
    { const int hi_ = max(V[9], V[13]); const int lo_ = min(V[9], V[13]); V[9] = hi_; V[13] = lo_; } \
    { const int hi_ = max(V[10], V[14]); const int lo_ = min(V[10], V[14]); V[10] = hi_; V[14] = lo_; } \
    { const int hi_ = max(V[11], V[15]); const int lo_ = min(V[11], V[15]); V[11] = hi_; V[15] = lo_; } \
    { const int hi_ = max(V[0], V[2]); const int lo_ = min(V[0], V[2]); V[0] = hi_; V[2] = lo_; } \
    { const int hi_ = max(V[1], V[3]); const int lo_ = min(V[1], V[3]); V[1] = hi_; V[3] = lo_; } \
    { const int hi_ = max(V[4], V[6]); const int lo_ = min(V[4], V[6]); V[4] = hi_; V[6] = lo_; } \
    { const int hi_ = max(V[5], V[7]); const int lo_ = min(V[5], V[7]); V[5] = hi_; V[7] = lo_; } \
    { const int hi_ = max(V[8], V[10]); const int lo_ = min(V[8], V[10]); V[8] = hi_; V[10] = lo_; } \
    { const int hi_ = max(V[9], V[11]); const int lo_ = min(V[9], V[11]); V[9] = hi_; V[11] = lo_; } \
    { const int hi_ = max(V[12], V[14]); const int lo_ = min(V[12], V[14]); V[12] = hi_; V[14] = lo_; } \
    { const int hi_ = max(V[13], V[15]); const int lo_ = min(V[13], V[15]); V[13] = hi_; V[15] = lo_; } \
    { const int hi_ = max(V[0], V[1]); const int lo_ = min(V[0], V[1]); V[0] = hi_; V[1] = lo_; } \
    { const int hi_ = max(V[2], V[3]); const int lo_ = min(V[2], V[3]); V[2] = hi_; V[3] = lo_; } \
    { const int hi_ = max(V[4], V[5]); const int lo_ = min(V[4], V[5]); V[4] = hi_; V[5] = lo_; } \
    { const int hi_ = max(V[6], V[7]); const int lo_ = min(V[6], V[7]); V[6] = hi_; V[7] = lo_; } \
    { const int hi_ = max(V[8], V[9]); const int lo_ = min(V[8], V[9]); V[8] = hi_; V[9] = lo_; } \
    { const int hi_ = max(V[10], V[11]); const int lo_ = min(V[10], V[11]); V[10] = hi_; V[11] = lo_; } \
    { const int hi_ = max(V[12], V[13]); const int lo_ = min(V[12], V[13]); V[12] = hi_; V[13] = lo_; } \
    { const int hi_ = max(V[14], V[15]); const int lo_ = min(V[14], V[15]); V[14] = hi_; V[15] = lo_; } \
  }
#define KMERGE2(L, G) { \
    int c_[16]; \
    _Pragma("unroll") for (int k_ = 0; k_ < 16; k_++) c_[k_] = max(L[k_], G[15 - k_]); \
    KSTAGE(c_, 8) KSTAGE(c_, 4) KSTAGE(c_, 2) KSTAGE(c_, 1) \
    _Pragma("unroll") for (int k_ = 0; k_ < 16; k_++) L[k_] = c_[k_]; \
  }
__device__ __forceinline__ void phase_topk(const Params& p, int layer, bf16_t* sm) {
  const int tidx_ = opaque_tid();
  const int tid = tidx_, lane = tid & 63, wave = tid >> 6, wm = wave >> 1, wn = wave & 1;
  const bf16_t* H = (const bf16_t*)(p.ws + OFF_H);
  const bf16_t* WPQ = (const bf16_t*)(p.ws + OFF_WPQ) + (size_t)layer * 2048 * 1024;
  const bf16_t* KEYS = (const bf16_t*)(p.ws + OFF_KEYS) + (size_t)layer * 2 * 16384;
  int* IDX = (int*)(p.ws + OFF_IDX);
  float* GW = (float*)(p.ws + OFF_GW);
  float* sc = (float*)sm;
  int* ib = (int*)sm;
  const int r = tid >> 1, hf = tid & 1;
#pragma unroll 1
  for (int mt = blockIdx.x; mt < 512; mt += gridDim.x)
#pragma unroll 1
  for (int h = 0; h < 8; h++) {
    int k1[16], k2[16];
#pragma unroll
    for (int pp = 0; pp < 2; pp++) {
      f32x16 acc[2][2];
      gemm_tile(H + (size_t)mt * 128 * 1024, 1024, WPQ + (size_t)(h * 256 + pp * 128) * 1024, 1024, 1024, acc, sm);
#pragma unroll
      for (int mi = 0; mi < 2; mi++)
#pragma unroll
        for (int ni = 0; ni < 2; ni++)
#pragma unroll
          for (int rr = 0; rr < 16; rr++)
            sm[EPI_ROW(wm, mi, rr, lane) * CS_LD + EPI_COL(wn, ni, lane)] = f2bf(acc[mi][ni][rr]);
      gemm_ldsA_k128(KEYS + pp * 16384, acc, sm);
#pragma unroll
      for (int mi = 0; mi < 2; mi++)
#pragma unroll
        for (int ni = 0; ni < 2; ni++)
#pragma unroll
          for (int rr = 0; rr < 16; rr++)
            sc[EPI_ROW(wm, mi, rr, lane) * 130 + wn * 65 + ni * 32 + (lane & 31)] = acc[mi][ni][rr];
      __syncthreads();
      int L[16];
      const float* rp = sc + r * 130 + hf * 65;
      const int ibase = 127 - hf * 64;
#pragma unroll
      for (int j = 0; j < 16; j++) L[j] = (ordf(rp[j]) & ~127) | (ibase - j);
      KSORT16(L);
#pragma unroll 1
      for (int g = 1; g < 4; g++) {
        int G[16];
#pragma unroll
        for (int j = 0; j < 16; j++) G[j] = (ordf(rp[g * 16 + j]) & ~127) | (ibase - (g * 16 + j));
        KSORT16(G);
        KMERGE2(L, G);
      }
      KMERGE(L);
      if (pp == 0) {
#pragma unroll
        for (int k = 0; k < 16; k++) k1[k] = L[k];
      } else {
#pragma unroll
        for (int k = 0; k < 16; k++) k2[k] = L[k];
      }
      __syncthreads();
    }
    if (hf == 0) {
#pragma unroll
      for (int k = 0; k < 16; k++) { ib[r * 32 + k] = 127 - (k1[k] & 127); ib[r * 32 + 16 + k] = 127 - (k2[k] & 127); }
    }
    float A[16], B[16];
#pragma unroll
    for (int k = 0; k < 16; k++) {
      const float v1 = unordf(k1[k] & ~127), v2 = unordf(k2[k] & ~127);
      A[k] = hf ? v2 : v1;
      B[k] = hf ? v1 : v2;
    }
    int F[16], F2[16];
    F[0] = (ordf(A[0] + B[1]) & ~255) | (255 - (hf ? 16 : 1));
    F[1] = (ordf(A[0] + B[2]) & ~255) | (255 - (hf ? 32 : 2));
    F[2] = (ordf(A[0] + B[3]) & ~255) | (255 - (hf ? 48 : 3));
    F[3] = (ordf(A[0] + B[4]) & ~255) | (255 - (hf ? 64 : 4));
    F[4] = (ordf(A[0] + B[5]) & ~255) | (255 - (hf ? 80 : 5));
    F[5] = (ordf(A[0] + B[6]) & ~255) | (255 - (hf ? 96 : 6));
    F[6] = (ordf(A[0] + B[7]) & ~255) | (255 - (hf ? 112 : 7));
    F[7] = (ordf(A[0] + B[8]) & ~255) | (255 - (hf ? 128 : 8));
    F[8] = (ordf(A[0] + B[9]) & ~255) | (255 - (hf ? 144 : 9));
    F[9] = (ordf(A[0] + B[10]) & ~255) | (255 - (hf ? 160 : 10));
    F[10] = (ordf(A[0] + B[11]) & ~255) | (255 - (hf ? 176 : 11));
    F[11] = (ordf(A[0] + B[12]) & ~255) | (255 - (hf ? 192 : 12));
    F[12] = (ordf(A[0] + B[13]) & ~255) | (255 - (hf ? 208 : 13));
    F[13] = (ordf(A[0] + B[14]) & ~255) | (255 - (hf ? 224 : 14));
    F[14] = (ordf(A[0] + B[15]) & ~255) | (255 - (hf ? 240 : 15));
    F[15] = (ordf(A[1] + B[2]) & ~255) | (255 - (hf ? 33 : 18));
    F2[0] = (ordf(A[1] + B[3]) & ~255) | (255 - (hf ? 49 : 19));
    F2[1] = (ordf(A[1] + B[4]) & ~255) | (255 - (hf ? 65 : 20));
    F2[2] = (ordf(A[1] + B[5]) & ~255) | (255 - (hf ? 81 : 21));
    F2[3] = (ordf(A[1] + B[6]) & ~255) | (255 - (hf ? 97 : 22));
    F2[4] = (ordf(A[1] + B[7]) & ~255) | (255 - (hf ? 113 : 23));
    F2[5] = (ordf(A[2] + B[3]) & ~255) | (255 - (hf ? 50 : 35));
    F2[6] = (ordf(A[2] + B[4]) & ~255) | (255 - (hf ? 66 : 36));
    F2[7] = hf ? KEY_MIN : ((ordf(A[0] + B[0]) & ~255) | (255 - 0));
    F2[8] = hf ? KEY_MIN : ((ordf(A[1] + B[1]) & ~255) | (255 - 17));
    F2[9] = hf ? KEY_MIN : ((ordf(A[2] + B[2]) & ~255) | (255 - 34));
    F2[10] = hf ? KEY_MIN : ((ordf(A[3] + B[3]) & ~255) | (255 - 51));
    F2[11] = KEY_MIN;
    F2[12] = KEY_MIN;
    F2[13] = KEY_MIN;
    F2[14] = KEY_MIN;
    F2[15] = KEY_MIN;
    KSORT16(F);
    KSORT16(F2);
    KMERGE2(F, F2);
    KMERGE(F);
    __syncthreads();
    float e[16], se = 0.f;
    const float fmx = unordf(F[0] & ~255);
#pragma unroll
    for (int k = 0; k < 16; k++) { e[k] = __expf(unordf(F[k] & ~255) - fmx); se += e[k]; }
    const float inv = 1.f / se;
    int oi[8]; float og[8];
    const int hmask = -hf;
#pragma unroll
    for (int k = 0; k < 8; k++) {
      const int key = (F[k + 8] & hmask) | (F[k] & ~hmask);
      const int j = 255 - (key & 255);
      oi[k] = ib[r * 32 + (j >> 4)] * 128 + ib[r * 32 + 16 + (j & 15)];
      og[k] = __int_as_float((__float_as_int(e[k + 8]) & hmask) | (__float_as_int(e[k]) & ~hmask)) * inv;
    }
    const size_t o = ((size_t)(mt * 128 + r)) * 128 + h * 16 + hf * 8;
    *(int4*)(IDX + o) = make_int4(oi[0], oi[1], oi[2], oi[3]);
    *(int4*)(IDX + o + 4) = make_int4(oi[4], oi[5], oi[6], oi[7]);
    *(float4*)(GW + o) = make_float4(og[0], og[1], og[2], og[3]);
    *(float4*)(GW + o + 4) = make_float4(og[4], og[5], og[6], og[7]);
    __syncthreads();
  }
}

__device__ __forceinline__ float dot16_fp8(uint4 u, const f32x2* hf) {
  f32x2 a = __builtin_amdgcn_cvt_pk_f32_fp8((int)u.x, false) * hf[0];
  a += __builtin_amdgcn_cvt_pk_f32_fp8((int)u.x, true) * hf[1];
  a += __builtin_amdgcn_cvt_pk_f32_fp8((int)u.y, false) * hf[2];
  a += __builtin_amdgcn_cvt_pk_f32_fp8((int)u.y, true) * hf[3];
  a += __builtin_amdgcn_cvt_pk_f32_fp8((int)u.z, false) * hf[4];
  a += __builtin_amdgcn_cvt_pk_f32_fp8((int)u.z, true) * hf[5];
  a += __builtin_amdgcn_cvt_pk_f32_fp8((int)u.w, false) * hf[6];
  a += __builtin_amdgcn_cvt_pk_f32_fp8((int)u.w, true) * hf[7];
  return a.x + a.y;
}
__device__ __forceinline__ void fma16_fp8(f32x2* o, uint4 u, float a) {
  f32x2 aa = {a, a};
  o[0] += __builtin_amdgcn_cvt_pk_f32_fp8((int)u.x, false) * aa;
  o[1] += __builtin_amdgcn_cvt_pk_f32_fp8((int)u.x, true) * aa;
  o[2] += __builtin_amdgcn_cvt_pk_f32_fp8((int)u.y, false) * aa;
  o[3] += __builtin_amdgcn_cvt_pk_f32_fp8((int)u.y, true) * aa;
  o[4] += __builtin_amdgcn_cvt_pk_f32_fp8((int)u.z, false) * aa;
  o[5] += __builtin_amdgcn_cvt_pk_f32_fp8((int)u.z, true) * aa;
  o[6] += __builtin_amdgcn_cvt_pk_f32_fp8((int)u.w, false) * aa;
  o[7] += __builtin_amdgcn_cvt_pk_f32_fp8((int)u.w, true) * aa;
}
constexpr size_t OFF_ACT = OFF_B + 128 * MBY;
__device__ __forceinline__ void phase_gatherU(const Params& p) {
  const int tidx_ = opaque_tid();
  const int lane = tidx_ & 63;
  const int gw = (blockIdx.x * 256 + tidx_) >> 6, nw = gridDim.x * 4;
  const bf16_t* H = (const bf16_t*)(p.ws + OFF_H);
  const unsigned char* UT = (const unsigned char*)(p.ws + OFF_UT);
  const int* IDX = (const int*)(p.ws + OFF_IDX);
  const float* GW = (const float*)(p.ws + OFF_GW);
  float* ACT = (float*)(p.ws + OFF_ACT);
  const bool b5 = (lane & 32) != 0, b4 = (lane & 16) != 0, b3 = (lane & 8) != 0;
  for (int t = gw; t < T_TOK; t += nw) {
    f32x2 hf[8];
    {
      uint4 h0 = *(const uint4*)(H + (size_t)t * 1024 + lane * 16);
      uint4 h1 = *(const uint4*)(H + (size_t)t * 1024 + lane * 16 + 8);
      hf[0] = f32x2{lo2f(h0.x), hi2f(h0.x)}; hf[1] = f32x2{lo2f(h0.y), hi2f(h0.y)};
      hf[2] = f32x2{lo2f(h0.z), hi2f(h0.z)}; hf[3] = f32x2{lo2f(h0.w), hi2f(h0.w)};
      hf[4] = f32x2{lo2f(h1.x), hi2f(h1.x)}; hf[5] = f32x2{lo2f(h1.y), hi2f(h1.y)};
      hf[6] = f32x2{lo2f(h1.z), hi2f(h1.z)}; hf[7] = f32x2{lo2f(h1.w), hi2f(h1.w)};
    }
    const int id0 = IDX[(size_t)t * 128 + lane], id1 = IDX[(size_t)t * 128 + 64 + lane];
    const float g0 = GW[(size_t)t * 128 + lane], g1 = GW[(size_t)t * 128 + 64 + lane];
    float act0 = 0.f, act1 = 0.f;
    for (int half = 0; half < 2; half++) {
      const int idv = half ? id1 : id0;
      const float gv = half ? g1 : g0;
      float acth = 0.f;
#pragma unroll
      for (int gq = 0; gq < 8; gq += 2) {
        uint4 ua[16];
#pragma unroll
        for (int e = 0; e < 16; e++) {
          const int ex = __builtin_amdgcn_readlane(idv, gq * 8 + e);
          ua[e] = *(const uint4*)(UT + (size_t)ex * 1024 + lane * 16);
        }
#pragma unroll
        for (int g2 = 0; g2 < 2; g2++) {
          float d[8];
#pragma unroll
          for (int e = 0; e < 8; e++) d[e] = dot16_fp8(ua[g2 * 8 + e], hf);
          float e4[4], e2[2], e1;
#pragma unroll
          for (int i = 0; i < 4; i++) {
            const float snd = b5 ? d[i] : d[i + 4];
            const float kp = b5 ? d[i + 4] : d[i];
            e4[i] = kp + __shfl_xor(snd, 32);
          }
#pragma unroll
          for (int i = 0; i < 2; i++) {
            const float snd = b4 ? e4[i] : e4[i + 2];
            const float kp = b4 ? e4[i + 2] : e4[i];
            e2[i] = kp + __shfl_xor(snd, 16);
          }
          {
            const float snd = b3 ? e2[0] : e2[1];
            const float kp = b3 ? e2[1] : e2[0];
            e1 = kp + __shfl_xor(snd, 8);
          }
          e1 += __shfl_xor(e1, 4);
          e1 += __shfl_xor(e1, 2);
          e1 += __shfl_xor(e1, 1);
          const int grp = gq + g2;
          const float gE = __shfl(gv, grp * 8 + (lane >> 3));
          const float mine = gelu_t(e1 * (1.f / U_SCALE)) * gE * (1.f / V_SCALE);
          const float got = __shfl(mine, (lane & 7) * 8);
          acth = ((lane >> 3) == grp) ? got : acth;
        }
      }
      if (half) act1 = acth; else act0 = acth;
    }
    ACT[(size_t)t * 128 + lane] = act0;
    ACT[(size_t)t * 128 + 64 + lane] = act1;
  }
}

__device__ __forceinline__ void phase_gatherV(const Params& p, int layer) {
  const int tidx_ = opaque_tid();
  const int lane = tidx_ & 63;
  const int gw = (blockIdx.x * 256 + tidx_) >> 6, nw = gridDim.x * 4;
  const unsigned char* VT = (const unsigned char*)(p.ws + OFF_VTAB);
  const int* IDX = (const int*)(p.ws + OFF_IDX);
  const float* ACT = (const float*)(p.ws + OFF_ACT);
  const float* mod = (const float*)(p.ws + OFF_MOD);
  for (int t = gw; t < T_TOK; t += nw) {
    const int id0 = IDX[(size_t)t * 128 + lane], id1 = IDX[(size_t)t * 128 + 64 + lane];
    const float a0 = ACT[(size_t)t * 128 + lane], a1 = ACT[(size_t)t * 128 + 64 + lane];
    f32x2 o[8];
#pragma unroll
    for (int j = 0; j < 8; j++) o[j] = f32x2{0.f, 0.f};
    for (int half = 0; half < 2; half++) {
      const int idv = half ? id1 : id0;
      const int av = __float_as_int(half ? a1 : a0);
#pragma unroll
      for (int gq = 0; gq < 8; gq += 2) {
        uint4 va[16];
#pragma unroll
        for (int e = 0; e < 16; e++) {
          const int ex = __builtin_amdgcn_readlane(idv, gq * 8 + e);
          va[e] = *(const uint4*)(VT + (size_t)ex * 1024 + lane * 16);
        }
#pragma unroll
        for (int e = 0; e < 16; e++) {
          const float ae = __int_as_float(__builtin_amdgcn_readlane(av, gq * 8 + e));
          fma16_fp8(o, va[e], ae);
        }
      }
    }
    SeqInfo si = seq_of(t);
    const float* g2p = mod + (layer * 10 + si.b) * 6144 + 5 * 1024 + lane * 16;
    float* orow = p.out + (size_t)t * 1024 + lane * 16;
    float4 xn[4];
    float ssx = 0.f;
#pragma unroll
    for (int j = 0; j < 4; j++) {
      float4 xv = *(float4*)(orow + j * 4);
      float4 gg = *(const float4*)(g2p + j * 4);
      xv.x += gg.x * o[2 * j].x; xv.y += gg.y * o[2 * j].y;
      xv.z += gg.z * o[2 * j + 1].x; xv.w += gg.w * o[2 * j + 1].y;
      *(float4*)(orow + j * 4) = xv;
      xn[j] = xv;
      ssx += xv.x * xv.x + xv.y * xv.y + xv.z * xv.z + xv.w * xv.w;
    }
    if (layer == 0) {
      ssx = wave_sum(ssx);
      const float rstd = rsqrtf(ssx * (1.f / 1024.f) + EPSN);
      const float* gn = p.in[6] + 1024 + lane * 16;
      const float* md = mod + (1 * 10 + si.b) * 6144 + lane * 16;
      unsigned pk[8];
#pragma unroll
      for (int j = 0; j < 4; j++) {
        float4 gg = *(const float4*)(gn + j * 4);
        float4 sh = *(const float4*)(md + j * 4);
        float4 sc = *(const float4*)(md + 1024 + j * 4);
        const float y0 = xn[j].x * rstd * gg.x * (1.f + sc.x) + sh.x;
        const float y1 = xn[j].y * rstd * gg.y * (1.f + sc.y) + sh.y;
        const float y2 = xn[j].z * rstd * gg.z * (1.f + sc.z) + sh.z;
        const float y3 = xn[j].w * rstd * gg.w * (1.f + sc.w) + sh.w;
        pk[2 * j] = pack2(y0, y1); pk[2 * j + 1] = pack2(y2, y3);
      }
      bf16_t* hw = (bf16_t*)(p.ws + OFF_H) + (size_t)t * 1024 + lane * 16;
      *(uint4*)(hw) = make_uint4(pk[0], pk[1], pk[2], pk[3]);
      *(uint4*)(hw + 8) = make_uint4(pk[4], pk[5], pk[6], pk[7]);
    }
  }
}

__device__ __forceinline__ void phase_g8(const Params& p, bf16_t* sm) {
  const int tidx_ = opaque_tid();
  const int lane = tidx_ & 63, wave = tidx_ >> 6, wm = wave >> 1, wn = wave & 1;
  const bf16_t* H = (const bf16_t*)(p.ws + OFF_H);
  const bf16_t* W = (const bf16_t*)(p.ws + OFF_WCIN);
  bf16_t* BG = (bf16_t*)(p.ws + OFF_R1);
  bf16_t* U1 = (bf16_t*)(p.ws + OFF_R1 + 128 * MBY);
  XCD_TILE_LOOP(24, mt, nt) {
    f32x16 acc[2][2];
    gemm_tile(H + (size_t)mt * 128 * 1024, 1024, W + (size_t)nt * 128 * 1024, 1024, 1024, acc, sm);
    if (nt < 8) {
#pragma unroll
      for (int mi = 0; mi < 2; mi++)
#pragma unroll
        for (int ni = 0; ni < 2; ni++)
#pragma unroll
          for (int r = 0; r < 16; r++)
            sm[EPI_ROW(wm, mi, r, lane) * CS_LD + EPI_COL(wn, ni, lane)] = f2bf(acc[mi][ni][r]);
      __syncthreads();
      tile_copy_out(sm, BG + (size_t)mt * 128 * 1024 + nt * 128, 1024, 4);
    } else {
#pragma unroll
      for (int mi = 0; mi < 2; mi++)
#pragma unroll
        for (int r = 0; r < 16; r++)
          sm[EPI_ROW(wm, mi, r, lane) * CS_LD + wn * 32 + (lane & 31)] = f2bf(acc[mi][0][r] * acc[mi][1][r]);
      __syncthreads();
      tile_copy_out(sm, U1 + (size_t)mt * 128 * 1024 + (nt - 8) * 64, 1024, 3);
    }
    __syncthreads();
  }
}

__device__ __forceinline__ void phase_conv1(const Params& p) {
  const int tidx_ = opaque_tid();
  const int gtid = blockIdx.x * 256 + tidx_, gsz = gridDim.x * 256;
  const bf16_t* BG = (const bf16_t*)(p.ws + OFF_R1);
  const bf16_t* U1 = (const bf16_t*)(p.ws + OFF_R1 + 128 * MBY);
  bf16_t* Y = (bf16_t*)(p.ws + OFF_H);
  const float* cw = p.in[24];
  for (int mt_ = blockIdx.x; mt_ < 512; mt_ += gridDim.x)
  for (int j_ = tidx_; j_ < 16384; j_ += 256) {
    const int t = mt_ * 128 + (j_ >> 7), c = (j_ & 127) * 8;
    SeqInfo si = seq_of(t);
    float acc[8];
#pragma unroll
    for (int j = 0; j < 8; j++) acc[j] = 0.f;
#pragma unroll
    for (int k = 0; k < 3; k++) {
      const int tt = t + k - 1;
      if (tt >= si.s0 && tt < si.s0 + si.S) {
        uint4 v = *(const uint4*)(U1 + (size_t)tt * 1024 + c);
        const float* w = cw + k * 1024 + c;
        acc[0] += w[0] * lo2f(v.x); acc[1] += w[1] * hi2f(v.x);
        acc[2] += w[2] * lo2f(v.y); acc[3] += w[3] * hi2f(v.y);
        acc[4] += w[4] * lo2f(v.z); acc[5] += w[5] * hi2f(v.z);
        acc[6] += w[6] * lo2f(v.w); acc[7] += w[7] * hi2f(v.w);
      }
    }
    uint4 b = *(const uint4*)(BG + (size_t)t * 1024 + c);
    float bf[8]; unpack8(b, bf);
#pragma unroll
    for (int j = 0; j < 8; j++) acc[j] *= bf[j];
    *(uint4*)(Y + (size_t)t * 1024 + c) = pack8(acc);
  }
}

__device__ __forceinline__ void gbar_sync(unsigned* bar, unsigned& gen) {
  __syncthreads();
  gen++;
  if (threadIdx.x == 0) {
    __builtin_amdgcn_fence(__ATOMIC_RELEASE, "agent");
    const unsigned G = gridDim.x, b = blockIdx.x, x = b & 7u, y = (b >> 3) & 7u;
    const unsigned nA = (G - (x + 8u * y) + 63u) / 64u;
    const unsigned nBf = (G - x + 7u) / 8u, nB = nBf < 8u ? nBf : 8u;
    const unsigned nR = G < 8u ? G : 8u;
    unsigned* cA = bar + (x * 8u + y) * 16u;
    unsigned* cB = bar + 1024u + x * 16u;
    unsigned* cR = bar + 1024u + 128u;
    unsigned* fl = bar + 1024u + 256u;
    if (atomicAdd(cA, 1u) == nA - 1u) {
      atomicExch(cA, 0u);
      if (atomicAdd(cB, 1u) == nB - 1u) {
        atomicExch(cB, 0u);
        if (atomicAdd(cR, 1u) == nR - 1u) {
          atomicExch(cR, 0u);
          __builtin_amdgcn_fence(__ATOMIC_RELEASE, "agent");
#pragma unroll
          for (int i = 0; i < 8; i++) __hip_atomic_store(fl + i * 16, gen, __ATOMIC_RELAXED, __HIP_MEMORY_SCOPE_AGENT);
        }
      }
    }
    unsigned spins = 0;
    while (__hip_atomic_load(fl + x * 16u, __ATOMIC_RELAXED, __HIP_MEMORY_SCOPE_AGENT) < gen) {
      __builtin_amdgcn_s_sleep(2);
      if (++spins > (1u << 18)) break;
    }
    __builtin_amdgcn_fence(__ATOMIC_ACQUIRE, "agent");
  }
  __syncthreads();
}

#ifndef PROBE_MASK
#define PROBE_MASK 0
#endif
#ifndef PROBE_K
#define PROBE_K 1
#endif
#if PROBE_MASK
#define STAMP(k) do { if (blockIdx.x == 0 && threadIdx.x == 0) ((volatile unsigned long long*)(ws + OFF_CNT + 1024))[k] = wall_clock64(); } while (0)
#else
#define STAMP(k) do { } while (0)
#endif
__global__ void __launch_bounds__(256, 2) mega_fwd(Params p) {
  extern __shared__ __attribute__((aligned(16))) unsigned char smem[];
  cg::grid_group grid = cg::this_grid();
  bf16_t* sm = (bf16_t*)smem;
  unsigned char* ws = p.ws;
  unsigned* bar_ = (unsigned*)(ws + OFF_BAR);
  unsigned bgen_ = 0;

  STAMP(0);
  phase_prep(p, smem);
  gbar_sync(bar_, bgen_); STAMP(1);
  phase_norm(p, 0, 1, true);
  gbar_sync(bar_, bgen_); STAMP(2);
  phase_g1(p, sm);
  gbar_sync(bar_, bgen_); STAMP(3);
  phase_conv0(p);
  gbar_sync(bar_, bgen_); STAMP(4);
  phase_g234(p, sm);
  gbar_sync(bar_, bgen_); STAMP(5);
  phase_qkprep_scan1(p);
  gbar_sync(bar_, bgen_); STAMP(6); STAMP(7);
  phase_attn_scan3(p, sm);
  gbar_sync(bar_, bgen_); STAMP(8);
  phase_gres_norm(p, (const bf16_t*)(ws + OFF_R1), (const bf16_t*)(ws + OFF_WOUT), 0, true, sm);
  STAMP(9);
  __syncthreads();
  STAMP(10); STAMP(11);
  phase_topk(p, 0, sm);
  phase_uvconv(p, 0);
  gbar_sync(bar_, bgen_); STAMP(12);
  phase_gatherU(p);
  gbar_sync(bar_, bgen_);
  phase_gatherV(p, 0);
  gbar_sync(bar_, bgen_); STAMP(13);
  STAMP(14);
  phase_g8(p, sm);
  gbar_sync(bar_, bgen_); STAMP(15);
  phase_conv1(p);
  __syncthreads(); STAMP(16);
  phase_gres_norm(p, (const bf16_t*)(ws + OFF_H), (const bf16_t*)(ws + OFF_WCOUT), 1, false, sm);
  STAMP(17);
  __syncthreads();
  STAMP(18); STAMP(19);
  phase_topk(p, 1, sm);
  phase_uvconv(p, 1);
  gbar_sync(bar_, bgen_); STAMP(20);
  phase_gatherU(p);
  gbar_sync(bar_, bgen_);
  phase_gatherV(p, 1);
  if (p.ws == nullptr) grid.sync();
#if PROBE_MASK
  gbar_sync(bar_, bgen_); STAMP(21);
  __threadfence();
  gbar_sync(bar_, bgen_);
  {
    const volatile unsigned long long* ts = (const volatile unsigned long long*)(ws + OFF_CNT + 1024);
    unsigned long long tot = 0;
    for (int k = 0; k < 21; k++) if ((PROBE_MASK >> k) & 1) tot += ts[k + 1] - ts[k];
    tot *= PROBE_K;
    const unsigned long long t0 = wall_clock64();
    while (wall_clock64() - t0 < tot) { }
  }
#endif
}

extern "C" void kernel_launch(void* const* d_in, const int* in_sizes, int n_in, void* d_out, int out_size, void* d_ws,
                              size_t ws_size, hipStream_t stream) {
  static int grid_blocks = 0;
  if (grid_blocks == 0) {
    if (n_in != 31 || ws_size < WS_NEED) {
      fprintf(stderr, "kernel_launch: unexpected n_in %d or ws_size %zu (< %zu)\n", n_in, ws_size, (size_t)WS_NEED);
      grid_blocks = -1;
      return;
    }
    int dev = 0, cus = 0, per_cu = 0;
    hipGetDevice(&dev);
    hipDeviceGetAttribute(&cus, hipDeviceAttributeMultiprocessorCount, dev);
    if (hipFuncSetAttribute((const void*)mega_fwd, hipFuncAttributeMaxDynamicSharedMemorySize, LDS_BYTES) != hipSuccess) {
      fprintf(stderr, "kernel_launch: hipFuncSetAttribute failed\n");
      grid_blocks = -1;
      return;
    }
    hipOccupancyMaxActiveBlocksPerMultiprocessor(&per_cu, (const void*)mega_fwd, 256, LDS_BYTES);
    if (per_cu < 1) per_cu = 1;
    if (per_cu > 2) per_cu = 2;
    grid_blocks = cus * per_cu;
    fprintf(stderr, "kernel_launch: cus %d per_cu %d grid %d ws %zu\n", cus, per_cu, grid_blocks, ws_size);
  }
  if (grid_blocks < 0) return;
  Params p{};
  for (int i = 0; i < 31; i++) p.in[i] = (const float*)d_in[i];
  p.out = (float*)d_out;
  p.ws = (unsigned char*)d_ws;
  (void)hipMemsetAsync((char*)d_ws + OFF_BAR, 0, 16384, stream);
  void* args[] = {&p};
  hipError_t e = hipLaunchCooperativeKernel((const void*)mega_fwd, dim3(grid_blocks), dim3(256), args, LDS_BYTES, stream);
  if (e != hipSuccess) fprintf(stderr, "cooperative launch failed: %s (grid %d)\n", hipGetErrorString(e), grid_blocks);
}
```

```cpp
#include <hip/hip_runtime.h>
#include <hip/hip_cooperative_groups.h>
#include <cstdio>
#include <cstdint>
namespace cg = cooperative_groups;

typedef unsigned short bf16_t;
using bf16x8 = __attribute__((ext_vector_type(8))) short;
using bf16x4 = __attribute__((ext_vector_type(4))) short;
using f32x16 = __attribute__((ext_vector_type(16))) float;

#define T_TOK 65536
#define EPSN 1e-6f

struct Params {
  const float* in[31];
  float* out;
  unsigned char* ws;
};

constexpr size_t MBY = (size_t)1 << 20;
constexpr size_t OFF_WIN = 0;
constexpr size_t OFF_WUQ = OFF_WIN + (size_t)1536 * 1024 * 2;
constexpr size_t OFF_WUKV = OFF_WUQ + (size_t)768 * 256 * 2;
constexpr size_t OFF_WGATE = OFF_WUKV + (size_t)1024 * 128 * 2;
constexpr size_t OFF_WOUT = OFF_WGATE + (size_t)16 * 128 * 64 * 2;
constexpr size_t OFF_WCIN = OFF_WOUT + (size_t)1024 * 1024 * 2;
constexpr size_t OFF_WCOUT = OFF_WCIN + (size_t)3072 * 1024 * 2;
constexpr size_t OFF_WPQ = OFF_WCOUT + (size_t)1024 * 1024 * 2;
constexpr size_t OFF_KEYS = OFF_WPQ + (size_t)2 * 2048 * 1024 * 2;
constexpr size_t OFF_MOD = OFF_KEYS + (size_t)4 * 128 * 128 * 2;
constexpr size_t OFF_C8 = OFF_MOD + (size_t)2 * 10 * 6144 * 4;
constexpr size_t OFF_RSTDQ = OFF_C8 + 4096;
constexpr size_t OFF_RSTDKV = OFF_RSTDQ + (size_t)T_TOK * 4;
constexpr size_t OFF_AGGA = OFF_RSTDKV + (size_t)T_TOK * 4;
constexpr size_t OFF_AGGB = OFF_AGGA + 2 * MBY;
constexpr size_t OFF_CARRY = OFF_AGGB + 2 * MBY;
constexpr size_t OFF_CNT = OFF_CARRY + 2 * MBY;
constexpr size_t OFF_BAR = OFF_CNT + 8192;
static_assert(OFF_BAR + 8192 < 40 * MBY, "small region overflow");
constexpr size_t OFF_H = 40 * MBY;
constexpr size_t OFF_R1 = 168 * MBY;
constexpr size_t OFF_Z2 = OFF_R1 + 128 * MBY;
constexpr size_t OFF_XC = OFF_R1 + 180 * MBY;
constexpr size_t OFF_B = 424 * MBY;
constexpr size_t OFF_VT = OFF_B + 96 * MBY;
constexpr size_t OFF_UT = OFF_B;
constexpr size_t OFF_VTAB = OFF_B + 32 * MBY;
constexpr size_t OFF_IDX = OFF_B + 64 * MBY;
constexpr size_t OFF_GW = OFF_B + 96 * MBY;
constexpr size_t WS_NEED = 584 * MBY;

#define LDS_BYTES 73728

__device__ __forceinline__ float bf2f(unsigned short h) { return __uint_as_float(((unsigned)h) << 16); }
__device__ __forceinline__ unsigned short f2bf(float f) {
  unsigned u = __float_as_uint(f);
  u += 0x7fffu + ((u >> 16) & 1u);
  return (unsigned short)(u >> 16);
}
typedef __bf16 hwbf16x2 __attribute__((ext_vector_type(2)));
typedef float f32x2 __attribute__((ext_vector_type(2)));
__device__ __forceinline__ unsigned pack2(float a, float b) {
  f32x2 v = {a, b};
  hwbf16x2 r = __builtin_convertvector(v, hwbf16x2);
  return *(unsigned*)&r;
}
__device__ __forceinline__ float lo2f(unsigned u) { return __uint_as_float(u << 16); }
__device__ __forceinline__ float hi2f(unsigned u) { return __uint_as_float(u & 0xffff0000u); }
__device__ __forceinline__ float fexp2(float x) { return __builtin_amdgcn_exp2f(x); }
__device__ __forceinline__ float frcp(float x) { return __builtin_amdgcn_rcpf(x); }
__device__ __forceinline__ float gelu_t(float x) {
  float u = 0.7978845608f * (x + 0.044715f * x * x * x);
  float t = 1.f - 2.f * frcp(1.f + fexp2(u * 2.8853900817779268f));
  return 0.5f * x * (1.f + t);
}
__device__ __forceinline__ float sigmoid_f(float x) { return frcp(1.f + fexp2(-1.4426950408889634f * x)); }
__device__ __forceinline__ float wave_sum(float v) {
#pragma unroll
  for (int o = 32; o > 0; o >>= 1) v += __shfl_xor(v, o);
  return v;
}
__device__ __forceinline__ int opaque_tid() { int t = threadIdx.x; asm volatile("" : "+v"(t)); return t; }
struct SeqInfo { int b, s0, S; };
__device__ __forceinline__ SeqInfo seq_of(int t) {
  SeqInfo r;
  if (t < 32768) { r.b = t >> 14; r.s0 = r.b << 14; r.S = 16384; }
  else { int u = (t - 32768) >> 12; r.b = 2 + u; r.s0 = 32768 + (u << 12); r.S = 4096; }
  return r;
}
__device__ __forceinline__ const float* xin_row(const Params& p, int t) {
  return t < 32768 ? p.in[0] + (size_t)t * 1024 : p.in[1] + (size_t)(t - 32768) * 1024;
}

#define GT_BUF 16384
__device__ __forceinline__ void gemm_tile(const bf16_t* __restrict__ A, int lda, const bf16_t* __restrict__ B, int ldb,
                                          int K, f32x16 (&acc)[2][2], bf16_t* sm) {
  const int tidx_ = opaque_tid();
  const int tid = tidx_, lane = tid & 63, wave = tid >> 6, wm = wave >> 1, wn = wave & 1;
  const int nk = K >> 6;
  const bf16_t* src = wave < 2 ? A : B;
  const unsigned ld = (unsigned)(wave < 2 ? lda : ldb);
  const int i0 = (wave & 1) * 8;
  char* dbase = (char*)sm + (wave >> 1) * 16384 + i0 * 1024 + lane * 16;
#define GOFF(j_) ({ const unsigned s_ = (unsigned)((i0 + (j_)) * 64 + lane); const unsigned r_ = s_ >> 3; const unsigned c_ = (s_ & 7u) ^ ((r_ >> 1) & 7u); r_ * ld + c_ * 8u; })
  const unsigned g0 = GOFF(0), g1 = GOFF(1), g2 = GOFF(2), g3 = GOFF(3), g4 = GOFF(4), g5 = GOFF(5), g6 = GOFF(6), g7 = GOFF(7);
#undef GOFF
#define DMA1(gj_, j_, sp_, db_) __builtin_amdgcn_global_load_lds((const unsigned*)((sp_) + (gj_)), (unsigned __attribute__((address_space(3)))*)((db_) + (j_) * 1024), 16, 0, 0)
#define DMA_TILE(kt_, buf_)                                                       \
  {                                                                               \
    const bf16_t* sp_ = src + (kt_) * 64;                                         \
    char* db_ = dbase + (buf_) * (GT_BUF * 2);                                    \
    DMA1(g0, 0, sp_, db_); DMA1(g1, 1, sp_, db_); DMA1(g2, 2, sp_, db_);          \
    DMA1(g3, 3, sp_, db_); DMA1(g4, 4, sp_, db_); DMA1(g5, 5, sp_, db_);          \
    DMA1(g6, 6, sp_, db_); DMA1(g7, 7, sp_, db_);                                 \
  }
  DMA_TILE(0, 0);
#pragma unroll
  for (int mi = 0; mi < 2; mi++)
#pragma unroll
    for (int ni = 0; ni < 2; ni++)
#pragma unroll
      for (int r = 0; r < 16; r++) acc[mi][ni][r] = 0.f;
  asm volatile("s_waitcnt vmcnt(0)" ::: "memory");
  __syncthreads();
  const int sw = ((lane & 31) >> 1) & 7, hh = lane >> 5;
  const int arow = (wm * 64 + (lane & 31)) * 64;
  const int brow = 8192 + (wn * 64 + (lane & 31)) * 64;
  for (int kt = 0; kt < nk; ++kt) {
    if (kt + 1 < nk) DMA_TILE(kt + 1, (kt + 1) & 1);
    const bf16_t* cA = sm + (kt & 1) * GT_BUF;
#pragma unroll
    for (int kk = 0; kk < 4; ++kk) {
      const int pc = ((kk * 2 + hh) ^ sw) * 8;
      bf16x8 a[2], b[2];
#pragma unroll
      for (int mi = 0; mi < 2; mi++) a[mi] = *(const bf16x8*)(cA + arow + mi * 32 * 64 + pc);
#pragma unroll
      for (int ni = 0; ni < 2; ni++) b[ni] = *(const bf16x8*)(cA + brow + ni * 32 * 64 + pc);
#pragma unroll
      for (int mi = 0; mi < 2; mi++)
#pragma unroll
        for (int ni = 0; ni < 2; ni++)
          acc[mi][ni] = __builtin_amdgcn_mfma_f32_32x32x16_bf16(a[mi], b[ni], acc[mi][ni], 0, 0, 0);
    }
    asm volatile("s_waitcnt vmcnt(0)" ::: "memory");
    __syncthreads();
  }
#undef DMA1
#undef DMA_TILE
}

#define CS_LD 136
__device__ __forceinline__ void gemm_ldsA_k128(const bf16_t* __restrict__ B, f32x16 (&acc)[2][2], bf16_t* sm) {
  const int tidx_ = opaque_tid();
  const int tid = tidx_, lane = tid & 63, wave = tid >> 6, wm = wave >> 1, wn = wave & 1;
  const int lr = tid >> 3, lc = (tid & 7) * 8;
  const bf16_t* Bp = B + (size_t)lr * 128 + lc;
  bf16_t* sB = sm + 128 * CS_LD;
  uint4 b0 = *(const uint4*)(Bp), b1 = *(const uint4*)(Bp + 32 * 128), b2 = *(const uint4*)(Bp + 64 * 128), b3 = *(const uint4*)(Bp + 96 * 128);
  uint4 c0 = *(const uint4*)(Bp + 64), c1 = *(const uint4*)(Bp + 32 * 128 + 64), c2 = *(const uint4*)(Bp + 64 * 128 + 64), c3 = *(const uint4*)(Bp + 96 * 128 + 64);
  const int so = lr * 72 + lc;
  *(uint4*)(sB + so) = b0; *(uint4*)(sB + so + 32 * 72) = b1; *(uint4*)(sB + so + 64 * 72) = b2; *(uint4*)(sB + so + 96 * 72) = b3;
  *(uint4*)(sB + 128 * 72 + so) = c0; *(uint4*)(sB + 128 * 72 + so + 32 * 72) = c1;
  *(uint4*)(sB + 128 * 72 + so + 64 * 72) = c2; *(uint4*)(sB + 128 * 72 + so + 96 * 72) = c3;
#pragma unroll
  for (int mi = 0; mi < 2; mi++)
#pragma unroll
    for (int ni = 0; ni < 2; ni++)
#pragma unroll
      for (int r = 0; r < 16; r++) acc[mi][ni][r] = 0.f;
  __syncthreads();
  const int aoff = (wm * 64 + (lane & 31)) * CS_LD + (lane >> 5) * 8;
  const int boff = (wn * 64 + (lane & 31)) * 72 + (lane >> 5) * 8;
#pragma unroll
  for (int kt = 0; kt < 2; kt++)
#pragma unroll
    for (int kk = 0; kk < 4; ++kk) {
      bf16x8 a[2], b[2];
#pragma unroll
      for (int mi = 0; mi < 2; mi++) a[mi] = *(const bf16x8*)(sm + aoff + mi * 32 * CS_LD + kt * 64 + kk * 16);
#pragma unroll
      for (int ni = 0; ni < 2; ni++) b[ni] = *(const bf16x8*)(sB + kt * 128 * 72 + boff + ni * 32 * 72 + kk * 16);
#pragma unroll
      for (int mi = 0; mi < 2; mi++)
#pragma unroll
        for (int ni = 0; ni < 2; ni++)
          acc[mi][ni] = __builtin_amdgcn_mfma_f32_32x32x16_bf16(a[mi], b[ni], acc[mi][ni], 0, 0, 0);
    }
  __syncthreads();
}

#define EPI_ROW(wm, mi, r, lane) ((wm) * 64 + (mi) * 32 + 8 * ((r) >> 2) + 4 * ((lane) >> 5) + ((r) & 3))
#define EPI_COL(wn, ni, lane) ((wn) * 64 + (ni) * 32 + ((lane) & 31))

template <class F>
__device__ __forceinline__ void tconv(bf16_t* dst, int N, int K, F src, float* tile, int& rot) {
  const int tidx_ = opaque_tid();
  const int tn = N >> 6, tk = K >> 6;
  int first = (int)blockIdx.x - rot; if (first < 0) first += gridDim.x;
  rot = (rot + tn * tk) % (int)gridDim.x;
  for (int it = first; it < tn * tk; it += gridDim.x) {
    const int n0 = (it % tn) << 6, k0 = (it / tn) << 6;
    for (int i = tidx_; i < 4096; i += 256) { int kk = i >> 6, nn = i & 63; tile[kk * 65 + nn] = src(k0 + kk, n0 + nn); }
    __syncthreads();
    for (int i = tidx_; i < 4096; i += 256) { int nn = i >> 6, kk = i & 63; dst[(size_t)(n0 + nn) * K + k0 + kk] = f2bf(tile[kk * 65 + nn]); }
    __syncthreads();
  }
}

__device__ __forceinline__ void phase_prep(const Params& p, unsigned char* smem) {
  const int tidx_ = opaque_tid();
  unsigned char* ws = p.ws;
  float* tile = (float*)smem;
  int rot = 0;
  const int tid = tidx_;
  const int gtid = blockIdx.x * 256 + tid, gsz = gridDim.x * 256;
  {
    const float* w_in = p.in[8];
    tconv((bf16_t*)(ws + OFF_WIN), 1536, 1024, [=](int k, int n) { return n < 1440 ? w_in[(size_t)k * 1440 + n] : 0.f; }, tile, rot);
    const float* w_uq = p.in[17]; const float* qn = p.in[16];
    tconv((bf16_t*)(ws + OFF_WUQ), 768, 256, [=](int k, int n) { return w_uq[k * 768 + n] * qn[k]; }, tile, rot);
    const float* w_ukv = p.in[19]; const float* kvn = p.in[18];
    tconv((bf16_t*)(ws + OFF_WUKV), 1024, 128, [=](int k, int n) { return w_ukv[k * 1024 + n] * kvn[k]; }, tile, rot);
    const float* wa = p.in[11]; const float* wx = p.in[13];
    for (int hd = 0; hd < 16; ++hd) {
      const int h = hd >> 1, d = hd & 1;
      tconv((bf16_t*)(ws + OFF_WGATE) + hd * 128 * 64, 128, 64, [=](int k, int n) {
        int wn = n >> 6, ty = (n >> 5) & 1, j = n & 31; int c = wn * 32 + j;
        const float* W = ty ? wx : wa;
        return W[((d * 8 + h) * 64 + k) * 64 + c]; }, tile, rot);
    }
    const float* w_out = p.in[22];
    tconv((bf16_t*)(ws + OFF_WOUT), 1024, 1024, [=](int k, int n) { return w_out[((k + 512) & 1023) * 1024 + n]; }, tile, rot);
    const float* c_w_in = p.in[23];
    tconv((bf16_t*)(ws + OFF_WCIN), 3072, 1024, [=](int k, int n) {
      int col;
      if (n < 1024) col = n;
      else { int q = n - 1024; int tl = q >> 7, wi = q & 127; int wn = wi >> 6, ty = (wi >> 5) & 1, j = wi & 31; col = 1024 + ty * 1024 + tl * 64 + wn * 32 + j; }
      return c_w_in[(size_t)k * 3072 + col]; }, tile, rot);
    const float* c_w_out = p.in[25];
    tconv((bf16_t*)(ws + OFF_WCOUT), 1024, 1024, [=](int k, int n) { return c_w_out[k * 1024 + n]; }, tile, rot);
    const float* wq = p.in[26];
    for (int l = 0; l < 2; ++l)
      tconv((bf16_t*)(ws + OFF_WPQ) + (size_t)l * 2048 * 1024, 2048, 1024, [=](int k, int n) { return wq[((size_t)(l * 1024 + k)) * 2048 + n]; }, tile, rot);
  }
  {
    bf16_t* keys = (bf16_t*)(ws + OFF_KEYS);
    const float* k1 = p.in[27]; const float* k2 = p.in[28];
    for (int i = gtid; i < 65536; i += gsz) {
      int l = i >> 15, pp = (i >> 14) & 1, r = i & 16383;
      keys[i] = f2bf((pp ? k2 : k1)[l * 16384 + r]);
    }
    float* c8 = (float*)(ws + OFF_C8);
    const float* lam = p.in[15];
    for (int i = gtid; i < 1024; i += gsz) c8[i] = 8.f * log1pf(__expf(-lam[i])) * 1.44269504f;
    if (gtid < 16) ((int*)(ws + OFF_CNT))[gtid] = 0;
    for (int i = gtid; i < 2048; i += gsz) ((unsigned*)(ws + OFF_BAR))[i] = 0u;
  }
  {
    float* silu_s = (float*)smem;
    float* red = silu_s + 10240;
    float* mod = (float*)(ws + OFF_MOD);
    const float* cp = p.in[2]; const float* cs = p.in[3];
    const float* ada_w = p.in[4]; const float* ada_b = p.in[5];
    __syncthreads();
    for (int i = tid; i < 10240; i += 256) {
      int b = i >> 10, k = i & 1023;
      float c = b < 2 ? cp[b * 1024 + k] : cs[(b - 2) * 1024 + k];
      silu_s[i] = c / (1.f + __expf(-c));
    }
    __syncthreads();
    for (int it = blockIdx.x; it < 192; it += gridDim.x) {
      const int l = it / 96, n = (it % 96) * 64 + (tid & 63), kq = tid >> 6;
      float acc[10];
#pragma unroll
      for (int b = 0; b < 10; b++) acc[b] = 0.f;
#pragma unroll 8
      for (int k = kq * 256; k < kq * 256 + 256; ++k) {
        float w = ada_w[((size_t)(l * 1024 + k)) * 6144 + n];
#pragma unroll
        for (int b = 0; b < 10; b++) acc[b] += silu_s[b * 1024 + k] * w;
      }
#pragma unroll
      for (int b = 0; b < 10; b++) red[(kq * 10 + b) * 64 + (tid & 63)] = acc[b];
      __syncthreads();
      if (tid < 64) {
#pragma unroll
        for (int b = 0; b < 10; b++)
          mod[(l * 10 + b) * 6144 + n] = ada_b[l * 6144 + n] + red[(0 * 10 + b) * 64 + tid] + red[(1 * 10 + b) * 64 + tid] +
                                         red[(2 * 10 + b) * 64 + tid] + red[(3 * 10 + b) * 64 + tid];
      }
      __syncthreads();
    }
  }
}

#define U_SCALE 64.f
#define V_SCALE 8.f
__device__ __forceinline__ unsigned pack_fp8x4(float4 a, float sc) {
  int pk = __builtin_amdgcn_cvt_pk_fp8_f32(a.x * sc, a.y * sc, 0, false);
  pk = __builtin_amdgcn_cvt_pk_fp8_f32(a.z * sc, a.w * sc, pk, true);
  return (unsigned)pk;
}
__device__ __forceinline__ void phase_uvconv(const Params& p, int l, int part, int nparts) {
  const int tidx_ = opaque_tid();
  const int gtid = blockIdx.x * 256 + tidx_, gsz = gridDim.x * 256;
  const float4* us = (const float4*)(p.in[29] + (size_t)l * 16384 * 1024);
  const float4* vs = (const float4*)(p.in[30] + (size_t)l * 16384 * 1024);
  unsigned* ud = (unsigned*)(p.ws + OFF_UT);
  unsigned* vd = (unsigned*)(p.ws + OFF_VTAB);
  for (int i = gtid + part * gsz; i < 16384 * 256; i += gsz * nparts) {
    ud[i] = pack_fp8x4(us[i], U_SCALE);
    vd[i] = pack_fp8x4(vs[i], V_SCALE);
  }
}

__device__ __forceinline__ void phase_norm(const Params& p, int layer, int which, bool from_input) {
  const int tidx_ = opaque_tid();
  const int lane = tidx_ & 63;
  const int gw = (blockIdx.x * 256 + tidx_) >> 6, nw = gridDim.x * 4;
  const float* g = (which == 1 ? p.in[6] : p.in[7]) + layer * 1024;
  const float* mod = (const float*)(p.ws + OFF_MOD);
  bf16_t* H = (bf16_t*)(p.ws + OFF_H);
  for (int t = gw; t < T_TOK; t += nw) {
    SeqInfo si = seq_of(t);
    const float* x = from_input ? xin_row(p, t) : p.out + (size_t)t * 1024;
    const float* md = mod + (layer * 10 + si.b) * 6144 + (which == 1 ? 0 : 3 * 1024);
    float4 v[4];
    float ss = 0.f;
#pragma unroll
    for (int j = 0; j < 4; j++) {
      v[j] = *(const float4*)(x + j * 256 + lane * 4);
      ss += v[j].x * v[j].x + v[j].y * v[j].y + v[j].z * v[j].z + v[j].w * v[j].w;
    }
    ss = wave_sum(ss);
    const float rstd = rsqrtf(ss * (1.f / 1024.f) + EPSN);
#pragma unroll
    for (int j = 0; j < 4; j++) {
      const int idx = j * 256 + lane * 4;
      float4 gg = *(const float4*)(g + idx);
      float4 sh = *(const float4*)(md + idx);
      float4 sc = *(const float4*)(md + 1024 + idx);
      float y0 = v[j].x * rstd * gg.x * (1.f + sc.x) + sh.x;
      float y1 = v[j].y * rstd * gg.y * (1.f + sc.y) + sh.y;
      float y2 = v[j].z * rstd * gg.z * (1.f + sc.z) + sh.z;
      float y3 = v[j].w * rstd * gg.w * (1.f + sc.w) + sh.w;
      *(uint2*)(H + (size_t)t * 1024 + idx) = make_uint2(pack2(y0, y1), pack2(y2, y3));
    }
  }
}

#define XCD_TILE_LOOP(NT_, mt_, nt_)                                                               \
  for (int li_ = (int)(blockIdx.x >> 3), mt_ = 0, nt_ = 0;                                          \
       li_ < 64 * (NT_) && ((mt_ = (li_ / (NT_)) * 8 + (int)(blockIdx.x & 7)), (nt_ = li_ % (NT_)), true); \
       li_ += (int)(gridDim.x >> 3))

__device__ __forceinline__ void tile_copy_out(const bf16_t* cs, bf16_t* dst, size_t ldd, int nchunk_log2) {
  const int tidx_ = opaque_tid();
  const int per_row = 1 << nchunk_log2;
  const int total = 128 << nchunk_log2;
  for (int c = tidx_; c < total; c += 256) {
    const int row = c >> nchunk_log2, cc = c & (per_row - 1);
    const uint4 v = *(const uint4*)(cs + row * CS_LD + cc * 8);
    *(uint4*)(dst + (size_t)row * ldd + cc * 8) = v;
  }
}

__device__ __forceinline__ void phase_g1(const Params& p, bf16_t* sm) {
  const int tidx_ = opaque_tid();
  const int lane = tidx_ & 63, wave = tidx_ >> 6, wm = wave >> 1, wn = wave & 1;
  const bf16_t* H = (const bf16_t*)(p.ws + OFF_H);
  const bf16_t* W = (const bf16_t*)(p.ws + OFF_WIN);
  bf16_t* Z1 = (bf16_t*)(p.ws + OFF_R1);
  bf16_t* Z2 = (bf16_t*)(p.ws + OFF_Z2);
  XCD_TILE_LOOP(12, mt, nt) {
    f32x16 acc[2][2];
    gemm_tile(H + (size_t)mt * 128 * 1024, 1024, W + (size_t)nt * 128 * 1024, 1024, 1024, acc, sm);
#pragma unroll
    for (int mi = 0; mi < 2; mi++)
#pragma unroll
      for (int ni = 0; ni < 2; ni++)
#pragma unroll
        for (int r = 0; r < 16; r++)
          sm[EPI_ROW(wm, mi, r, lane) * CS_LD + EPI_COL(wn, ni, lane)] = f2bf(acc[mi][ni][r]);
    __syncthreads();
    if (nt < 8) tile_copy_out(sm, Z1 + (size_t)mt * 128 * 1024 + nt * 128, 1024, 4);
    else if (nt < 11) tile_copy_out(sm, Z2 + (size_t)mt * 128 * 416 + (nt - 8) * 128, 416, 4);
    else tile_copy_out(sm, Z2 + (size_t)mt * 128 * 416 + 384, 416, 2);
    __syncthreads();
  }
}

__device__ __forceinline__ void phase_conv0(const Params& p) {
  const int tidx_ = opaque_tid();
  const int gtid = blockIdx.x * 256 + tidx_, gsz = gridDim.x * 256;
  const bf16_t* Z1 = (const bf16_t*)(p.ws + OFF_R1);
  const bf16_t* Z2 = (const bf16_t*)(p.ws + OFF_Z2);
  bf16_t* XC = (bf16_t*)(p.ws + OFF_XC);
  const float* cw = p.in[9]; const float* cb = p.in[10];
  for (int i = gtid; i < T_TOK * 64; i += gsz) {
    const int t = i >> 6, c = (i & 63) * 8;
    SeqInfo si = seq_of(t);
    float acc[8];
#pragma unroll
    for (int j = 0; j < 8; j++) acc[j] = cb[c + j];
#pragma unroll
    for (int k = 0; k < 4; k++) {
      const int tt = t + k - 2;
      if (tt >= si.s0 && tt < si.s0 + si.S) {
        uint4 v = *(const uint4*)(Z1 + (size_t)tt * 1024 + c);
        const float* w = cw + k * 512 + c;
        acc[0] += w[0] * lo2f(v.x); acc[1] += w[1] * hi2f(v.x);
        acc[2] += w[2] * lo2f(v.y); acc[3] += w[3] * hi2f(v.y);
        acc[4] += w[4] * lo2f(v.z); acc[5] += w[5] * hi2f(v.z);
        acc[6] += w[6] * lo2f(v.w); acc[7] += w[7] * hi2f(v.w);
      }
    }
    *(uint4*)(XC + (size_t)t * 512 + c) = make_uint4(pack2(acc[0], acc[1]), pack2(acc[2], acc[3]), pack2(acc[4], acc[5]), pack2(acc[6], acc[7]));
  }
  const int lane = tidx_ & 63;
  const int gw = gtid >> 6, nw = gsz >> 6;
  float* rq = (float*)(p.ws + OFF_RSTDQ);
  float* rkv = (float*)(p.ws + OFF_RSTDKV);
  for (int t = gw; t < T_TOK; t += nw) {
    const bf16_t* z = Z2 + (size_t)t * 416;
    uint2 a = *(const uint2*)(z + lane * 4);
    unsigned b = *(const unsigned*)(z + 256 + lane * 2);
    float ssq = lo2f(a.x) * lo2f(a.x) + hi2f(a.x) * hi2f(a.x) + lo2f(a.y) * lo2f(a.y) + hi2f(a.y) * hi2f(a.y);
    float ssk = lo2f(b) * lo2f(b) + hi2f(b) * hi2f(b);
    ssq = wave_sum(ssq); ssk = wave_sum(ssk);
    if (lane == 0) { rq[t] = rsqrtf(ssq * (1.f / 256.f) + EPSN); rkv[t] = rsqrtf(ssk * (1.f / 128.f) + EPSN); }
  }
}

__device__ __forceinline__ void phase_g234(const Params& p, bf16_t* sm) {
  const int tidx_ = opaque_tid();
  const int lane = tidx_ & 63, wave = tidx_ >> 6, wm = wave >> 1, wn = wave & 1;
  const bf16_t* Z2 = (const bf16_t*)(p.ws + OFF_Z2);
  const bf16_t* XC = (const bf16_t*)(p.ws + OFF_XC);
  bf16_t* QR = (bf16_t*)(p.ws + OFF_H);
  bf16_t* Kb = (bf16_t*)(p.ws + OFF_B);
  bf16_t* Vt = (bf16_t*)(p.ws + OFF_VT);
  unsigned* AB = (unsigned*)p.out;
  const float* rq = (const float*)(p.ws + OFF_RSTDQ);
  const float* rkv = (const float*)(p.ws + OFF_RSTDKV);
  const float* c8 = (const float*)(p.ws + OFF_C8);
  for (int it = blockIdx.x; it < 15360; it += gridDim.x) {
    f32x16 acc[2][2];
    if (it < 3072) {
      const int mt = it / 6, nt = it % 6;
      gemm_tile(Z2 + (size_t)mt * 128 * 416, 416, (const bf16_t*)(p.ws + OFF_WUQ) + nt * 128 * 256, 256, 256, acc, sm);
#pragma unroll
      for (int mi = 0; mi < 2; mi++)
#pragma unroll
        for (int r = 0; r < 16; r++) {
          const int rl = EPI_ROW(wm, mi, r, lane);
          const float rs = rq[mt * 128 + rl];
#pragma unroll
          for (int ni = 0; ni < 2; ni++) sm[rl * CS_LD + EPI_COL(wn, ni, lane)] = f2bf(acc[mi][ni][r] * rs);
        }
      __syncthreads();
      tile_copy_out(sm, QR + (size_t)mt * 128 * 768 + nt * 128, 768, 4);
      __syncthreads();
    } else if (it < 7168) {
      const int j = it - 3072;
      const int mt = j >> 3, h = j & 7;
      gemm_tile(Z2 + (size_t)mt * 128 * 416 + 256, 416, (const bf16_t*)(p.ws + OFF_WUKV) + h * 128 * 128, 128, 128, acc, sm);
      SeqInfo si = seq_of(mt * 128);
      if (wn == 0) {
#pragma unroll
        for (int mi = 0; mi < 2; mi++)
#pragma unroll
          for (int r = 0; r < 16; r++) {
            const int row = mt * 128 + EPI_ROW(wm, mi, r, lane);
            const float rs = rkv[row];
            const size_t krow = (size_t)si.s0 * 8 + (size_t)h * si.S + (row - si.s0);
#pragma unroll
            for (int ni = 0; ni < 2; ni++)
              Kb[krow * 96 + ni * 32 + (lane & 31)] = f2bf(acc[mi][ni][r] * rs);
          }
      } else {
        bf16_t* vb = Vt + ((size_t)si.s0 * 8 + (size_t)h * si.S) * 64;
#pragma unroll
        for (int mi = 0; mi < 2; mi++)
#pragma unroll
          for (int rg = 0; rg < 4; rg++) {
            const int t4 = mt * 128 + wm * 64 + mi * 32 + 8 * rg + 4 * (lane >> 5);
            const float r0 = rkv[t4], r1 = rkv[t4 + 1], r2 = rkv[t4 + 2], r3 = rkv[t4 + 3];
#pragma unroll
            for (int ni = 0; ni < 2; ni++) {
              const int dv = ni * 32 + (lane & 31);
              uint2 pk = make_uint2(pack2(acc[mi][ni][rg * 4 + 0] * r0, acc[mi][ni][rg * 4 + 1] * r1),
                                    pack2(acc[mi][ni][rg * 4 + 2] * r2, acc[mi][ni][rg * 4 + 3] * r3));
              const int ps_ = t4 - si.s0;
              const int pp_ = (ps_ & ~12) | ((ps_ & 4) << 1) | ((ps_ & 8) >> 1);
              *(uint2*)(vb + (size_t)dv * si.S + pp_) = pk;
            }
          }
      }
    } else {
      const int j = it - 7168;
      const int mt = j >> 4, hd = j & 15, h = hd >> 1, d = hd & 1;
      gemm_tile(XC + (size_t)mt * 128 * 512 + h * 64, 512, (const bf16_t*)(p.ws + OFF_WGATE) + hd * 128 * 64, 64, 64, acc, sm);
      const int c = h * 64 + wn * 32 + (lane & 31);
      const float ba = p.in[12][d * 512 + c], bx = p.in[14][d * 512 + c], cc8 = c8[d * 512 + c];
#pragma unroll
      for (int mi = 0; mi < 2; mi++)
#pragma unroll
        for (int r = 0; r < 16; r++) {
          const int row = mt * 128 + EPI_ROW(wm, mi, r, lane);
          const float rg = sigmoid_f(acc[mi][0][r] + ba);
          const float ig = sigmoid_f(acc[mi][1][r] + bx);
          const float l2a = -rg * cc8;
          const float a2 = fexp2(2.f * l2a);
          const float xv = bf2f(XC[(size_t)row * 512 + c]);
          const float bb = __builtin_amdgcn_sqrtf(fmaxf(1.f - a2, 0.f)) * ig * xv;
          AB[((size_t)d * T_TOK + row) * 512 + c] = pack2(l2a, bb);
        }
    }
  }
}

__device__ __forceinline__ void unpack8(uint4 v, float* f) {
  f[0] = lo2f(v.x); f[1] = hi2f(v.x); f[2] = lo2f(v.y); f[3] = hi2f(v.y);
  f[4] = lo2f(v.z); f[5] = hi2f(v.z); f[6] = lo2f(v.w); f[7] = hi2f(v.w);
}
__device__ __forceinline__ uint4 pack8(const float* f) {
  return make_uint4(pack2(f[0], f[1]), pack2(f[2], f[3]), pack2(f[4], f[5]), pack2(f[6], f[7]));
}
__device__ __forceinline__ float sumsq8(uint4 v) {
  float a0 = lo2f(v.x), a1 = hi2f(v.x), a2 = lo2f(v.y), a3 = hi2f(v.y), a4 = lo2f(v.z), a5 = hi2f(v.z), a6 = lo2f(v.w), a7 = hi2f(v.w);
  return a0 * a0 + a1 * a1 + a2 * a2 + a3 * a3 + a4 * a4 + a5 * a5 + a6 * a6 + a7 * a7;
}
__device__ __forceinline__ void norm_rope96(uint4 (&v)[12], const float* __restrict__ gain, float outscale, const float (&cs)[16], const float (&sn)[16]) {
  float ss = 0.f;
#pragma unroll
  for (int i = 0; i < 12; i++) ss += sumsq8(v[i]);
  const float rstd = rsqrtf(ss * (1.f / 96.f) + EPSN);
#pragma unroll
  for (int i = 0; i < 8; i++) {
    float f[8]; unpack8(v[i], f);
#pragma unroll
    for (int j = 0; j < 8; j++) f[j] = f[j] * rstd * gain[i * 8 + j] * outscale;
    v[i] = pack8(f);
  }
#pragma unroll
  for (int q = 0; q < 2; q++) {
    float f1[8], f2[8]; unpack8(v[8 + q], f1); unpack8(v[10 + q], f2);
#pragma unroll
    for (int j = 0; j < 8; j++) {
      const float r1 = f1[j] * rstd * gain[64 + q * 8 + j];
      const float r2 = f2[j] * rstd * gain[80 + q * 8 + j];
      const float c = cs[q * 8 + j], s = sn[q * 8 + j];
      f1[j] = (r1 * c - r2 * s) * outscale;
      f2[j] = (r2 * c + r1 * s) * outscale;
    }
    v[8 + q] = pack8(f1); v[10 + q] = pack8(f2);
  }
}

#define QSCALE (0.10206207261596575f * 1.4426950408889634f)

__device__ __forceinline__ void phase_qkprep_scan1(const Params& p) {
  const int tidx_ = opaque_tid();
  const int tid = tidx_;
  bf16_t* QR = (bf16_t*)(p.ws + OFF_H);
  bf16_t* Kb = (bf16_t*)(p.ws + OFF_B);
  const bf16_t* Z2 = (const bf16_t*)(p.ws + OFF_Z2);
  const unsigned* AB = (const unsigned*)p.out;
  float* aggA = (float*)(p.ws + OFF_AGGA);
  float* aggB = (float*)(p.ws + OFF_AGGB);
  for (int it = blockIdx.x; it < 4096; it += gridDim.x) {
    if (it < 2048) {
      const int i = it * 256 + tid;
      const int t = i >> 3, h = i & 7;
      SeqInfo si = seq_of(t);
      const float pos = (float)(t - si.s0);
      float cs[16], sn[16];
#pragma unroll
      for (int k = 0; k < 16; k++) {
        const float inv = exp2f(-(float)k * (13.287712379549449f / 16.f));
        float rev = pos * inv * 0.15915494309189535f;
        rev = rev - floorf(rev);
        cs[k] = __builtin_amdgcn_cosf(rev);
        sn[k] = __builtin_amdgcn_sinf(rev);
      }
      uint4 v[12];
      bf16_t* qp = QR + (size_t)t * 768 + h * 96;
#pragma unroll
      for (int k = 0; k < 12; k++) v[k] = *(const uint4*)(qp + k * 8);
      norm_rope96(v, p.in[20], QSCALE, cs, sn);
#pragma unroll
      for (int k = 0; k < 12; k++) *(uint4*)(qp + k * 8) = v[k];
      bf16_t* kp = Kb + ((size_t)si.s0 * 8 + (size_t)h * si.S + (t - si.s0)) * 96;
#pragma unroll
      for (int k = 0; k < 8; k++) v[k] = *(const uint4*)(kp + k * 8);
#pragma unroll
      for (int k = 0; k < 4; k++) v[8 + k] = *(const uint4*)(Z2 + (size_t)t * 416 + 384 + k * 8);
      norm_rope96(v, p.in[21], 1.f, cs, sn);
#pragma unroll
      for (int k = 0; k < 12; k++) *(uint4*)(kp + k * 8) = v[k];
    } else {
      const int i = (it - 2048) * 256 + tid;
      const int c = i & 511, ch = (i >> 9) & 511, d = i >> 18;
      const unsigned* ab = AB + ((size_t)d * T_TOK + (size_t)ch * 128) * 512 + c;
      float A = 1.f, Bv = 0.f;
      if (d == 0) {
        for (int sb = 0; sb < 128; sb += 16) {
          unsigned u[16];
#pragma unroll
          for (int j = 0; j < 16; j++) u[j] = ab[(size_t)(sb + j) * 512];
#pragma unroll
          for (int j = 0; j < 16; j++) { float a = fexp2(lo2f(u[j])); Bv = a * Bv + hi2f(u[j]); A *= a; }
        }
      } else {
        for (int sb = 112; sb >= 0; sb -= 16) {
          unsigned u[16];
#pragma unroll
          for (int j = 0; j < 16; j++) u[j] = ab[(size_t)(sb + j) * 512];
#pragma unroll
          for (int j = 15; j >= 0; j--) { float a = fexp2(lo2f(u[j])); Bv = a * Bv + hi2f(u[j]); A *= a; }
        }
      }
      aggA[i] = A; aggB[i] = Bv;
    }
  }
}

__device__ __forceinline__ void phase_scan2(const Params& p) {
  const int tidx_ = opaque_tid();
  const int gtid = blockIdx.x * 256 + tidx_, gsz = gridDim.x * 256;
  const float* aggA = (const float*)(p.ws + OFF_AGGA);
  const float* aggB = (const float*)(p.ws + OFF_AGGB);
  float* carry = (float*)(p.ws + OFF_CARRY);
  for (int i = gtid; i < 10240; i += gsz) {
    const int d = i / 5120, rem = i % 5120, seq = rem >> 9, c = rem & 511;
    const int ch0 = seq < 2 ? seq * 128 : 256 + (seq - 2) * 32;
    const int nch = seq < 2 ? 128 : 32;
    float cr = 0.f;
    const int ob = ((d * 512) + ch0) * 512 + c;
    if (d == 0) {
      for (int jb = 0; jb < nch; jb += 16) {
        float av[16], bv[16];
#pragma unroll
        for (int j = 0; j < 16; j++) { av[j] = aggA[ob + (jb + j) * 512]; bv[j] = aggB[ob + (jb + j) * 512]; }
#pragma unroll
        for (int j = 0; j < 16; j++) { carry[ob + (jb + j) * 512] = cr; cr = av[j] * cr + bv[j]; }
      }
    } else {
      for (int jb = nch - 16; jb >= 0; jb -= 16) {
        float av[16], bv[16];
#pragma unroll
        for (int j = 0; j < 16; j++) { av[j] = aggA[ob + (jb + j) * 512]; bv[j] = aggB[ob + (jb + j) * 512]; }
#pragma unroll
        for (int j = 15; j >= 0; j--) { carry[ob + (jb + j) * 512] = cr; cr = av[j] * cr + bv[j]; }
      }
    }
  }
}

__device__ __forceinline__ void scan3_item(const Params& p, int it) {
  const int tidx_ = opaque_tid();
  const int i = it * 256 + tidx_;
  const int c = i & 511, ch = i >> 9;
  unsigned* AB = (unsigned*)p.out;
  bf16_t* Z1 = (bf16_t*)(p.ws + OFF_R1);
  unsigned* abf = AB + ((size_t)ch * 128) * 512 + c;
  unsigned* abb = AB + ((size_t)T_TOK + (size_t)ch * 128) * 512 + c;
  const float* aggA = (const float*)(p.ws + OFF_AGGA);
  const float* aggB = (const float*)(p.ws + OFF_AGGB);
  const int ch0 = ch < 256 ? (ch & ~127) : (ch & ~31);
  const int nch = ch < 256 ? 128 : 32;
  float hst = 0.f;
#pragma unroll 8
  for (int j = ch0; j < ch; j++) hst = aggA[j * 512 + c] * hst + aggB[j * 512 + c];
  for (int sb = 0; sb < 128; sb += 16) {
    unsigned u[16];
#pragma unroll
    for (int j = 0; j < 16; j++) u[j] = abf[(size_t)(sb + j) * 512];
#pragma unroll
    for (int j = 0; j < 16; j++) { hst = fexp2(lo2f(u[j])) * hst + hi2f(u[j]); u[j] = __float_as_uint(hst); }
#pragma unroll
    for (int j = 0; j < 16; j++) abf[(size_t)(sb + j) * 512] = u[j];
  }
  hst = 0.f;
#pragma unroll 8
  for (int j = ch0 + nch - 1; j > ch; j--) hst = aggA[(512 + j) * 512 + c] * hst + aggB[(512 + j) * 512 + c];
  bf16_t* zp = Z1 + ((size_t)ch * 128) * 1024 + 512 + c;
  for (int sb = 112; sb >= 0; sb -= 16) {
    unsigned u[16]; float fw[16]; unsigned short yv[16];
#pragma unroll
    for (int j = 0; j < 16; j++) { u[j] = abb[(size_t)(sb + j) * 512]; fw[j] = __uint_as_float(abf[(size_t)(sb + j) * 512]); yv[j] = zp[(size_t)(sb + j) * 1024]; }
#pragma unroll
    for (int j = 15; j >= 0; j--) {
      hst = fexp2(lo2f(u[j])) * hst + hi2f(u[j]);
      const float tot = hst + fw[j];
      yv[j] = f2bf(tot * gelu_t(bf2f(yv[j])));
    }
#pragma unroll
    for (int j = 0; j < 16; j++) zp[(size_t)(sb + j) * 1024] = yv[j];
  }
}

#define KS_STRIDE 104
#define VS_STRIDE 72
#define ATT_BUF (64 * KS_STRIDE + 64 * VS_STRIDE)
__device__ __forceinline__ float xhalf_max(float x) {
  auto r = __builtin_amdgcn_permlane32_swap(__float_as_int(x), __float_as_int(x), false, false);
  return fmaxf(__int_as_float(r[0]), __int_as_float(r[1]));
}
template <bool OFFS>
__device__ __forceinline__ void attn_item(const Params& p, int seq, int h, int qt, bf16_t* sm) {
  const int tidx_ = opaque_tid();
  const int tid = tidx_, lane = tid & 63, w = tid >> 6, hh = lane >> 5, l31 = lane & 31;
  int s0, S;
  if (seq < 2) { s0 = seq << 14; S = 16384; } else { s0 = 32768 + ((seq - 2) << 12); S = 4096; }
  const bf16_t* Q = (const bf16_t*)(p.ws + OFF_H) + ((size_t)(s0 + qt * 256)) * 768 + h * 96;
  const bf16_t* Kp = (const bf16_t*)(p.ws + OFF_B) + ((size_t)s0 * 8 + (size_t)h * S) * 96;
  const bf16_t* Vp = (const bf16_t*)(p.ws + OFF_VT) + ((size_t)s0 * 8 + (size_t)h * S) * 64;
  bf16_t* Z1 = (bf16_t*)(p.ws + OFF_R1);
  bf16x8 qf[2][6];
#pragma unroll
  for (int qs = 0; qs < 2; qs++)
#pragma unroll
    for (int kk = 0; kk < 6; kk++) qf[qs][kk] = *(const bf16x8*)(Q + (size_t)(w * 64 + qs * 32 + l31) * 768 + kk * 16 + hh * 8);
  f32x16 o00, o01, o10, o11;
#pragma unroll
  for (int r = 0; r < 16; r++) { o00[r] = 0.f; o01[r] = 0.f; o10[r] = 0.f; o11[r] = 0.f; }
  float l0 = 0.f, l1 = 0.f;
  float negc0 = 0.f, negc1 = 0.f;
  if (OFFS) {
    float qa = 0.f, qb = 0.f;
#pragma unroll
    for (int kk = 0; kk < 6; kk++)
#pragma unroll
      for (int j = 0; j < 8; j++) {
        const float x = bf2f((unsigned short)qf[0][kk][j]); qa += x * x;
        const float y = bf2f((unsigned short)qf[1][kk][j]); qb += y * y;
      }
    qa += __shfl_xor(qa, 32);
    qb += __shfl_xor(qb, 32);
    const float* gk = p.in[21];
    float gm = fmaxf(fabsf(gk[lane]), lane < 32 ? fabsf(gk[64 + lane]) : 0.f);
#pragma unroll
    for (int o_ = 32; o_ > 0; o_ >>= 1) gm = fmaxf(gm, __shfl_xor(gm, o_));
    negc0 = -(sqrtf(qa) * 9.797958971f * gm * 1.01f + 1e-3f);
    negc1 = -(sqrtf(qb) * 9.797958971f * gm * 1.01f + 1e-3f);
  }
  const int kr0 = tid / 12, kc0 = (tid % 12) * 8;
  const int kr1 = (tid + 256) / 12, kc1 = ((tid + 256) % 12) * 8;
  const int kr2 = (tid + 512) / 12, kc2 = ((tid + 512) % 12) * 8;
  const int vr0 = tid >> 3, vc0 = (tid & 7) * 8;
  const int vr1 = (tid + 256) >> 3, vc1 = vc0;
  const int ko0 = kr0 * KS_STRIDE + kc0, ko1 = kr1 * KS_STRIDE + kc1, ko2 = kr2 * KS_STRIDE + kc2;
  const int vo0 = 64 * KS_STRIDE + vr0 * VS_STRIDE + vc0, vo1 = 64 * KS_STRIDE + vr1 * VS_STRIDE + vc1;
  const unsigned kq0 = (unsigned)(kr0 * 96 + kc0), kq1 = (unsigned)(kr1 * 96 + kc1), kq2 = (unsigned)(kr2 * 96 + kc2);
  const unsigned vq0 = (unsigned)(vr0 * S + vc0), vq1 = (unsigned)(vr1 * S + vc1);
  uint4 rk0 = *(const uint4*)(Kp + kq0), rk1 = *(const uint4*)(Kp + kq1), rk2 = *(const uint4*)(Kp + kq2);
  uint4 rv0 = *(const uint4*)(Vp + vq0), rv1 = *(const uint4*)(Vp + vq1);
  const int nt = S >> 6;
  __syncthreads();
  *(uint4*)(sm + ko0) = rk0; *(uint4*)(sm + ko1) = rk1; *(uint4*)(sm + ko2) = rk2;
  *(uint4*)(sm + vo0) = rv0; *(uint4*)(sm + vo1) = rv1;
  __syncthreads();
  const int koff = l31 * KS_STRIDE + hh * 8;
  const int voff = 64 * KS_STRIDE + l31 * VS_STRIDE + hh * 8;
  for (int kt = 0; kt < nt; ++kt) {
    const bf16_t* Ks = sm + (kt & 1) * ATT_BUF;
    if (kt + 1 < nt) {
      const bf16_t* Kn = Kp + (size_t)(kt + 1) * 64 * 96;
      const bf16_t* Vn = Vp + (size_t)(kt + 1) * 64;
      rk0 = *(const uint4*)(Kn + kq0); rk1 = *(const uint4*)(Kn + kq1); rk2 = *(const uint4*)(Kn + kq2);
      rv0 = *(const uint4*)(Vn + vq0); rv1 = *(const uint4*)(Vn + vq1);
    }
#pragma unroll 1
    for (int sub = 0; sub < 2; sub++) {
      f32x16 sv0, sv1;
#pragma unroll
      for (int r = 0; r < 16; r++) { sv0[r] = 0.f; sv1[r] = 0.f; }
      const bf16_t* Kr = Ks + koff + sub * 32 * KS_STRIDE;
#pragma unroll
      for (int kk = 0; kk < 6; kk++) {
        bf16x8 kf = *(const bf16x8*)(Kr + kk * 16);
        sv0 = __builtin_amdgcn_mfma_f32_32x32x16_bf16(kf, qf[0][kk], sv0, 0, 0, 0);
        sv1 = __builtin_amdgcn_mfma_f32_32x32x16_bf16(kf, qf[1][kk], sv1, 0, 0, 0);
      }
      float ps0 = 0.f, ps1 = 0.f;
#pragma unroll
      for (int r = 0; r < 16; r++) { float pv = fexp2(OFFS ? sv0[r] + negc0 : sv0[r]); ps0 += pv; sv0[r] = pv; }
#pragma unroll
      for (int r = 0; r < 16; r++) { float pv = fexp2(OFFS ? sv1[r] + negc1 : sv1[r]); ps1 += pv; sv1[r] = pv; }
      l0 += ps0; l1 += ps1;
      const bf16_t* Vr = Ks + voff + sub * 32;
#pragma unroll
      for (int st = 0; st < 2; st++) {
        union { bf16x8 v; unsigned u[4]; } pf0, pf1;
#pragma unroll
        for (int j = 0; j < 4; j++) {
          pf0.u[j] = pack2(sv0[8 * st + 2 * j], sv0[8 * st + 2 * j + 1]);
          pf1.u[j] = pack2(sv1[8 * st + 2 * j], sv1[8 * st + 2 * j + 1]);
        }
        bf16x8 vfa = *(const bf16x8*)(Vr + 16 * st);
        bf16x8 vfb = *(const bf16x8*)(Vr + 32 * VS_STRIDE + 16 * st);
        o00 = __builtin_amdgcn_mfma_f32_32x32x16_bf16(vfa, pf0.v, o00, 0, 0, 0);
        o10 = __builtin_amdgcn_mfma_f32_32x32x16_bf16(vfa, pf1.v, o10, 0, 0, 0);
        o01 = __builtin_amdgcn_mfma_f32_32x32x16_bf16(vfb, pf0.v, o01, 0, 0, 0);
        o11 = __builtin_amdgcn_mfma_f32_32x32x16_bf16(vfb, pf1.v, o11, 0, 0, 0);
      }
    }
    if (kt + 1 < nt) {
      bf16_t* nK = sm + ((kt + 1) & 1) * ATT_BUF;
      *(uint4*)(nK + ko0) = rk0; *(uint4*)(nK + ko1) = rk1; *(uint4*)(nK + ko2) = rk2;
      *(uint4*)(nK + vo0) = rv0; *(uint4*)(nK + vo1) = rv1;
    }
    __syncthreads();
  }
#pragma unroll
  for (int qs = 0; qs < 2; qs++) {
    const float lq = qs ? l1 : l0;
    const float lt = lq + __shfl_xor(lq, 32);
    const float inv = 1.f / lt;
    const size_t trow = (size_t)(s0 + qt * 256 + w * 64 + qs * 32 + l31);
#pragma unroll
    for (int dvt = 0; dvt < 2; dvt++) {
      const f32x16& oo = qs ? (dvt ? o11 : o10) : (dvt ? o01 : o00);
#pragma unroll
      for (int rg = 0; rg < 4; rg++) {
        const int dv = dvt * 32 + 8 * rg + 4 * hh;
        uint2 pk = make_uint2(pack2(oo[rg * 4 + 0] * inv, oo[rg * 4 + 1] * inv), pack2(oo[rg * 4 + 2] * inv, oo[rg * 4 + 3] * inv));
        *(uint2*)(Z1 + trow * 1024 + h * 64 + dv) = pk;
      }
    }
  }
}

__device__ __forceinline__ void phase_attn_scan3(const Params& p, bf16_t* sm) {
  const int tidx_ = opaque_tid();
  __shared__ int s_item;
  int* cnt = (int*)(p.ws + OFF_CNT);
  const int tid = tidx_;
  const int xcc = (int)(__builtin_amdgcn_s_getreg((3 << 11) | 20) & 0xFu) & 7;
  bool use_offs;
  {
    const int lane = tid & 63;
    const float* gq = p.in[20]; const float* gk = p.in[21];
    float a = fmaxf(fabsf(gq[lane]), lane < 32 ? fabsf(gq[64 + lane]) : 0.f);
    float b = fmaxf(fabsf(gk[lane]), lane < 32 ? fabsf(gk[64 + lane]) : 0.f);
#pragma unroll
    for (int o_ = 32; o_ > 0; o_ >>= 1) { a = fmaxf(a, __shfl_xor(a, o_)); b = fmaxf(b, __shfl_xor(b, o_)); }
    const float bound = 96.f * QSCALE * a * b * 1.03f;
    use_offs = !(bound < 64.f);
  }
  for (int dq = 0; dq < 8; ++dq) {
    const int q = (xcc + dq) & 7;
    while (true) {
      __syncthreads();
      if (tid == 0) s_item = atomicAdd(&cnt[q], 1);
      __syncthreads();
      const int it = s_item;
      if (it >= 256) break;
      int seq, h, qt;
      if (it < 128) { const int pair = q + 8 * (it >> 6); seq = pair >> 3; h = pair & 7; qt = it & 63; }
      else { const int j = it - 128; const int pair = q + 8 * (j >> 4); seq = 2 + (pair >> 3); h = pair & 7; qt = j & 15; }
      if (use_offs) attn_item<true>(p, seq, h, qt, sm); else attn_item<false>(p, seq, h, qt, sm);
    }
  }
  while (true) {
    __syncthreads();
    if (tid == 0) s_item = atomicAdd(&cnt[8], 1);
    __syncthreads();
    const int it = s_item;
    if (it >= 1024) break;
    scan3_item(p, it);
  }
}

__device__ __forceinline__ void phase_gres_norm(const Params& p, const bf16_t* A, const bf16_t* W, int layer, bool res_from_input, bf16_t* sm) {
  const int tidx_ = opaque_tid();
  const int lane = tidx_ & 63, wave = tidx_ >> 6, wm = wave >> 1, wn = wave & 1;
  const float* mod = (const float*)(p.ws + OFF_MOD);
  const float* g = p.in[7] + layer * 1024;
  bf16_t* H = (bf16_t*)(p.ws + OFF_H);
  for (int mt = blockIdx.x; mt < 512; mt += gridDim.x) {
    SeqInfo si = seq_of(mt * 128);
    const float* g1 = mod + (layer * 10 + si.b) * 6144 + 2 * 1024;
#pragma unroll 1
    for (int nt = 0; nt < 8; nt++) {
      f32x16 acc[2][2];
      gemm_tile(A + (size_t)mt * 128 * 1024, 1024, W + (size_t)nt * 128 * 1024, 1024, 1024, acc, sm);
      int mrow0 = mt * 128;
      asm volatile("" : "+s"(mrow0));
      const float* xb = res_from_input ? (mrow0 < 32768 ? p.in[0] : p.in[1] - (size_t)32768 * 1024) : p.out;
#pragma unroll
      for (int ni = 0; ni < 2; ni++) {
        const int col = nt * 128 + EPI_COL(wn, ni, lane);
        const float gg = g1[col];
#pragma unroll
        for (int mi = 0; mi < 2; mi++)
#pragma unroll
          for (int r = 0; r < 16; r++) {
            const unsigned off = (unsigned)((mrow0 + EPI_ROW(wm, mi, r, lane)) * 1024 + col);
            p.out[off] = xb[off] + gg * acc[mi][ni][r];
          }
      }
    }
    __syncthreads();
    const float* md = mod + (layer * 10 + si.b) * 6144 + 3 * 1024;
#pragma unroll 1
    for (int rr = wave; rr < 128; rr += 4) {
      const int t = mt * 128 + rr;
      const float* x = p.out + (size_t)t * 1024;
      float4 v[4];
      float ss = 0.f;
#pragma unroll
      for (int j = 0; j < 4; j++) {
        v[j] = *(const float4*)(x + j * 256 + lane * 4);
        ss += v[j].x * v[j].x + v[j].y * v[j].y + v[j].z * v[j].z + v[j].w * v[j].w;
      }
      ss = wave_sum(ss);
      const float rstd = rsqrtf(ss * (1.f / 1024.f) + EPSN);
#pragma unroll
      for (int j = 0; j < 4; j++) {
        const int idx = j * 256 + lane * 4;
        float4 gg = *(const float4*)(g + idx);
        float4 sh = *(const float4*)(md + idx);
        float4 sc = *(const float4*)(md + 1024 + idx);
        float y0 = v[j].x * rstd * gg.x * (1.f + sc.x) + sh.x;
        float y1 = v[j].y * rstd * gg.y * (1.f + sc.y) + sh.y;
        float y2 = v[j].z * rstd * gg.z * (1.f + sc.z) + sh.z;
        float y3 = v[j].w * rstd * gg.w * (1.f + sc.w) + sh.w;
        *(uint2*)(H + (size_t)t * 1024 + idx) = make_uint2(pack2(y0, y1), pack2(y2, y3));
      }
    }
    __syncthreads();
  }
}

__device__ __forceinline__ void phase_pq(const Params& p, int layer, bf16_t* sm) {
  const int tidx_ = opaque_tid();
  const int lane = tidx_ & 63, wave = tidx_ >> 6, wm = wave >> 1, wn = wave & 1;
  const bf16_t* H = (const bf16_t*)(p.ws + OFF_H);
  const bf16_t* W = (const bf16_t*)(p.ws + OFF_WPQ) + (size_t)layer * 2048 * 1024;
  bf16_t* PQ = (bf16_t*)(p.ws + OFF_R1);
  XCD_TILE_LOOP(16, mt, nt) {
    f32x16 acc[2][2];
    gemm_tile(H + (size_t)mt * 128 * 1024, 1024, W + (size_t)nt * 128 * 1024, 1024, 1024, acc, sm);
#pragma unroll
    for (int mi = 0; mi < 2; mi++)
#pragma unroll
      for (int ni = 0; ni < 2; ni++)
#pragma unroll
        for (int r = 0; r < 16; r++)
          sm[EPI_ROW(wm, mi, r, lane) * CS_LD + EPI_COL(wn, ni, lane)] = f2bf(acc[mi][ni][r]);
    __syncthreads();
    tile_copy_out(sm, PQ + (size_t)mt * 128 * 2048 + nt * 128, 2048, 4);
    __syncthreads();
  }
}

__device__ __forceinline__ int ordf(float x) { int b = __float_as_int(x); return b ^ ((b >> 31) & 0x7fffffff); }
__device__ __forceinline__ float unordf(int o) { return __int_as_float(o ^ ((o >> 31) & 0x7fffffff)); }
#define KEY_MIN ((int)0x80000000)
#define KINS(L, key)                                              \
  {                                                               \
    int cx_ = (key);                                              \
    _Pragma("unroll") for (int k_ = 0; k_ < 16; k_++) {           \
      const int hi_ = max(L[k_], cx_);                            \
      cx_ = min(L[k_], cx_);                                      \
      L[k_] = hi_;                                                \
    }                                                             \
  }
#define KSTAGE(c_, st_)                                                  \
  _Pragma("unroll") for (int i_ = 0; i_ < 16; i_++) {                     \
    if ((i_ & (st_)) == 0) {                                              \
      const int hi_ = max(c_[i_], c_[i_ + (st_)]);                        \
      const int lo_ = min(c_[i_], c_[i_ + (st_)]);                        \
      c_[i_] = hi_; c_[i_ + (st_)] = lo_;                                 \
    }                                                                     \
  }
#define KMERGE(L)                                                                     \
  {                                                                                   \
    int c_[16];                                                                       \
    _Pragma("unroll") for (int k_ = 0; k_ < 16; k_++) c_[k_] = max(L[k_], __shfl_xor(L[15 - k_], 1)); \
    KSTAGE(c_, 8) KSTAGE(c_, 4) KSTAGE(c_, 2) KSTAGE(c_, 1)                           \
    _Pragma("unroll") for (int k_ = 0; k_ < 16; k_++) L[k_] = c_[k_];                 \
  }

#define KSORT16(V) { \
    { const int hi_ = max(V[0], V[1]); const int lo_ = min(V[0], V[1]); V[0] = hi_; V[1] = lo_; } \
    { const int hi_ = max(V[3], V[2]); const int lo_ = min(V[3], V[2]); V[3] = hi_; V[2] = lo_; } \
    { const int hi_ = max(V[4], V[5]); const int lo_ = min(V[4], V[5]); V[4] = hi_; V[5] = lo_; } \
    { const int hi_ = max(V[7], V[6]); const int lo_ = min(V[7], V[6]); V[7] = hi_; V[6] = lo_; } \
    { const int hi_ = max(V[8], V[9]); const int lo_ = min(V[8], V[9]); V[8] = hi_; V[9] = lo_; } \
    { const int hi_ = max(V[11], V[10]); const int lo_ = min(V[11], V[10]); V[11] = hi_; V[10] = lo_; } \
    { const int hi_ = max(V[12], V[13]); const int lo_ = min(V[12], V[13]); V[12] = hi_; V[13] = lo_; } \
    { const int hi_ = max(V[15], V[14]); const int lo_ = min(V[15], V[14]); V[15] = hi_; V[14] = lo_; } \
    { const int hi_ = max(V[0], V[2]); const int lo_ = min(V[0], V[2]); V[0] = hi_; V[2] = lo_; } \
    { const int hi_ = max(V[1], V[3]); const int lo_ = min(V[1], V[3]); V[1] = hi_; V[3] = lo_; } \
    { const int hi_ = max(V[6], V[4]); const int lo_ = min(V[6], V[4]); V[6] = hi_; V[4] = lo_; } \
    { const int hi_ = max(V[7], V[5]); const int lo_ = min(V[7], V[5]); V[7] = hi_; V[5] = lo_; } \
    { const int hi_ = max(V[8], V[10]); const int lo_ = min(V[8], V[10]); V[8] = hi_; V[10] = lo_; } \
    { const int hi_ = max(V[9], V[11]); const int lo_ = min(V[9], V[11]); V[9] = hi_; V[11] = lo_; } \
    { const int hi_ = max(V[14], V[12]); const int lo_ = min(V[14], V[12]); V[14] = hi_; V[12] = lo_; } \
    { const int hi_ = max(V[15], V[13]); const int lo_ = min(V[15], V[13]); V[15] = hi_; V[13] = lo_; } \
    { const int hi_ = max(V[0], V[1]); const int lo_ = min(V[0], V[1]); V[0] = hi_; V[1] = lo_; } \
    { const int hi_ = max(V[2], V[3]); const int lo_ = min(V[2], V[3]); V[2] = hi_; V[3] = lo_; } \
    { const int hi_ = max(V[5], V[4]); const int lo_ = min(V[5], V[4]); V[5] = hi_; V[4] = lo_; } \
    { const int hi_ = max(V[7], V[6]); const int lo_ = min(V[7], V[6]); V[7] = hi_; V[6] = lo_; } \
    { const int hi_ = max(V[8], V[9]); const int lo_ = min(V[8], V[9]); V[8] = hi_; V[9] = lo_; } \
    { const int hi_ = max(V[10], V[11]); const int lo_ = min(V[10], V[11]); V[10] = hi_; V[11] = lo_; } \
    { const int hi_ = max(V[13], V[12]); const int lo_ = min(V[13], V[12]); V[13] = hi_; V[12] = lo_; } \
    { const int hi_ = max(V[15], V[14]); const int lo_ = min(V[15], V[14]); V[15] = hi_; V[14] = lo_; } \
    { const int hi_ = max(V[0], V[4]); const int lo_ = min(V[0], V[4]); V[0] = hi_; V[4] = lo_; } \
    { const int hi_ = max(V[1], V[5]); const int lo_ = min(V[1], V[5]); V[1] = hi_; V[5] = lo_; } \
    { const int hi_ = max(V[2], V[6]); const int lo_ = min(V[2], V[6]); V[2] = hi_; V[6] = lo_; } \
    { const int hi_ = max(V[3], V[7]); const int lo_ = min(V[3], V[7]); V[3] = hi_; V[7] = lo_; } \
    { const int hi_ = max(V[12], V[8]); const int lo_ = min(V[12], V[8]); V[12] = hi_; V[8] = lo_; } \
    { const int hi_ = max(V[13], V[9]); const int lo_ = min(V[13], V[9]); V[13] = hi_; V[9] = lo_; } \
    { const int hi_ = max(V[14], V[10]); const int lo_ = min(V[14], V[10]); V[14] = hi_; V[10] = lo_; } \
    { const int hi_ = max(V[15], V[11]); const int lo_ = min(V[15], V[11]); V[15] = hi_; V[11] = lo_; } \
    { const int hi_ = max(V[0], V[2]); const int lo_ = min(V[0], V[2]); V[0] = hi_; V[2] = lo_; } \
    { const int hi_ = max(V[1], V[3]); const int lo_ = min(V[1], V[3]); V[1] = hi_; V[3] = lo_; } \
    { const int hi_ = max(V[4], V[6]); const int lo_ = min(V[4], V[6]); V[4] = hi_; V[6] = lo_; } \
    { const int hi_ = max(V[5], V[7]); const int lo_ = min(V[5], V[7]); V[5] = hi_; V[7] = lo_; } \
    { const int hi_ = max(V[10], V[8]); const int lo_ = min(V[10], V[8]); V[10] = hi_; V[8] = lo_; } \
    { const int hi_ = max(V[11], V[9]); const int lo_ = min(V[11], V[9]); V[11] = hi_; V[9] = lo_; } \
    { const int hi_ = max(V[14], V[12]); const int lo_ = min(V[14], V[12]); V[14] = hi_; V[12] = lo_; } \
    { const int hi_ = max(V[15], V[13]); const int lo_ = min(V[15], V[13]); V[15] = hi_; V[13] = lo_; } \
    { const int hi_ = max(V[0], V[1]); const int lo_ = min(V[0], V[1]); V[0] = hi_; V[1] = lo_; } \
    { const int hi_ = max(V[2], V[3]); const int lo_ = min(V[2], V[3]); V[2] = hi_; V[3] = lo_; } \
    { const int hi_ = max(V[4], V[5]); const int lo_ = min(V[4], V[5]); V[4] = hi_; V[5] = lo_; } \
    { const int hi_ = max(V[6], V[7]); const int lo_ = min(V[6], V[7]); V[6] = hi_; V[7] = lo_; } \
    { const int hi_ = max(V[9], V[8]); const int lo_ = min(V[9], V[8]); V[9] = hi_; V[8] = lo_; } \
    { const int hi_ = max(V[11], V[10]); const int lo_ = min(V[11], V[10]); V[11] = hi_; V[10] = lo_; } \
    { const int hi_ = max(V[13], V[12]); const int lo_ = min(V[13], V[12]); V[13] = hi_; V[12] = lo_; } \
    { const int hi_ = max(V[15], V[14]); const int lo_ = min(V[15], V[14]); V[15] = hi_; V[14] = lo_; } \
    { const int hi_ = max(V[0], V[8]); const int lo_ = min(V[0], V[8]); V[0] = hi_; V[8] = lo_; } \
    { const int hi_ = max(V[1], V[9]); const int lo_ = min(V[1], V[9]); V[1] = hi_; V[9] = lo_; } \
    { const int hi_ = max(V[2], V[10]); const int lo_ = min(V[2], V[10]); V[2] = hi_; V[10] = lo_; } \
    { const int hi_ = max(V[3], V[11]); const int lo_ = min(V[3], V[11]); V[3] = hi_; V[11] = lo_; } \
    { const int hi_ = max(V[4], V[12]); const int lo_ = min(V[4], V[12]); V[4] = hi_; V[12] = lo_; } \
    { const int hi_ = max(V[5], V[13]); const int lo_ = min(V[5], V[13]); V[5] = hi_; V[13] = lo_; } \
    { const int hi_ = max(V[6], V[14]); const int lo_ = min(V[6], V[14]); V[6] = hi_; V[14] = lo_; } \
    { const int hi_ = max(V[7], V[15]); const int lo_ = min(V[7], V[15]); V[7] = hi_; V[15] = lo_; } \
    { const int hi_ = max(V[0], V[4]); const int lo_ = min(V[0], V[4]); V[0] = hi_; V[4] = lo_; } \
    { const int hi_ = max(V[1], V[5]); const int lo_ = min(V[1], V[5]); V[1] = hi_; V[5] = lo_; } \
    { const int hi_ = max(V[2], V[6]); const int lo_ = min(V[2], V[6]); V[2] = hi_; V[6] = lo_; } \
    { const int hi_ = max(V[3], V[7]); const int lo_ = min(V[3], V[7]); V[3] = hi_; V[7] = lo_; } \
    { const int hi_ = max(V[8], V[12]); const int lo_ = min(V[8], V[12]); V[8] = hi_; V[12] = lo_; } \
    { const int hi_ = max(V[9], V[13]); const int lo_ = min(V[9], V[13]); V[9] = hi_; V[13] = lo_; } \
    { const int hi_ = max(V[10], V[14]); const int lo_ = min(V[10], V[14]); V[10] = hi_; V[14] = lo_; } \
    { const int hi_ = max(V[11], V[15]); const int lo_ = min(V[11], V[15]); V[11] = hi_; V[15] = lo_; } \
    { const int hi_ = max(V[0], V[2]); const int lo_ = min(V[0], V[2]); V[0] = hi_; V[2] = lo_; } \
    { const int hi_ = max(V[1], V[3]); const int lo_ = min(V[1], V[3]); V[1] = hi_; V[3] = lo_; } \
    { const int hi_ = max(V[4], V[6]); const int lo_ = min(V[4], V[6]); V[4] = hi_; V[6] = lo_; } \
    { const int hi_ = max(V[5], V[7]); const int lo_ = min(V[5], V[7]); V[5] = hi_; V[7] = lo_; } \
    { const int hi_ = max(V[8], V[10]); const int lo_ = min(V[8], V[10]); V[8] = hi_; V[10] = lo_; } \
    { const int hi_ = max(V[9], V[11]); const int lo_ = min(V[9], V[11]); V[9] = hi_; V[11] = lo_; } \
    { const int hi_ = max(V[12], V[14]); const int lo_ = min(V[12], V[14]); V[12] = hi_; V[14] = lo_; } \
    { const int hi_ = max(V[13], V[15]); const int lo_ = min(V[13], V[15]); V[13] = hi_; V[15] = lo_; } \
    { const int hi_ = max(V[0], V[1]); const int lo_ = min(V[0], V[1]); V[0] = hi_; V[1] = lo_; } \
    { const int hi_ = max(V[2], V[3]); const int lo_ = min(V[2], V[3]); V[2] = hi_; V[3] = lo_; } \
    { const int hi_ = max(V[4], V[5]); const int lo_ = min(V[4], V[5]); V[4] = hi_; V[5] = lo_; } \
    { const int hi_ = max(V[6], V[7]); const int lo_ = min(V[6], V[7]); V[6] = hi_; V[7] = lo_; } \
    { const int hi_ = max(V[8], V[9]); const int lo_ = min(V[8], V[9]); V[8] = hi_; V[9] = lo_; } \
    { const int hi_ = max(V[10], V[11]); const int lo_ = min(V[10], V[11]); V[10] = hi_; V[11] = lo_; } \
    { const int hi_ = max(V[12], V[13]); const int lo_ = min(V[12], V[13]); V[12] = hi_; V[13] = lo_; } \
    { const int hi_ = max(V[14], V[15]); const int lo_ = min(V[14], V[15]); V[14] = hi_; V[15] = lo_; } \
  }
#define KMERGE2(L, G) { \
    int c_[16]; \
    _Pragma("unroll") for (int k_ = 0; k_ < 16; k_++) c_[k_] = max(L[k_], G[15 - k_]); \
    KSTAGE(c_, 8) KSTAGE(c_, 4) KSTAGE(c_, 2) KSTAGE(c_, 1) \
    _Pragma("unroll") for (int k_ = 0; k_ < 16; k_++) L[k_] = c_[k_]; \
  }
__device__ __forceinline__ void phase_topk(const Params& p, int layer, bf16_t* sm) {
  const int tidx_ = opaque_tid();
  const int tid = tidx_, lane = tid & 63, wave = tid >> 6, wm = wave >> 1, wn = wave & 1;
  const bf16_t* H = (const bf16_t*)(p.ws + OFF_H);
  const bf16_t* WPQ = (const bf16_t*)(p.ws + OFF_WPQ) + (size_t)layer * 2048 * 1024;
  const bf16_t* KEYS = (const bf16_t*)(p.ws + OFF_KEYS) + (size_t)layer * 2 * 16384;
  int* IDX = (int*)(p.ws + OFF_IDX);
  float* GW = (float*)(p.ws + OFF_GW);
  float* sc = (float*)sm;
  int* ib = (int*)sm;
  const int r = tid >> 1, hf = tid & 1;
#pragma unroll 1
  for (int mt = blockIdx.x; mt < 512; mt += gridDim.x)
#pragma unroll 1
  for (int h = 0; h < 8; h++) {
    int k1[16], k2[16];
#pragma unroll
    for (int pp = 0; pp < 2; pp++) {
      f32x16 acc[2][2];
      gemm_tile(H + (size_t)mt * 128 * 1024, 1024, WPQ + (size_t)(h * 256 + pp * 128) * 1024, 1024, 1024, acc, sm);
#pragma unroll
      for (int mi = 0; mi < 2; mi++)
#pragma unroll
        for (int ni = 0; ni < 2; ni++)
#pragma unroll
          for (int rr = 0; rr < 16; rr++)
            sm[EPI_ROW(wm, mi, rr, lane) * CS_LD + EPI_COL(wn, ni, lane)] = f2bf(acc[mi][ni][rr]);
      gemm_ldsA_k128(KEYS + pp * 16384, acc, sm);
#pragma unroll
      for (int mi = 0; mi < 2; mi++)
#pragma unroll
        for (int ni = 0; ni < 2; ni++)
#pragma unroll
          for (int rr = 0; rr < 16; rr++)
            sc[EPI_ROW(wm, mi, rr, lane) * 130 + wn * 65 + ni * 32 + (lane & 31)] = acc[mi][ni][rr];
      __syncthreads();
      int L[16];
      const float* rp = sc + r * 130 + hf * 65;
      const int ibase = 127 - hf * 64;
#pragma unroll
      for (int j = 0; j < 16; j++) L[j] = (ordf(rp[j]) & ~127) | (ibase - j);
      KSORT16(L);
#pragma unroll 1
      for (int g = 1; g < 4; g++) {
        int G[16];
#pragma unroll
        for (int j = 0; j < 16; j++) G[j] = (ordf(rp[g * 16 + j]) & ~127) | (ibase - (g * 16 + j));
        KSORT16(G);
        KMERGE2(L, G);
      }
      KMERGE(L);
      if (pp == 0) {
#pragma unroll
        for (int k = 0; k < 16; k++) k1[k] = L[k];
      } else {
#pragma unroll
        for (int k = 0; k < 16; k++) k2[k] = L[k];
      }
      __syncthreads();
    }
    if (hf == 0) {
#pragma unroll
      for (int k = 0; k < 16; k++) { ib[r * 32 + k] = 127 - (k1[k] & 127); ib[r * 32 + 16 + k] = 127 - (k2[k] & 127); }
    }
    float A[16], B[16];
#pragma unroll
    for (int k = 0; k < 16; k++) {
      const float v1 = unordf(k1[k] & ~127), v2 = unordf(k2[k] & ~127);
      A[k] = hf ? v2 : v1;
      B[k] = hf ? v1 : v2;
    }
    int F[16], F2[16];
    F[0] = (ordf(A[0] + B[1]) & ~255) | (255 - (hf ? 16 : 1));
    F[1] = (ordf(A[0] + B[2]) & ~255) | (255 - (hf ? 32 : 2));
    F[2] = (ordf(A[0] + B[3]) & ~255) | (255 - (hf ? 48 : 3));
    F[3] = (ordf(A[0] + B[4]) & ~255) | (255 - (hf ? 64 : 4));
    F[4] = (ordf(A[0] + B[5]) & ~255) | (255 - (hf ? 80 : 5));
    F[5] = (ordf(A[0] + B[6]) & ~255) | (255 - (hf ? 96 : 6));
    F[6] = (ordf(A[0] + B[7]) & ~255) | (255 - (hf ? 112 : 7));
    F[7] = (ordf(A[0] + B[8]) & ~255) | (255 - (hf ? 128 : 8));
    F[8] = (ordf(A[0] + B[9]) & ~255) | (255 - (hf ? 144 : 9));
    F[9] = (ordf(A[0] + B[10]) & ~255) | (255 - (hf ? 160 : 10));
    F[10] = (ordf(A[0] + B[11]) & ~255) | (255 - (hf ? 176 : 11));
    F[11] = (ordf(A[0] + B[12]) & ~255) | (255 - (hf ? 192 : 12));
    F[12] = (ordf(A[0] + B[13]) & ~255) | (255 - (hf ? 208 : 13));
    F[13] = (ordf(A[0] + B[14]) & ~255) | (255 - (hf ? 224 : 14));
    F[14] = (ordf(A[0] + B[15]) & ~255) | (255 - (hf ? 240 : 15));
    F[15] = (ordf(A[1] + B[2]) & ~255) | (255 - (hf ? 33 : 18));
    F2[0] = (ordf(A[1] + B[3]) & ~255) | (255 - (hf ? 49 : 19));
    F2[1] = (ordf(A[1] + B[4]) & ~255) | (255 - (hf ? 65 : 20));
    F2[2] = (ordf(A[1] + B[5]) & ~255) | (255 - (hf ? 81 : 21));
    F2[3] = (ordf(A[1] + B[6]) & ~255) | (255 - (hf ? 97 : 22));
    F2[4] = (ordf(A[1] + B[7]) & ~255) | (255 - (hf ? 113 : 23));
    F2[5] = (ordf(A[2] + B[3]) & ~255) | (255 - (hf ? 50 : 35));
    F2[6] = (ordf(A[2] + B[4]) & ~255) | (255 - (hf ? 66 : 36));
    F2[7] = hf ? KEY_MIN : ((ordf(A[0] + B[0]) & ~255) | (255 - 0));
    F2[8] = hf ? KEY_MIN : ((ordf(A[1] + B[1]) & ~255) | (255 - 17));
    F2[9] = hf ? KEY_MIN : ((ordf(A[2] + B[2]) & ~255) | (255 - 34));
    F2[10] = hf ? KEY_MIN : ((ordf(A[3] + B[3]) & ~255) | (255 - 51));
    F2[11] = KEY_MIN;
    F2[12] = KEY_MIN;
    F2[13] = KEY_MIN;
    F2[14] = KEY_MIN;
    F2[15] = KEY_MIN;
    KSORT16(F);
    KSORT16(F2);
    KMERGE2(F, F2);
    KMERGE(F);
    __syncthreads();
    float e[16], se = 0.f;
    const float fmx = unordf(F[0] & ~255);
#pragma unroll
    for (int k = 0; k < 16; k++) { e[k] = __expf(unordf(F[k] & ~255) - fmx); se += e[k]; }
    const float inv = 1.f / se;
    int oi[8]; float og[8];
    const int hmask = -hf;
#pragma unroll
    for (int k = 0; k < 8; k++) {
      const int key = (F[k + 8] & hmask) | (F[k] & ~hmask);
      const int j = 255 - (key & 255);
      oi[k] = ib[r * 32 + (j >> 4)] * 128 + ib[r * 32 + 16 + (j & 15)];
      og[k] = __int_as_float((__float_as_int(e[k + 8]) & hmask) | (__float_as_int(e[k]) & ~hmask)) * inv;
    }
    const size_t o = ((size_t)(mt * 128 + r)) * 128 + h * 16 + hf * 8;
    *(int4*)(IDX + o) = make_int4(oi[0], oi[1], oi[2], oi[3]);
    *(int4*)(IDX + o + 4) = make_int4(oi[4], oi[5], oi[6], oi[7]);
    *(float4*)(GW + o) = make_float4(og[0], og[1], og[2], og[3]);
    *(float4*)(GW + o + 4) = make_float4(og[4], og[5], og[6], og[7]);
    __syncthreads();
    if (mt == (int)blockIdx.x) phase_uvconv(p, layer, h, 8);
  }
}

__device__ __forceinline__ float dot16_fp8(uint4 u, const f32x2* hf) {
  f32x2 a = __builtin_amdgcn_cvt_pk_f32_fp8((int)u.x, false) * hf[0];
  a += __builtin_amdgcn_cvt_pk_f32_fp8((int)u.x, true) * hf[1];
  a += __builtin_amdgcn_cvt_pk_f32_fp8((int)u.y, false) * hf[2];
  a += __builtin_amdgcn_cvt_pk_f32_fp8((int)u.y, true) * hf[3];
  a += __builtin_amdgcn_cvt_pk_f32_fp8((int)u.z, false) * hf[4];
  a += __builtin_amdgcn_cvt_pk_f32_fp8((int)u.z, true) * hf[5];
  a += __builtin_amdgcn_cvt_pk_f32_fp8((int)u.w, false) * hf[6];
  a += __builtin_amdgcn_cvt_pk_f32_fp8((int)u.w, true) * hf[7];
  return a.x + a.y;
}
__device__ __forceinline__ void fma16_fp8(f32x2* o, uint4 u, float a) {
  f32x2 aa = {a, a};
  o[0] += __builtin_amdgcn_cvt_pk_f32_fp8((int)u.x, false) * aa;
  o[1] += __builtin_amdgcn_cvt_pk_f32_fp8((int)u.x, true) * aa;
  o[2] += __builtin_amdgcn_cvt_pk_f32_fp8((int)u.y, false) * aa;
  o[3] += __builtin_amdgcn_cvt_pk_f32_fp8((int)u.y, true) * aa;
  o[4] += __builtin_amdgcn_cvt_pk_f32_fp8((int)u.z, false) * aa;
  o[5] += __builtin_amdgcn_cvt_pk_f32_fp8((int)u.z, true) * aa;
  o[6] += __builtin_amdgcn_cvt_pk_f32_fp8((int)u.w, false) * aa;
  o[7] += __builtin_amdgcn_cvt_pk_f32_fp8((int)u.w, true) * aa;
}
constexpr size_t OFF_ACT = OFF_B + 128 * MBY;
__device__ __forceinline__ void phase_gatherU(const Params& p) {
  const int tidx_ = opaque_tid();
  const int lane = tidx_ & 63;
  const int gw = (blockIdx.x * 256 + tidx_) >> 6, nw = gridDim.x * 4;
  const bf16_t* H = (const bf16_t*)(p.ws + OFF_H);
  const unsigned char* UT = (const unsigned char*)(p.ws + OFF_UT);
  const int* IDX = (const int*)(p.ws + OFF_IDX);
  const float* GW = (const float*)(p.ws + OFF_GW);
  float* ACT = (float*)(p.ws + OFF_ACT);
  const bool b5 = (lane & 32) != 0, b4 = (lane & 16) != 0, b3 = (lane & 8) != 0;
  for (int t = gw; t < T_TOK; t += nw) {
    f32x2 hf[8];
    {
      uint4 h0 = *(const uint4*)(H + (size_t)t * 1024 + lane * 16);
      uint4 h1 = *(const uint4*)(H + (size_t)t * 1024 + lane * 16 + 8);
      hf[0] = f32x2{lo2f(h0.x), hi2f(h0.x)}; hf[1] = f32x2{lo2f(h0.y), hi2f(h0.y)};
      hf[2] = f32x2{lo2f(h0.z), hi2f(h0.z)}; hf[3] = f32x2{lo2f(h0.w), hi2f(h0.w)};
      hf[4] = f32x2{lo2f(h1.x), hi2f(h1.x)}; hf[5] = f32x2{lo2f(h1.y), hi2f(h1.y)};
      hf[6] = f32x2{lo2f(h1.z), hi2f(h1.z)}; hf[7] = f32x2{lo2f(h1.w), hi2f(h1.w)};
    }
    const int id0 = IDX[(size_t)t * 128 + lane], id1 = IDX[(size_t)t * 128 + 64 + lane];
    const float g0 = GW[(size_t)t * 128 + lane], g1 = GW[(size_t)t * 128 + 64 + lane];
    float act0 = 0.f, act1 = 0.f;
    for (int half = 0; half < 2; half++) {
      const int idv = half ? id1 : id0;
      const float gv = half ? g1 : g0;
      float acth = 0.f;
#pragma unroll
      for (int gq = 0; gq < 8; gq += 2) {
        uint4 ua[16];
#pragma unroll
        for (int e = 0; e < 16; e++) {
          const int ex = __builtin_amdgcn_readlane(idv, gq * 8 + e);
          ua[e] = *(const uint4*)(UT + (size_t)ex * 1024 + lane * 16);
        }
#pragma unroll
        for (int g2 = 0; g2 < 2; g2++) {
          float d[8];
#pragma unroll
          for (int e = 0; e < 8; e++) d[e] = dot16_fp8(ua[g2 * 8 + e], hf);
          float e4[4], e2[2], e1;
#pragma unroll
          for (int i = 0; i < 4; i++) {
            const float snd = b5 ? d[i] : d[i + 4];
            const float kp = b5 ? d[i + 4] : d[i];
            e4[i] = kp + __shfl_xor(snd, 32);
          }
#pragma unroll
          for (int i = 0; i < 2; i++) {
            const float snd = b4 ? e4[i] : e4[i + 2];
            const float kp = b4 ? e4[i + 2] : e4[i];
            e2[i] = kp + __shfl_xor(snd, 16);
          }
          {
            const float snd = b3 ? e2[0] : e2[1];
            const float kp = b3 ? e2[1] : e2[0];
            e1 = kp + __shfl_xor(snd, 8);
          }
          e1 += __shfl_xor(e1, 4);
          e1 += __shfl_xor(e1, 2);
          e1 += __shfl_xor(e1, 1);
          const int grp = gq + g2;
          const float gE = __shfl(gv, grp * 8 + (lane >> 3));
          const float mine = gelu_t(e1 * (1.f / U_SCALE)) * gE * (1.f / V_SCALE);
          const float got = __shfl(mine, (lane & 7) * 8);
          acth = ((lane >> 3) == grp) ? got : acth;
        }
      }
      if (half) act1 = acth; else act0 = acth;
    }
    ACT[(size_t)t * 128 + lane] = act0;
    ACT[(size_t)t * 128 + 64 + lane] = act1;
  }
}

__device__ __forceinline__ void phase_gatherV(const Params& p, int layer) {
  const int tidx_ = opaque_tid();
  const int lane = tidx_ & 63;
  const int gw = (blockIdx.x * 256 + tidx_) >> 6, nw = gridDim.x * 4;
  const unsigned char* VT = (const unsigned char*)(p.ws + OFF_VTAB);
  const int* IDX = (const int*)(p.ws + OFF_IDX);
  const float* ACT = (const float*)(p.ws + OFF_ACT);
  const float* mod = (const float*)(p.ws + OFF_MOD);
  for (int t = gw; t < T_TOK; t += nw) {
    const int id0 = IDX[(size_t)t * 128 + lane], id1 = IDX[(size_t)t * 128 + 64 + lane];
    const float a0 = ACT[(size_t)t * 128 + lane], a1 = ACT[(size_t)t * 128 + 64 + lane];
    f32x2 o[8];
#pragma unroll
    for (int j = 0; j < 8; j++) o[j] = f32x2{0.f, 0.f};
    for (int half = 0; half < 2; half++) {
      const int idv = half ? id1 : id0;
      const int av = __float_as_int(half ? a1 : a0);
#pragma unroll
      for (int gq = 0; gq < 8; gq += 2) {
        uint4 va[16];
#pragma unroll
        for (int e = 0; e < 16; e++) {
          const int ex = __builtin_amdgcn_readlane(idv, gq * 8 + e);
          va[e] = *(const uint4*)(VT + (size_t)ex * 1024 + lane * 16);
        }
#pragma unroll
        for (int e = 0; e < 16; e++) {
          const float ae = __int_as_float(__builtin_amdgcn_readlane(av, gq * 8 + e));
          fma16_fp8(o, va[e], ae);
        }
      }
    }
    SeqInfo si = seq_of(t);
    const float* g2p = mod + (layer * 10 + si.b) * 6144 + 5 * 1024 + lane * 16;
    float* orow = p.out + (size_t)t * 1024 + lane * 16;
    float4 xn[4];
    float ssx = 0.f;
#pragma unroll
    for (int j = 0; j < 4; j++) {
      float4 xv = *(float4*)(orow + j * 4);
      float4 gg = *(const float4*)(g2p + j * 4);
      xv.x += gg.x * o[2 * j].x; xv.y += gg.y * o[2 * j].y;
      xv.z += gg.z * o[2 * j + 1].x; xv.w += gg.w * o[2 * j + 1].y;
      *(float4*)(orow + j * 4) = xv;
      xn[j] = xv;
      ssx += xv.x * xv.x + xv.y * xv.y + xv.z * xv.z + xv.w * xv.w;
    }
    if (layer == 0) {
      ssx = wave_sum(ssx);
      const float rstd = rsqrtf(ssx * (1.f / 1024.f) + EPSN);
      const float* gn = p.in[6] + 1024 + lane * 16;
      const float* md = mod + (1 * 10 + si.b) * 6144 + lane * 16;
      unsigned pk[8];
#pragma unroll
      for (int j = 0; j < 4; j++) {
        float4 gg = *(const float4*)(gn + j * 4);
        float4 sh = *(const float4*)(md + j * 4);
        float4 sc = *(const float4*)(md + 1024 + j * 4);
        const float y0 = xn[j].x * rstd * gg.x * (1.f + sc.x) + sh.x;
        const float y1 = xn[j].y * rstd * gg.y * (1.f + sc.y) + sh.y;
        const float y2 = xn[j].z * rstd * gg.z * (1.f + sc.z) + sh.z;
        const float y3 = xn[j].w * rstd * gg.w * (1.f + sc.w) + sh.w;
        pk[2 * j] = pack2(y0, y1); pk[2 * j + 1] = pack2(y2, y3);
      }
      bf16_t* hw = (bf16_t*)(p.ws + OFF_H) + (size_t)t * 1024 + lane * 16;
      *(uint4*)(hw) = make_uint4(pk[0], pk[1], pk[2], pk[3]);
      *(uint4*)(hw + 8) = make_uint4(pk[4], pk[5], pk[6], pk[7]);
    }
  }
}

__device__ __forceinline__ void phase_g8(const Params& p, bf16_t* sm) {
  const int tidx_ = opaque_tid();
  const int lane = tidx_ & 63, wave = tidx_ >> 6, wm = wave >> 1, wn = wave & 1;
  const bf16_t* H = (const bf16_t*)(p.ws + OFF_H);
  const bf16_t* W = (const bf16_t*)(p.ws + OFF_WCIN);
  bf16_t* BG = (bf16_t*)(p.ws + OFF_R1);
  bf16_t* U1 = (bf16_t*)(p.ws + OFF_R1 + 128 * MBY);
  XCD_TILE_LOOP(24, mt, nt) {
    f32x16 acc[2][2];
    gemm_tile(H + (size_t)mt * 128 * 1024, 1024, W + (size_t)nt * 128 * 1024, 1024, 1024, acc, sm);
    if (nt < 8) {
#pragma unroll
      for (int mi = 0; mi < 2; mi++)
#pragma unroll
        for (int ni = 0; ni < 2; ni++)
#pragma unroll
          for (int r = 0; r < 16; r++)
            sm[EPI_ROW(wm, mi, r, lane) * CS_LD + EPI_COL(wn, ni, lane)] = f2bf(acc[mi][ni][r]);
      __syncthreads();
      tile_copy_out(sm, BG + (size_t)mt * 128 * 1024 + nt * 128, 1024, 4);
    } else {
#pragma unroll
      for (int mi = 0; mi < 2; mi++)
#pragma unroll
        for (int r = 0; r < 16; r++)
          sm[EPI_ROW(wm, mi, r, lane) * CS_LD + wn * 32 + (lane & 31)] = f2bf(acc[mi][0][r] * acc[mi][1][r]);
      __syncthreads();
      tile_copy_out(sm, U1 + (size_t)mt * 128 * 1024 + (nt - 8) * 64, 1024, 3);
    }
    __syncthreads();
  }
}

__device__ __forceinline__ void phase_conv1(const Params& p) {
  const int tidx_ = opaque_tid();
  const int gtid = blockIdx.x * 256 + tidx_, gsz = gridDim.x * 256;
  const bf16_t* BG = (const bf16_t*)(p.ws + OFF_R1);
  const bf16_t* U1 = (const bf16_t*)(p.ws + OFF_R1 + 128 * MBY);
  bf16_t* Y = (bf16_t*)(p.ws + OFF_H);
  const float* cw = p.in[24];
  for (int mt_ = blockIdx.x; mt_ < 512; mt_ += gridDim.x)
  for (int j_ = tidx_; j_ < 16384; j_ += 256) {
    const int t = mt_ * 128 + (j_ >> 7), c = (j_ & 127) * 8;
    SeqInfo si = seq_of(t);
    float acc[8];
#pragma unroll
    for (int j = 0; j < 8; j++) acc[j] = 0.f;
#pragma unroll
    for (int k = 0; k < 3; k++) {
      const int tt = t + k - 1;
      if (tt >= si.s0 && tt < si.s0 + si.S) {
        uint4 v = *(const uint4*)(U1 + (size_t)tt * 1024 + c);
        const float* w = cw + k * 1024 + c;
        acc[0] += w[0] * lo2f(v.x); acc[1] += w[1] * hi2f(v.x);
        acc[2] += w[2] * lo2f(v.y); acc[3] += w[3] * hi2f(v.y);
        acc[4] += w[4] * lo2f(v.z); acc[5] += w[5] * hi2f(v.z);
        acc[6] += w[6] * lo2f(v.w); acc[7] += w[7] * hi2f(v.w);
      }
    }
    uint4 b = *(const uint4*)(BG + (size_t)t * 1024 + c);
    float bf[8]; unpack8(b, bf);
#pragma unroll
    for (int j = 0; j < 8; j++) acc[j] *= bf[j];
    *(uint4*)(Y + (size_t)t * 1024 + c) = pack8(acc);
  }
}

__device__ __forceinline__ void gbar_sync(unsigned* bar, unsigned& gen) {
  __syncthreads();
  gen++;
  if (threadIdx.x == 0) {
    __builtin_amdgcn_fence(__ATOMIC_RELEASE, "agent");
    const unsigned G = gridDim.x, b = blockIdx.x, x = b & 7u, y = (b >> 3) & 7u;
    const unsigned nA = (G - (x + 8u * y) + 63u) / 64u;
    const unsigned nBf = (G - x + 7u) / 8u, nB = nBf < 8u ? nBf : 8u;
    const unsigned nR = G < 8u ? G : 8u;
    unsigned* cA = bar + (x * 8u + y) * 16u;
    unsigned* cB = bar + 1024u + x * 16u;
    unsigned* cR = bar + 1024u + 128u;
    unsigned* fl = bar + 1024u + 256u;
    if (atomicAdd(cA, 1u) == nA - 1u) {
      atomicExch(cA, 0u);
      if (atomicAdd(cB, 1u) == nB - 1u) {
        atomicExch(cB, 0u);
        if (atomicAdd(cR, 1u) == nR - 1u) {
          atomicExch(cR, 0u);
          __builtin_amdgcn_fence(__ATOMIC_RELEASE, "agent");
#pragma unroll
          for (int i = 0; i < 8; i++) __hip_atomic_store(fl + i * 16, gen, __ATOMIC_RELAXED, __HIP_MEMORY_SCOPE_AGENT);
        }
      }
    }
    unsigned spins = 0;
    while (__hip_atomic_load(fl + x * 16u, __ATOMIC_RELAXED, __HIP_MEMORY_SCOPE_AGENT) < gen) {
      __builtin_amdgcn_s_sleep(2);
      if (++spins > (1u << 18)) break;
    }
    __builtin_amdgcn_fence(__ATOMIC_ACQUIRE, "agent");
  }
  __syncthreads();
}

#ifndef PROBE_MASK
#define PROBE_MASK 0
#endif
#ifndef PROBE_K
#define PROBE_K 1
#endif
#if PROBE_MASK
#define STAMP(k) do { if (blockIdx.x == 0 && threadIdx.x == 0) ((volatile unsigned long long*)(ws + OFF_CNT + 1024))[k] = wall_clock64(); } while (0)
#else
#define STAMP(k) do { } while (0)
#endif
__global__ void __launch_bounds__(256, 2) mega_fwd(Params p) {
  extern __shared__ __attribute__((aligned(16))) unsigned char smem[];
  cg::grid_group grid = cg::this_grid();
  bf16_t* sm = (bf16_t*)smem;
  unsigned char* ws = p.ws;
  unsigned* bar_ = (unsigned*)(ws + OFF_BAR);
  unsigned bgen_ = 0;

  STAMP(0);
  phase_prep(p, smem);
  grid.sync(); STAMP(1);
  phase_norm(p, 0, 1, true);
  gbar_sync(bar_, bgen_); STAMP(2);
  phase_g1(p, sm);
  gbar_sync(bar_, bgen_); STAMP(3);
  phase_conv0(p);
  gbar_sync(bar_, bgen_); STAMP(4);
  phase_g234(p, sm);
  gbar_sync(bar_, bgen_); STAMP(5);
  phase_qkprep_scan1(p);
  gbar_sync(bar_, bgen_); STAMP(6); STAMP(7);
  phase_attn_scan3(p, sm);
  gbar_sync(bar_, bgen_); STAMP(8);
  phase_gres_norm(p, (const bf16_t*)(ws + OFF_R1), (const bf16_t*)(ws + OFF_WOUT), 0, true, sm);
  STAMP(9);
  __syncthreads();
  STAMP(10); STAMP(11);
  phase_topk(p, 0, sm);
  gbar_sync(bar_, bgen_); STAMP(12);
  phase_gatherU(p);
  gbar_sync(bar_, bgen_);
  phase_gatherV(p, 0);
  gbar_sync(bar_, bgen_); STAMP(13);
  STAMP(14);
  phase_g8(p, sm);
  gbar_sync(bar_, bgen_); STAMP(15);
  phase_conv1(p);
  __syncthreads(); STAMP(16);
  phase_gres_norm(p, (const bf16_t*)(ws + OFF_H), (const bf16_t*)(ws + OFF_WCOUT), 1, false, sm);
  STAMP(17);
  __syncthreads();
  STAMP(18); STAMP(19);
  phase_topk(p, 1, sm);
  gbar_sync(bar_, bgen_); STAMP(20);
  phase_gatherU(p);
  gbar_sync(bar_, bgen_);
  phase_gatherV(p, 1);
#if PROBE_MASK
  gbar_sync(bar_, bgen_); STAMP(21);
  __threadfence();
  gbar_sync(bar_, bgen_);
  {
    const volatile unsigned long long* ts = (const volatile unsigned long long*)(ws + OFF_CNT + 1024);
    unsigned long long tot = 0;
    for (int k = 0; k < 21; k++) if ((PROBE_MASK >> k) & 1) tot += ts[k + 1] - ts[k];
    tot *= PROBE_K;
    const unsigned long long t0 = wall_clock64();
    while (wall_clock64() - t0 < tot) { }
  }
#endif
}

extern "C" void kernel_launch(void* const* d_in, const int* in_sizes, int n_in, void* d_out, int out_size, void* d_ws,
                              size_t ws_size, hipStream_t stream) {
  static int grid_blocks = 0;
  if (grid_blocks == 0) {
    if (n_in != 31 || ws_size < WS_NEED) {
      fprintf(stderr, "kernel_launch: unexpected n_in %d or ws_size %zu (< %zu)\n", n_in, ws_size, (size_t)WS_NEED);
      grid_blocks = -1;
      return;
    }
    int dev = 0, cus = 0, per_cu = 0;
    hipGetDevice(&dev);
    hipDeviceGetAttribute(&cus, hipDeviceAttributeMultiprocessorCount, dev);
    if (hipFuncSetAttribute((const void*)mega_fwd, hipFuncAttributeMaxDynamicSharedMemorySize, LDS_BYTES) != hipSuccess) {
      fprintf(stderr, "kernel_launch: hipFuncSetAttribute failed\n");
      grid_blocks = -1;
      return;
    }
    hipOccupancyMaxActiveBlocksPerMultiprocessor(&per_cu, (const void*)mega_fwd, 256, LDS_BYTES);
    if (per_cu < 1) per_cu = 1;
    if (per_cu > 2) per_cu = 2;
    grid_blocks = cus * per_cu;
    fprintf(stderr, "kernel_launch: cus %d per_cu %d grid %d ws %zu\n", cus, per_cu, grid_blocks, ws_size);
  }
  if (grid_blocks < 0) return;
  Params p{};
  for (int i = 0; i < 31; i++) p.in[i] = (const float*)d_in[i];
  p.out = (float*)d_out;
  p.ws = (unsigned char*)d_ws;
  void* args[] = {&p};
  hipError_t e = hipLaunchCooperativeKernel((const void*)mega_fwd, dim3(grid_blocks), dim3(256), args, LDS_BYTES, stream);
  if (e != hipSuccess) fprintf(stderr, "cooperative launch failed: %s (grid %d)\n", hipGetErrorString(e), grid_blocks);
}
```

```cpp
#include <hip/hip_runtime.h>
#include <hip/hip_cooperative_groups.h>
#include <cstdio>
#include <cstdint>
namespace cg = cooperative_groups;

typedef unsigned short bf16_t;
using bf16x8 = __attribute__((ext_vector_type(8))) short;
using bf16x4 = __attribute__((ext_vector_type(4))) short;
using f32x16 = __attribute__((ext_vector_type(16))) float;

#define T_TOK 65536
#define EPSN 1e-6f

struct Params {
  const float* in[31];
  float* out;
  unsigned char* ws;
};

constexpr size_t MBY = (size_t)1 << 20;
constexpr size_t OFF_WIN = 0;
constexpr size_t OFF_WUQ = OFF_WIN + (size_t)1536 * 1024 * 2;
constexpr size_t OFF_WUKV = OFF_WUQ + (size_t)768 * 256 * 2;
constexpr size_t OFF_WGATE = OFF_WUKV + (size_t)1024 * 128 * 2;
constexpr size_t OFF_WOUT = OFF_WGATE + (size_t)16 * 128 * 64 * 2;
constexpr size_t OFF_WCIN = OFF_WOUT + (size_t)1024 * 1024 * 2;
constexpr size_t OFF_WCOUT = OFF_WCIN + (size_t)3072 * 1024 * 2;
constexpr size_t OFF_WPQ = OFF_WCOUT + (size_t)1024 * 1024 * 2;
constexpr size_t OFF_KEYS = OFF_WPQ + (size_t)2 * 2048 * 1024 * 2;
constexpr size_t OFF_MOD = OFF_KEYS + (size_t)4 * 128 * 128 * 2;
constexpr size_t OFF_C8 = OFF_MOD + (size_t)2 * 10 * 6144 * 4;
constexpr size_t OFF_RSTDQ = OFF_C8 + 4096;
constexpr size_t OFF_RSTDKV = OFF_RSTDQ + (size_t)T_TOK * 4;
constexpr size_t OFF_AGGA = OFF_RSTDKV + (size_t)T_TOK * 4;
constexpr size_t OFF_AGGB = OFF_AGGA + 2 * MBY;
constexpr size_t OFF_CARRY = OFF_AGGB + 2 * MBY;
constexpr size_t OFF_CNT = OFF_CARRY + 2 * MBY;
constexpr size_t OFF_BAR = OFF_CNT + 8192;
static_assert(OFF_BAR + 8192 < 40 * MBY, "small region overflow");
constexpr size_t OFF_H = 40 * MBY;
constexpr size_t OFF_R1 = 168 * MBY;
constexpr size_t OFF_Z2 = OFF_R1 + 128 * MBY;
constexpr size_t OFF_XC = OFF_R1 + 180 * MBY;
constexpr size_t OFF_B = 424 * MBY;
constexpr size_t OFF_VT = OFF_B + 96 * MBY;
constexpr size_t OFF_UT = OFF_B;
constexpr size_t OFF_VTAB = OFF_B + 32 * MBY;
constexpr size_t OFF_IDX = OFF_B + 64 * MBY;
constexpr size_t OFF_GW = OFF_B + 96 * MBY;
constexpr size_t WS_NEED = 584 * MBY;

#define LDS_BYTES 73728

__device__ __forceinline__ float bf2f(unsigned short h) { return __uint_as_float(((unsigned)h) << 16); }
__device__ __forceinline__ unsigned short f2bf(float f) {
  unsigned u = __float_as_uint(f);
  u += 0x7fffu + ((u >> 16) & 1u);
  return (unsigned short)(u >> 16);
}
typedef __bf16 hwbf16x2 __attribute__((ext_vector_type(2)));
typedef float f32x2 __attribute__((ext_vector_type(2)));
__device__ __forceinline__ unsigned pack2(float a, float b) {
  f32x2 v = {a, b};
  hwbf16x2 r = __builtin_convertvector(v, hwbf16x2);
  return *(unsigned*)&r;
}
__device__ __forceinline__ float lo2f(unsigned u) { return __uint_as_float(u << 16); }
__device__ __forceinline__ float hi2f(unsigned u) { return __uint_as_float(u & 0xffff0000u); }
__device__ __forceinline__ float fexp2(float x) { return __builtin_amdgcn_exp2f(x); }
__device__ __forceinline__ float frcp(float x) { return __builtin_amdgcn_rcpf(x); }
__device__ __forceinline__ float gelu_t(float x) {
  float u = 0.7978845608f * (x + 0.044715f * x * x * x);
  float t = 1.f - 2.f * frcp(1.f + fexp2(u * 2.8853900817779268f));
  return 0.5f * x * (1.f + t);
}
__device__ __forceinline__ float sigmoid_f(float x) { return frcp(1.f + fexp2(-1.4426950408889634f * x)); }
__device__ __forceinline__ float wave_sum(float v) {
#pragma unroll
  for (int o = 32; o > 0; o >>= 1) v += __shfl_xor(v, o);
  return v;
}
__device__ __forceinline__ int opaque_tid() { int t = threadIdx.x; asm volatile("" : "+v"(t)); return t; }
struct SeqInfo { int b, s0, S; };
__device__ __forceinline__ SeqInfo seq_of(int t) {
  SeqInfo r;
  if (t < 32768) { r.b = t >> 14; r.s0 = r.b << 14; r.S = 16384; }
  else { int u = (t - 32768) >> 12; r.b = 2 + u; r.s0 = 32768 + (u << 12); r.S = 4096; }
  return r;
}
__device__ __forceinline__ const float* xin_row(const Params& p, int t) {
  return t < 32768 ? p.in[0] + (size_t)t * 1024 : p.in[1] + (size_t)(t - 32768) * 1024;
}

#define GT_BUF 16384
__device__ __forceinline__ void gemm_tile(const bf16_t* __restrict__ A, int lda, const bf16_t* __restrict__ B, int ldb,
                                          int K, f32x16 (&acc)[2][2], bf16_t* sm) {
  const int tidx_ = opaque_tid();
  const int tid = tidx_, lane = tid & 63, wave = tid >> 6, wm = wave >> 1, wn = wave & 1;
  const int nk = K >> 6;
  const bf16_t* src = wave < 2 ? A : B;
  const unsigned ld = (unsigned)(wave < 2 ? lda : ldb);
  const int i0 = (wave & 1) * 8;
  char* dbase = (char*)sm + (wave >> 1) * 16384 + i0 * 1024 + lane * 16;
#define GOFF(j_) ({ const unsigned s_ = (unsigned)((i0 + (j_)) * 64 + lane); const unsigned r_ = s_ >> 3; const unsigned c_ = (s_ & 7u) ^ ((r_ >> 1) & 7u); r_ * ld + c_ * 8u; })
  const unsigned g0 = GOFF(0), g1 = GOFF(1), g2 = GOFF(2), g3 = GOFF(3), g4 = GOFF(4), g5 = GOFF(5), g6 = GOFF(6), g7 = GOFF(7);
#undef GOFF
#define DMA1(gj_, j_, sp_, db_) __builtin_amdgcn_global_load_lds((const unsigned*)((sp_) + (gj_)), (unsigned __attribute__((address_space(3)))*)((db_) + (j_) * 1024), 16, 0, 0)
#define DMA_TILE(kt_, buf_)                                                       \
  {                                                                               \
    const bf16_t* sp_ = src + (kt_) * 64;                                         \
    char* db_ = dbase + (buf_) * (GT_BUF * 2);                                    \
    DMA1(g0, 0, sp_, db_); DMA1(g1, 1, sp_, db_); DMA1(g2, 2, sp_, db_);          \
    DMA1(g3, 3, sp_, db_); DMA1(g4, 4, sp_, db_); DMA1(g5, 5, sp_, db_);          \
    DMA1(g6, 6, sp_, db_); DMA1(g7, 7, sp_, db_);                                 \
  }
  DMA_TILE(0, 0);
#pragma unroll
  for (int mi = 0; mi < 2; mi++)
#pragma unroll
    for (int ni = 0; ni < 2; ni++)
#pragma unroll
      for (int r = 0; r < 16; r++) acc[mi][ni][r] = 0.f;
  asm volatile("s_waitcnt vmcnt(0)" ::: "memory");
  __syncthreads();
  const int sw = ((lane & 31) >> 1) & 7, hh = lane >> 5;
  const int arow = (wm * 64 + (lane & 31)) * 64;
  const int brow = 8192 + (wn * 64 + (lane & 31)) * 64;
  for (int kt = 0; kt < nk; ++kt) {
    if (kt + 1 < nk) DMA_TILE(kt + 1, (kt + 1) & 1);
    const bf16_t* cA = sm + (kt & 1) * GT_BUF;
#pragma unroll
    for (int kk = 0; kk < 4; ++kk) {
      const int pc = ((kk * 2 + hh) ^ sw) * 8;
      bf16x8 a[2], b[2];
#pragma unroll
      for (int mi = 0; mi < 2; mi++) a[mi] = *(const bf16x8*)(cA + arow + mi * 32 * 64 + pc);
#pragma unroll
      for (int ni = 0; ni < 2; ni++) b[ni] = *(const bf16x8*)(cA + brow + ni * 32 * 64 + pc);
#pragma unroll
      for (int mi = 0; mi < 2; mi++)
#pragma unroll
        for (int ni = 0; ni < 2; ni++)
          acc[mi][ni] = __builtin_amdgcn_mfma_f32_32x32x16_bf16(a[mi], b[ni], acc[mi][ni], 0, 0, 0);
    }
    asm volatile("s_waitcnt vmcnt(0)" ::: "memory");
    __syncthreads();
  }
#undef DMA1
#undef DMA_TILE
}

#define CS_LD 136
__device__ __forceinline__ void gemm_ldsA_k128(const bf16_t* __restrict__ B, f32x16 (&acc)[2][2], bf16_t* sm) {
  const int tidx_ = opaque_tid();
  const int tid = tidx_, lane = tid & 63, wave = tid >> 6, wm = wave >> 1, wn = wave & 1;
  const int lr = tid >> 3, lc = (tid & 7) * 8;
  const bf16_t* Bp = B + (size_t)lr * 128 + lc;
  bf16_t* sB = sm + 128 * CS_LD;
  uint4 b0 = *(const uint4*)(Bp), b1 = *(const uint4*)(Bp + 32 * 128), b2 = *(const uint4*)(Bp + 64 * 128), b3 = *(const uint4*)(Bp + 96 * 128);
  uint4 c0 = *(const uint4*)(Bp + 64), c1 = *(const uint4*)(Bp + 32 * 128 + 64), c2 = *(const uint4*)(Bp + 64 * 128 + 64), c3 = *(const uint4*)(Bp + 96 * 128 + 64);
  const int so = lr * 72 + lc;
  *(uint4*)(sB + so) = b0; *(uint4*)(sB + so + 32 * 72) = b1; *(uint4*)(sB + so + 64 * 72) = b2; *(uint4*)(sB + so + 96 * 72) = b3;
  *(uint4*)(sB + 128 * 72 + so) = c0; *(uint4*)(sB + 128 * 72 + so + 32 * 72) = c1;
  *(uint4*)(sB + 128 * 72 + so + 64 * 72) = c2; *(uint4*)(sB + 128 * 72 + so + 96 * 72) = c3;
#pragma unroll
  for (int mi = 0; mi < 2; mi++)
#pragma unroll
    for (int ni = 0; ni < 2; ni++)
#pragma unroll
      for (int r = 0; r < 16; r++) acc[mi][ni][r] = 0.f;
  __syncthreads();
  const int aoff = (wm * 64 + (lane & 31)) * CS_LD + (lane >> 5) * 8;
  const int boff = (wn * 64 + (lane & 31)) * 72 + (lane >> 5) * 8;
#pragma unroll
  for (int kt = 0; kt < 2; kt++)
#pragma unroll
    for (int kk = 0; kk < 4; ++kk) {
      bf16x8 a[2], b[2];
#pragma unroll
      for (int mi = 0; mi < 2; mi++) a[mi] = *(const bf16x8*)(sm + aoff + mi * 32 * CS_LD + kt * 64 + kk * 16);
#pragma unroll
      for (int ni = 0; ni < 2; ni++) b[ni] = *(const bf16x8*)(sB + kt * 128 * 72 + boff + ni * 32 * 72 + kk * 16);
#pragma unroll
      for (int mi = 0; mi < 2; mi++)
#pragma unroll
        for (int ni = 0; ni < 2; ni++)
          acc[mi][ni] = __builtin_amdgcn_mfma_f32_32x32x16_bf16(a[mi], b[ni], acc[mi][ni], 0, 0, 0);
    }
  __syncthreads();
}

#define EPI_ROW(wm, mi, r, lane) ((wm) * 64 + (mi) * 32 + 8 * ((r) >> 2) + 4 * ((lane) >> 5) + ((r) & 3))
#define EPI_COL(wn, ni, lane) ((wn) * 64 + (ni) * 32 + ((lane) & 31))

template <class F>
__device__ __forceinline__ void tconv(bf16_t* dst, int N, int K, F src, float* tile, int& rot) {
  const int tidx_ = opaque_tid();
  const int tn = N >> 6, tk = K >> 6;
  int first = (int)blockIdx.x - rot; if (first < 0) first += gridDim.x;
  rot = (rot + tn * tk) % (int)gridDim.x;
  for (int it = first; it < tn * tk; it += gridDim.x) {
    const int n0 = (it % tn) << 6, k0 = (it / tn) << 6;
    for (int i = tidx_; i < 4096; i += 256) { int kk = i >> 6, nn = i & 63; tile[kk * 65 + nn] = src(k0 + kk, n0 + nn); }
    __syncthreads();
    for (int i = tidx_; i < 4096; i += 256) { int nn = i >> 6, kk = i & 63; dst[(size_t)(n0 + nn) * K + k0 + kk] = f2bf(tile[kk * 65 + nn]); }
    __syncthreads();
  }
}

__device__ __forceinline__ void phase_prep(const Params& p, unsigned char* smem) {
  const int tidx_ = opaque_tid();
  unsigned char* ws = p.ws;
  float* tile = (float*)smem;
  int rot = 0;
  const int tid = tidx_;
  const int gtid = blockIdx.x * 256 + tid, gsz = gridDim.x * 256;
  {
    const float* w_in = p.in[8];
    tconv((bf16_t*)(ws + OFF_WIN), 1536, 1024, [=](int k, int n) { return n < 1440 ? w_in[(size_t)k * 1440 + n] : 0.f; }, tile, rot);
    const float* w_uq = p.in[17]; const float* qn = p.in[16];
    tconv((bf16_t*)(ws + OFF_WUQ), 768, 256, [=](int k, int n) { return w_uq[k * 768 + n] * qn[k]; }, tile, rot);
    const float* w_ukv = p.in[19]; const float* kvn = p.in[18];
    tconv((bf16_t*)(ws + OFF_WUKV), 1024, 128, [=](int k, int n) { return w_ukv[k * 1024 + n] * kvn[k]; }, tile, rot);
    const float* wa = p.in[11]; const float* wx = p.in[13];
    for (int hd = 0; hd < 16; ++hd) {
      const int h = hd >> 1, d = hd & 1;
      tconv((bf16_t*)(ws + OFF_WGATE) + hd * 128 * 64, 128, 64, [=](int k, int n) {
        int wn = n >> 6, ty = (n >> 5) & 1, j = n & 31; int c = wn * 32 + j;
        const float* W = ty ? wx : wa;
        return W[((d * 8 + h) * 64 + k) * 64 + c]; }, tile, rot);
    }
    const float* w_out = p.in[22];
    tconv((bf16_t*)(ws + OFF_WOUT), 1024, 1024, [=](int k, int n) { return w_out[((k + 512) & 1023) * 1024 + n]; }, tile, rot);
    const float* c_w_in = p.in[23];
    tconv((bf16_t*)(ws + OFF_WCIN), 3072, 1024, [=](int k, int n) {
      int col;
      if (n < 1024) col = n;
      else { int q = n - 1024; int tl = q >> 7, wi = q & 127; int wn = wi >> 6, ty = (wi >> 5) & 1, j = wi & 31; col = 1024 + ty * 1024 + tl * 64 + wn * 32 + j; }
      return c_w_in[(size_t)k * 3072 + col]; }, tile, rot);
    const float* c_w_out = p.in[25];
    tconv((bf16_t*)(ws + OFF_WCOUT), 1024, 1024, [=](int k, int n) { return c_w_out[k * 1024 + n]; }, tile, rot);
    const float* wq = p.in[26];
    for (int l = 0; l < 2; ++l)
      tconv((bf16_t*)(ws + OFF_WPQ) + (size_t)l * 2048 * 1024, 2048, 1024, [=](int k, int n) { return wq[((size_t)(l * 1024 + k)) * 2048 + n]; }, tile, rot);
  }
  {
    bf16_t* keys = (bf16_t*)(ws + OFF_KEYS);
    const float* k1 = p.in[27]; const float* k2 = p.in[28];
    for (int i = gtid; i < 65536; i += gsz) {
      int l = i >> 15, pp = (i >> 14) & 1, r = i & 16383;
      keys[i] = f2bf((pp ? k2 : k1)[l * 16384 + r]);
    }
    float* c8 = (float*)(ws + OFF_C8);
    const float* lam = p.in[15];
    for (int i = gtid; i < 1024; i += gsz) c8[i] = 8.f * log1pf(__expf(-lam[i])) * 1.44269504f;
    if (gtid < 16) ((int*)(ws + OFF_CNT))[gtid] = 0;
    for (int i = gtid; i < 2048; i += gsz) ((unsigned*)(ws + OFF_BAR))[i] = 0u;
  }
  {
    float* silu_s = (float*)smem;
    float* red = silu_s + 10240;
    float* mod = (float*)(ws + OFF_MOD);
    const float* cp = p.in[2]; const float* cs = p.in[3];
    const float* ada_w = p.in[4]; const float* ada_b = p.in[5];
    __syncthreads();
    for (int i = tid; i < 10240; i += 256) {
      int b = i >> 10, k = i & 1023;
      float c = b < 2 ? cp[b * 1024 + k] : cs[(b - 2) * 1024 + k];
      silu_s[i] = c / (1.f + __expf(-c));
    }
    __syncthreads();
    for (int it = blockIdx.x; it < 192; it += gridDim.x) {
      const int l = it / 96, n = (it % 96) * 64 + (tid & 63), kq = tid >> 6;
      float acc[10];
#pragma unroll
      for (int b = 0; b < 10; b++) acc[b] = 0.f;
#pragma unroll 8
      for (int k = kq * 256; k < kq * 256 + 256; ++k) {
        float w = ada_w[((size_t)(l * 1024 + k)) * 6144 + n];
#pragma unroll
        for (int b = 0; b < 10; b++) acc[b] += silu_s[b * 1024 + k] * w;
      }
#pragma unroll
      for (int b = 0; b < 10; b++) red[(kq * 10 + b) * 64 + (tid & 63)] = acc[b];
      __syncthreads();
      if (tid < 64) {
#pragma unroll
        for (int b = 0; b < 10; b++)
          mod[(l * 10 + b) * 6144 + n] = ada_b[l * 6144 + n] + red[(0 * 10 + b) * 64 + tid] + red[(1 * 10 + b) * 64 + tid] +
                                         red[(2 * 10 + b) * 64 + tid] + red[(3 * 10 + b) * 64 + tid];
      }
      __syncthreads();
    }
  }
}

#define U_SCALE 64.f
#define V_SCALE 8.f
__device__ __forceinline__ unsigned pack_fp8x4(float4 a, float sc) {
  int pk = __builtin_amdgcn_cvt_pk_fp8_f32(a.x * sc, a.y * sc, 0, false);
  pk = __builtin_amdgcn_cvt_pk_fp8_f32(a.z * sc, a.w * sc, pk, true);
  return (unsigned)pk;
}
__device__ __forceinline__ void phase_uvconv(const Params& p, int l, int part, int nparts) {
  const int tidx_ = opaque_tid();
  const int gtid = blockIdx.x * 256 + tidx_, gsz = gridDim.x * 256;
  const float4* us = (const float4*)(p.in[29] + (size_t)l * 16384 * 1024);
  const float4* vs = (const float4*)(p.in[30] + (size_t)l * 16384 * 1024);
  unsigned* ud = (unsigned*)(p.ws + OFF_UT);
  unsigned* vd = (unsigned*)(p.ws + OFF_VTAB);
  for (int i = gtid + part * gsz; i < 16384 * 256; i += gsz * nparts) {
    ud[i] = pack_fp8x4(us[i], U_SCALE);
    vd[i] = pack_fp8x4(vs[i], V_SCALE);
  }
}

__device__ __forceinline__ void phase_norm(const Params& p, int layer, int which, bool from_input) {
  const int tidx_ = opaque_tid();
  const int lane = tidx_ & 63;
  const int gw = (blockIdx.x * 256 + tidx_) >> 6, nw = gridDim.x * 4;
  const float* g = (which == 1 ? p.in[6] : p.in[7]) + layer * 1024;
  const float* mod = (const float*)(p.ws + OFF_MOD);
  bf16_t* H = (bf16_t*)(p.ws + OFF_H);
  for (int t = gw; t < T_TOK; t += nw) {
    SeqInfo si = seq_of(t);
    const float* x = from_input ? xin_row(p, t) : p.out + (size_t)t * 1024;
    const float* md = mod + (layer * 10 + si.b) * 6144 + (which == 1 ? 0 : 3 * 1024);
    float4 v[4];
    float ss = 0.f;
#pragma unroll
    for (int j = 0; j < 4; j++) {
      v[j] = *(const float4*)(x + j * 256 + lane * 4);
      ss += v[j].x * v[j].x + v[j].y * v[j].y + v[j].z * v[j].z + v[j].w * v[j].w;
    }
    ss = wave_sum(ss);
    const float rstd = rsqrtf(ss * (1.f / 1024.f) + EPSN);
#pragma unroll
    for (int j = 0; j < 4; j++) {
      const int idx = j * 256 + lane * 4;
      float4 gg = *(const float4*)(g + idx);
      float4 sh = *(const float4*)(md + idx);
      float4 sc = *(const float4*)(md + 1024 + idx);
      float y0 = v[j].x * rstd * gg.x * (1.f + sc.x) + sh.x;
      float y1 = v[j].y * rstd * gg.y * (1.f + sc.y) + sh.y;
      float y2 = v[j].z * rstd * gg.z * (1.f + sc.z) + sh.z;
      float y3 = v[j].w * rstd * gg.w * (1.f + sc.w) + sh.w;
      *(uint2*)(H + (size_t)t * 1024 + idx) = make_uint2(pack2(y0, y1), pack2(y2, y3));
    }
  }
}

#define XCD_TILE_LOOP(NT_, mt_, nt_)                                                               \
  for (int li_ = (int)(blockIdx.x >> 3), mt_ = 0, nt_ = 0;                                          \
       li_ < 64 * (NT_) && ((mt_ = (li_ / (NT_)) * 8 + (int)(blockIdx.x & 7)), (nt_ = li_ % (NT_)), true); \
       li_ += (int)(gridDim.x >> 3))

__device__ __forceinline__ void tile_copy_out(const bf16_t* cs, bf16_t* dst, size_t ldd, int nchunk_log2) {
  const int tidx_ = opaque_tid();
  const int per_row = 1 << nchunk_log2;
  const int total = 128 << nchunk_log2;
  for (int c = tidx_; c < total; c += 256) {
    const int row = c >> nchunk_log2, cc = c & (per_row - 1);
    const uint4 v = *(const uint4*)(cs + row * CS_LD + cc * 8);
    *(uint4*)(dst + (size_t)row * ldd + cc * 8) = v;
  }
}

__device__ __forceinline__ void phase_g1(const Params& p, bf16_t* sm) {
  const int tidx_ = opaque_tid();
  const int lane = tidx_ & 63, wave = tidx_ >> 6, wm = wave >> 1, wn = wave & 1;
  const bf16_t* H = (const bf16_t*)(p.ws + OFF_H);
  const bf16_t* W = (const bf16_t*)(p.ws + OFF_WIN);
  bf16_t* Z1 = (bf16_t*)(p.ws + OFF_R1);
  bf16_t* Z2 = (bf16_t*)(p.ws + OFF_Z2);
  XCD_TILE_LOOP(12, mt, nt) {
    f32x16 acc[2][2];
    gemm_tile(H + (size_t)mt * 128 * 1024, 1024, W + (size_t)nt * 128 * 1024, 1024, 1024, acc, sm);
#pragma unroll
    for (int mi = 0; mi < 2; mi++)
#pragma unroll
      for (int ni = 0; ni < 2; ni++)
#pragma unroll
        for (int r = 0; r < 16; r++)
          sm[EPI_ROW(wm, mi, r, lane) * CS_LD + EPI_COL(wn, ni, lane)] = f2bf(acc[mi][ni][r]);
    __syncthreads();
    if (nt < 8) tile_copy_out(sm, Z1 + (size_t)mt * 128 * 1024 + nt * 128, 1024, 4);
    else if (nt < 11) tile_copy_out(sm, Z2 + (size_t)mt * 128 * 416 + (nt - 8) * 128, 416, 4);
    else tile_copy_out(sm, Z2 + (size_t)mt * 128 * 416 + 384, 416, 2);
    __syncthreads();
  }
}

__device__ __forceinline__ void phase_conv0(const Params& p) {
  const int tidx_ = opaque_tid();
  const int gtid = blockIdx.x * 256 + tidx_, gsz = gridDim.x * 256;
  const bf16_t* Z1 = (const bf16_t*)(p.ws + OFF_R1);
  const bf16_t* Z2 = (const bf16_t*)(p.ws + OFF_Z2);
  bf16_t* XC = (bf16_t*)(p.ws + OFF_XC);
  const float* cw = p.in[9]; const float* cb = p.in[10];
  for (int i = gtid; i < T_TOK * 64; i += gsz) {
    const int t = i >> 6, c = (i & 63) * 8;
    SeqInfo si = seq_of(t);
    float acc[8];
#pragma unroll
    for (int j = 0; j < 8; j++) acc[j] = cb[c + j];
#pragma unroll
    for (int k = 0; k < 4; k++) {
      const int tt = t + k - 2;
      if (tt >= si.s0 && tt < si.s0 + si.S) {
        uint4 v = *(const uint4*)(Z1 + (size_t)tt * 1024 + c);
        const float* w = cw + k * 512 + c;
        acc[0] += w[0] * lo2f(v.x); acc[1] += w[1] * hi2f(v.x);
        acc[2] += w[2] * lo2f(v.y); acc[3] += w[3] * hi2f(v.y);
        acc[4] += w[4] * lo2f(v.z); acc[5] += w[5] * hi2f(v.z);
        acc[6] += w[6] * lo2f(v.w); acc[7] += w[7] * hi2f(v.w);
      }
    }
    *(uint4*)(XC + (size_t)t * 512 + c) = make_uint4(pack2(acc[0], acc[1]), pack2(acc[2], acc[3]), pack2(acc[4], acc[5]), pack2(acc[6], acc[7]));
  }
  const int lane = tidx_ & 63;
  const int gw = gtid >> 6, nw = gsz >> 6;
  float* rq = (float*)(p.ws + OFF_RSTDQ);
  float* rkv = (float*)(p.ws + OFF_RSTDKV);
  for (int t = gw; t < T_TOK; t += nw) {
    const bf16_t* z = Z2 + (size_t)t * 416;
    uint2 a = *(const uint2*)(z + lane * 4);
    unsigned b = *(const unsigned*)(z + 256 + lane * 2);
    float ssq = lo2f(a.x) * lo2f(a.x) + hi2f(a.x) * hi2f(a.x) + lo2f(a.y) * lo2f(a.y) + hi2f(a.y) * hi2f(a.y);
    float ssk = lo2f(b) * lo2f(b) + hi2f(b) * hi2f(b);
    ssq = wave_sum(ssq); ssk = wave_sum(ssk);
    if (lane == 0) { rq[t] = rsqrtf(ssq * (1.f / 256.f) + EPSN); rkv[t] = rsqrtf(ssk * (1.f / 128.f) + EPSN); }
  }
}

__device__ __forceinline__ void phase_g234(const Params& p, bf16_t* sm) {
  const int tidx_ = opaque_tid();
  const int lane = tidx_ & 63, wave = tidx_ >> 6, wm = wave >> 1, wn = wave & 1;
  const bf16_t* Z2 = (const bf16_t*)(p.ws + OFF_Z2);
  const bf16_t* XC = (const bf16_t*)(p.ws + OFF_XC);
  bf16_t* QR = (bf16_t*)(p.ws + OFF_H);
  bf16_t* Kb = (bf16_t*)(p.ws + OFF_B);
  bf16_t* Vt = (bf16_t*)(p.ws + OFF_VT);
  unsigned* AB = (unsigned*)p.out;
  const float* rq = (const float*)(p.ws + OFF_RSTDQ);
  const float* rkv = (const float*)(p.ws + OFF_RSTDKV);
  const float* c8 = (const float*)(p.ws + OFF_C8);
  for (int it = blockIdx.x; it < 15360; it += gridDim.x) {
    f32x16 acc[2][2];
    if (it < 3072) {
      const int mt = it / 6, nt = it % 6;
      gemm_tile(Z2 + (size_t)mt * 128 * 416, 416, (const bf16_t*)(p.ws + OFF_WUQ) + nt * 128 * 256, 256, 256, acc, sm);
#pragma unroll
      for (int mi = 0; mi < 2; mi++)
#pragma unroll
        for (int r = 0; r < 16; r++) {
          const int rl = EPI_ROW(wm, mi, r, lane);
          const float rs = rq[mt * 128 + rl];
#pragma unroll
          for (int ni = 0; ni < 2; ni++) sm[rl * CS_LD + EPI_COL(wn, ni, lane)] = f2bf(acc[mi][ni][r] * rs);
        }
      __syncthreads();
      tile_copy_out(sm, QR + (size_t)mt * 128 * 768 + nt * 128, 768, 4);
      __syncthreads();
    } else if (it < 7168) {
      const int j = it - 3072;
      const int mt = j >> 3, h = j & 7;
      gemm_tile(Z2 + (size_t)mt * 128 * 416 + 256, 416, (const bf16_t*)(p.ws + OFF_WUKV) + h * 128 * 128, 128, 128, acc, sm);
      SeqInfo si = seq_of(mt * 128);
      if (wn == 0) {
#pragma unroll
        for (int mi = 0; mi < 2; mi++)
#pragma unroll
          for (int r = 0; r < 16; r++) {
            const int row = mt * 128 + EPI_ROW(wm, mi, r, lane);
            const float rs = rkv[row];
            const size_t krow = (size_t)si.s0 * 8 + (size_t)h * si.S + (row - si.s0);
#pragma unroll
            for (int ni = 0; ni < 2; ni++)
              Kb[krow * 96 + ni * 32 + (lane & 31)] = f2bf(acc[mi][ni][r] * rs);
          }
      } else {
        bf16_t* vb = Vt + ((size_t)si.s0 * 8 + (size_t)h * si.S) * 64;
#pragma unroll
        for (int mi = 0; mi < 2; mi++)
#pragma unroll
          for (int rg = 0; rg < 4; rg++) {
            const int t4 = mt * 128 + wm * 64 + mi * 32 + 8 * rg + 4 * (lane >> 5);
            const float r0 = rkv[t4], r1 = rkv[t4 + 1], r2 = rkv[t4 + 2], r3 = rkv[t4 + 3];
#pragma unroll
            for (int ni = 0; ni < 2; ni++) {
              const int dv = ni * 32 + (lane & 31);
              uint2 pk = make_uint2(pack2(acc[mi][ni][rg * 4 + 0] * r0, acc[mi][ni][rg * 4 + 1] * r1),
                                    pack2(acc[mi][ni][rg * 4 + 2] * r2, acc[mi][ni][rg * 4 + 3] * r3));
              const int ps_ = t4 - si.s0;
              const int pp_ = (ps_ & ~12) | ((ps_ & 4) << 1) | ((ps_ & 8) >> 1);
              *(uint2*)(vb + (size_t)dv * si.S + pp_) = pk;
            }
          }
      }
    } else {
      const int j = it - 7168;
      const int mt = j >> 4, hd = j & 15, h = hd >> 1, d = hd & 1;
      gemm_tile(XC + (size_t)mt * 128 * 512 + h * 64, 512, (const bf16_t*)(p.ws + OFF_WGATE) + hd * 128 * 64, 64, 64, acc, sm);
      const int c = h * 64 + wn * 32 + (lane & 31);
      const float ba = p.in[12][d * 512 + c], bx = p.in[14][d * 512 + c], cc8 = c8[d * 512 + c];
#pragma unroll
      for (int mi = 0; mi < 2; mi++)
#pragma unroll
        for (int r = 0; r < 16; r++) {
          const int row = mt * 128 + EPI_ROW(wm, mi, r, lane);
          const float rg = sigmoid_f(acc[mi][0][r] + ba);
          const float ig = sigmoid_f(acc[mi][1][r] + bx);
          const float l2a = -rg * cc8;
          const float a2 = fexp2(2.f * l2a);
          const float xv = bf2f(XC[(size_t)row * 512 + c]);
          const float bb = __builtin_amdgcn_sqrtf(fmaxf(1.f - a2, 0.f)) * ig * xv;
          AB[((size_t)d * T_TOK + row) * 512 + c] = pack2(l2a, bb);
        }
    }
  }
}

__device__ __forceinline__ void unpack8(uint4 v, float* f) {
  f[0] = lo2f(v.x); f[1] = hi2f(v.x); f[2] = lo2f(v.y); f[3] = hi2f(v.y);
  f[4] = lo2f(v.z); f[5] = hi2f(v.z); f[6] = lo2f(v.w); f[7] = hi2f(v.w);
}
__device__ __forceinline__ uint4 pack8(const float* f) {
  return make_uint4(pack2(f[0], f[1]), pack2(f[2], f[3]), pack2(f[4], f[5]), pack2(f[6], f[7]));
}
__device__ __forceinline__ float sumsq8(uint4 v) {
  float a0 = lo2f(v.x), a1 = hi2f(v.x), a2 = lo2f(v.y), a3 = hi2f(v.y), a4 = lo2f(v.z), a5 = hi2f(v.z), a6 = lo2f(v.w), a7 = hi2f(v.w);
  return a0 * a0 + a1 * a1 + a2 * a2 + a3 * a3 + a4 * a4 + a5 * a5 + a6 * a6 + a7 * a7;
}
__device__ __forceinline__ void norm_rope96(uint4 (&v)[12], const float* __restrict__ gain, float outscale, const float (&cs)[16], const float (&sn)[16]) {
  float ss = 0.f;
#pragma unroll
  for (int i = 0; i < 12; i++) ss += sumsq8(v[i]);
  const float rstd = rsqrtf(ss * (1.f / 96.f) + EPSN);
#pragma unroll
  for (int i = 0; i < 8; i++) {
    float f[8]; unpack8(v[i], f);
#pragma unroll
    for (int j = 0; j < 8; j++) f[j] = f[j] * rstd * gain[i * 8 + j] * outscale;
    v[i] = pack8(f);
  }
#pragma unroll
  for (int q = 0; q < 2; q++) {
    float f1[8], f2[8]; unpack8(v[8 + q], f1); unpack8(v[10 + q], f2);
#pragma unroll
    for (int j = 0; j < 8; j++) {
      const float r1 = f1[j] * rstd * gain[64 + q * 8 + j];
      const float r2 = f2[j] * rstd * gain[80 + q * 8 + j];
      const float c = cs[q * 8 + j], s = sn[q * 8 + j];
      f1[j] = (r1 * c - r2 * s) * outscale;
      f2[j] = (r2 * c + r1 * s) * outscale;
    }
    v[8 + q] = pack8(f1); v[10 + q] = pack8(f2);
  }
}

#define QSCALE (0.10206207261596575f * 1.4426950408889634f)

__device__ __forceinline__ void phase_qkprep_scan1(const Params& p) {
  const int tidx_ = opaque_tid();
  const int tid = tidx_;
  bf16_t* QR = (bf16_t*)(p.ws + OFF_H);
  bf16_t* Kb = (bf16_t*)(p.ws + OFF_B);
  const bf16_t* Z2 = (const bf16_t*)(p.ws + OFF_Z2);
  const unsigned* AB = (const unsigned*)p.out;
  float* aggA = (float*)(p.ws + OFF_AGGA);
  float* aggB = (float*)(p.ws + OFF_AGGB);
  for (int it = blockIdx.x; it < 4096; it += gridDim.x) {
    if (it < 2048) {
      const int i = it * 256 + tid;
      const int t = i >> 3, h = i & 7;
      SeqInfo si = seq_of(t);
      const float pos = (float)(t - si.s0);
      float cs[16], sn[16];
#pragma unroll
      for (int k = 0; k < 16; k++) {
        const float inv = exp2f(-(float)k * (13.287712379549449f / 16.f));
        float rev = pos * inv * 0.15915494309189535f;
        rev = rev - floorf(rev);
        cs[k] = __builtin_amdgcn_cosf(rev);
        sn[k] = __builtin_amdgcn_sinf(rev);
      }
      uint4 v[12];
      bf16_t* qp = QR + (size_t)t * 768 + h * 96;
#pragma unroll
      for (int k = 0; k < 12; k++) v[k] = *(const uint4*)(qp + k * 8);
      norm_rope96(v, p.in[20], QSCALE, cs, sn);
#pragma unroll
      for (int k = 0; k < 12; k++) *(uint4*)(qp + k * 8) = v[k];
      bf16_t* kp = Kb + ((size_t)si.s0 * 8 + (size_t)h * si.S + (t - si.s0)) * 96;
#pragma unroll
      for (int k = 0; k < 8; k++) v[k] = *(const uint4*)(kp + k * 8);
#pragma unroll
      for (int k = 0; k < 4; k++) v[8 + k] = *(const uint4*)(Z2 + (size_t)t * 416 + 384 + k * 8);
      norm_rope96(v, p.in[21], 1.f, cs, sn);
#pragma unroll
      for (int k = 0; k < 12; k++) *(uint4*)(kp + k * 8) = v[k];
    } else {
      const int i = (it - 2048) * 256 + tid;
      const int c = i & 511, ch = (i >> 9) & 511, d = i >> 18;
      const unsigned* ab = AB + ((size_t)d * T_TOK + (size_t)ch * 128) * 512 + c;
      float A = 1.f, Bv = 0.f;
      if (d == 0) {
        for (int sb = 0; sb < 128; sb += 16) {
          unsigned u[16];
#pragma unroll
          for (int j = 0; j < 16; j++) u[j] = ab[(size_t)(sb + j) * 512];
#pragma unroll
          for (int j = 0; j < 16; j++) { float a = fexp2(lo2f(u[j])); Bv = a * Bv + hi2f(u[j]); A *= a; }
        }
      } else {
        for (int sb = 112; sb >= 0; sb -= 16) {
          unsigned u[16];
#pragma unroll
          for (int j = 0; j < 16; j++) u[j] = ab[(size_t)(sb + j) * 512];
#pragma unroll
          for (int j = 15; j >= 0; j--) { float a = fexp2(lo2f(u[j])); Bv = a * Bv + hi2f(u[j]); A *= a; }
        }
      }
      aggA[i] = A; aggB[i] = Bv;
    }
  }
}

__device__ __forceinline__ void phase_scan2(const Params& p) {
  const int tidx_ = opaque_tid();
  const int gtid = blockIdx.x * 256 + tidx_, gsz = gridDim.x * 256;
  const float* aggA = (const float*)(p.ws + OFF_AGGA);
  const float* aggB = (const float*)(p.ws + OFF_AGGB);
  float* carry = (float*)(p.ws + OFF_CARRY);
  for (int i = gtid; i < 10240; i += gsz) {
    const int d = i / 5120, rem = i % 5120, seq = rem >> 9, c = rem & 511;
    const int ch0 = seq < 2 ? seq * 128 : 256 + (seq - 2) * 32;
    const int nch = seq < 2 ? 128 : 32;
    float cr = 0.f;
    const int ob = ((d * 512) + ch0) * 512 + c;
    if (d == 0) {
      for (int jb = 0; jb < nch; jb += 16) {
        float av[16], bv[16];
#pragma unroll
        for (int j = 0; j < 16; j++) { av[j] = aggA[ob + (jb + j) * 512]; bv[j] = aggB[ob + (jb + j) * 512]; }
#pragma unroll
        for (int j = 0; j < 16; j++) { carry[ob + (jb + j) * 512] = cr; cr = av[j] * cr + bv[j]; }
      }
    } else {
      for (int jb = nch - 16; jb >= 0; jb -= 16) {
        float av[16], bv[16];
#pragma unroll
        for (int j = 0; j < 16; j++) { av[j] = aggA[ob + (jb + j) * 512]; bv[j] = aggB[ob + (jb + j) * 512]; }
#pragma unroll
        for (int j = 15; j >= 0; j--) { carry[ob + (jb + j) * 512] = cr; cr = av[j] * cr + bv[j]; }
      }
    }
  }
}

__device__ __forceinline__ void scan3_item(const Params& p, int it) {
  const int tidx_ = opaque_tid();
  const int i = it * 256 + tidx_;
  const int c = i & 511, ch = i >> 9;
  unsigned* AB = (unsigned*)p.out;
  bf16_t* Z1 = (bf16_t*)(p.ws + OFF_R1);
  unsigned* abf = AB + ((size_t)ch * 128) * 512 + c;
  unsigned* abb = AB + ((size_t)T_TOK + (size_t)ch * 128) * 512 + c;
  const float* aggA = (const float*)(p.ws + OFF_AGGA);
  const float* aggB = (const float*)(p.ws + OFF_AGGB);
  const int ch0 = ch < 256 ? (ch & ~127) : (ch & ~31);
  const int nch = ch < 256 ? 128 : 32;
  float hst = 0.f;
#pragma unroll 8
  for (int j = ch0; j < ch; j++) hst = aggA[j * 512 + c] * hst + aggB[j * 512 + c];
  for (int sb = 0; sb < 128; sb += 16) {
    unsigned u[16];
#pragma unroll
    for (int j = 0; j < 16; j++) u[j] = abf[(size_t)(sb + j) * 512];
#pragma unroll
    for (int j = 0; j < 16; j++) { hst = fexp2(lo2f(u[j])) * hst + hi2f(u[j]); u[j] = __float_as_uint(hst); }
#pragma unroll
    for (int j = 0; j < 16; j++) abf[(size_t)(sb + j) * 512] = u[j];
  }
  hst = 0.f;
#pragma unroll 8
  for (int j = ch0 + nch - 1; j > ch; j--) hst = aggA[(512 + j) * 512 + c] * hst + aggB[(512 + j) * 512 + c];
  bf16_t* zp = Z1 + ((size_t)ch * 128) * 1024 + 512 + c;
  for (int sb = 112; sb >= 0; sb -= 16) {
    unsigned u[16]; float fw[16]; unsigned short yv[16];
#pragma unroll
    for (int j = 0; j < 16; j++) { u[j] = abb[(size_t)(sb + j) * 512]; fw[j] = __uint_as_float(abf[(size_t)(sb + j) * 512]); yv[j] = zp[(size_t)(sb + j) * 1024]; }
#pragma unroll
    for (int j = 15; j >= 0; j--) {
      hst = fexp2(lo2f(u[j])) * hst + hi2f(u[j]);
      const float tot = hst + fw[j];
      yv[j] = f2bf(tot * gelu_t(bf2f(yv[j])));
    }
#pragma unroll
    for (int j = 0; j < 16; j++) zp[(size_t)(sb + j) * 1024] = yv[j];
  }
}

#define KS_STRIDE 104
#define VS_STRIDE 72
#define ATT_BUF (64 * KS_STRIDE + 64 * VS_STRIDE)
__device__ __forceinline__ float xhalf_max(float x) {
  auto r = __builtin_amdgcn_permlane32_swap(__float_as_int(x), __float_as_int(x), false, false);
  return fmaxf(__int_as_float(r[0]), __int_as_float(r[1]));
}
template <bool OFFS>
__device__ __forceinline__ void attn_item(const Params& p, int seq, int h, int qt, bf16_t* sm) {
  const int tidx_ = opaque_tid();
  const int tid = tidx_, lane = tid & 63, w = tid >> 6, hh = lane >> 5, l31 = lane & 31;
  int s0, S;
  if (seq < 2) { s0 = seq << 14; S = 16384; } else { s0 = 32768 + ((seq - 2) << 12); S = 4096; }
  const bf16_t* Q = (const bf16_t*)(p.ws + OFF_H) + ((size_t)(s0 + qt * 256)) * 768 + h * 96;
  const bf16_t* Kp = (const bf16_t*)(p.ws + OFF_B) + ((size_t)s0 * 8 + (size_t)h * S) * 96;
  const bf16_t* Vp = (const bf16_t*)(p.ws + OFF_VT) + ((size_t)s0 * 8 + (size_t)h * S) * 64;
  bf16_t* Z1 = (bf16_t*)(p.ws + OFF_R1);
  bf16x8 qf[2][6];
#pragma unroll
  for (int qs = 0; qs < 2; qs++)
#pragma unroll
    for (int kk = 0; kk < 6; kk++) qf[qs][kk] = *(const bf16x8*)(Q + (size_t)(w * 64 + qs * 32 + l31) * 768 + kk * 16 + hh * 8);
  f32x16 o00, o01, o10, o11;
#pragma unroll
  for (int r = 0; r < 16; r++) { o00[r] = 0.f; o01[r] = 0.f; o10[r] = 0.f; o11[r] = 0.f; }
  float l0 = 0.f, l1 = 0.f;
  float negc0 = 0.f, negc1 = 0.f;
  if (OFFS) {
    float qa = 0.f, qb = 0.f;
#pragma unroll
    for (int kk = 0; kk < 6; kk++)
#pragma unroll
      for (int j = 0; j < 8; j++) {
        const float x = bf2f((unsigned short)qf[0][kk][j]); qa += x * x;
        const float y = bf2f((unsigned short)qf[1][kk][j]); qb += y * y;
      }
    qa += __shfl_xor(qa, 32);
    qb += __shfl_xor(qb, 32);
    const float* gk = p.in[21];
    float gm = fmaxf(fabsf(gk[lane]), lane < 32 ? fabsf(gk[64 + lane]) : 0.f);
#pragma unroll
    for (int o_ = 32; o_ > 0; o_ >>= 1) gm = fmaxf(gm, __shfl_xor(gm, o_));
    negc0 = -(sqrtf(qa) * 9.797958971f * gm * 1.01f + 1e-3f);
    negc1 = -(sqrtf(qb) * 9.797958971f * gm * 1.01f + 1e-3f);
  }
  const int kr0 = tid / 12, kc0 = (tid % 12) * 8;
  const int kr1 = (tid + 256) / 12, kc1 = ((tid + 256) % 12) * 8;
  const int kr2 = (tid + 512) / 12, kc2 = ((tid + 512) % 12) * 8;
  const int vr0 = tid >> 3, vc0 = (tid & 7) * 8;
  const int vr1 = (tid + 256) >> 3, vc1 = vc0;
  const int ko0 = kr0 * KS_STRIDE + kc0, ko1 = kr1 * KS_STRIDE + kc1, ko2 = kr2 * KS_STRIDE + kc2;
  const int vo0 = 64 * KS_STRIDE + vr0 * VS_STRIDE + vc0, vo1 = 64 * KS_STRIDE + vr1 * VS_STRIDE + vc1;
  const unsigned kq0 = (unsigned)(kr0 * 96 + kc0), kq1 = (unsigned)(kr1 * 96 + kc1), kq2 = (unsigned)(kr2 * 96 + kc2);
  const unsigned vq0 = (unsigned)(vr0 * S + vc0), vq1 = (unsigned)(vr1 * S + vc1);
  uint4 rk0 = *(const uint4*)(Kp + kq0), rk1 = *(const uint4*)(Kp + kq1), rk2 = *(const uint4*)(Kp + kq2);
  uint4 rv0 = *(const uint4*)(Vp + vq0), rv1 = *(const uint4*)(Vp + vq1);
  const int nt = S >> 6;
  __syncthreads();
  *(uint4*)(sm + ko0) = rk0; *(uint4*)(sm + ko1) = rk1; *(uint4*)(sm + ko2) = rk2;
  *(uint4*)(sm + vo0) = rv0; *(uint4*)(sm + vo1) = rv1;
  __syncthreads();
  const int koff = l31 * KS_STRIDE + hh * 8;
  const int voff = 64 * KS_STRIDE + l31 * VS_STRIDE + hh * 8;
  for (int kt = 0; kt < nt; ++kt) {
    const bf16_t* Ks = sm + (kt & 1) * ATT_BUF;
    if (kt + 1 < nt) {
      const bf16_t* Kn = Kp + (size_t)(kt + 1) * 64 * 96;
      const bf16_t* Vn = Vp + (size_t)(kt + 1) * 64;
      rk0 = *(const uint4*)(Kn + kq0); rk1 = *(const uint4*)(Kn + kq1); rk2 = *(const uint4*)(Kn + kq2);
      rv0 = *(const uint4*)(Vn + vq0); rv1 = *(const uint4*)(Vn + vq1);
    }
#pragma unroll 1
    for (int sub = 0; sub < 2; sub++) {
      f32x16 sv0, sv1;
#pragma unroll
      for (int r = 0; r < 16; r++) { sv0[r] = 0.f; sv1[r] = 0.f; }
      const bf16_t* Kr = Ks + koff + sub * 32 * KS_STRIDE;
#pragma unroll
      for (int kk = 0; kk < 6; kk++) {
        bf16x8 kf = *(const bf16x8*)(Kr + kk * 16);
        sv0 = __builtin_amdgcn_mfma_f32_32x32x16_bf16(kf, qf[0][kk], sv0, 0, 0, 0);
        sv1 = __builtin_amdgcn_mfma_f32_32x32x16_bf16(kf, qf[1][kk], sv1, 0, 0, 0);
      }
      float ps0 = 0.f, ps1 = 0.f;
#pragma unroll
      for (int r = 0; r < 16; r++) { float pv = fexp2(OFFS ? sv0[r] + negc0 : sv0[r]); ps0 += pv; sv0[r] = pv; }
#pragma unroll
      for (int r = 0; r < 16; r++) { float pv = fexp2(OFFS ? sv1[r] + negc1 : sv1[r]); ps1 += pv; sv1[r] = pv; }
      l0 += ps0; l1 += ps1;
      const bf16_t* Vr = Ks + voff + sub * 32;
#pragma unroll
      for (int st = 0; st < 2; st++) {
        union { bf16x8 v; unsigned u[4]; } pf0, pf1;
#pragma unroll
        for (int j = 0; j < 4; j++) {
          pf0.u[j] = pack2(sv0[8 * st + 2 * j], sv0[8 * st + 2 * j + 1]);
          pf1.u[j] = pack2(sv1[8 * st + 2 * j], sv1[8 * st + 2 * j + 1]);
        }
        bf16x8 vfa = *(const bf16x8*)(Vr + 16 * st);
        bf16x8 vfb = *(const bf16x8*)(Vr + 32 * VS_STRIDE + 16 * st);
        o00 = __builtin_amdgcn_mfma_f32_32x32x16_bf16(vfa, pf0.v, o00, 0, 0, 0);
        o10 = __builtin_amdgcn_mfma_f32_32x32x16_bf16(vfa, pf1.v, o10, 0, 0, 0);
        o01 = __builtin_amdgcn_mfma_f32_32x32x16_bf16(vfb, pf0.v, o01, 0, 0, 0);
        o11 = __builtin_amdgcn_mfma_f32_32x32x16_bf16(vfb, pf1.v, o11, 0, 0, 0);
      }
    }
    if (kt + 1 < nt) {
      bf16_t* nK = sm + ((kt + 1) & 1) * ATT_BUF;
      *(uint4*)(nK + ko0) = rk0; *(uint4*)(nK + ko1) = rk1; *(uint4*)(nK + ko2) = rk2;
      *(uint4*)(nK + vo0) = rv0; *(uint4*)(nK + vo1) = rv1;
    }
    __syncthreads();
  }
#pragma unroll
  for (int qs = 0; qs < 2; qs++) {
    const float lq = qs ? l1 : l0;
    const float lt = lq + __shfl_xor(lq, 32);
    const float inv = 1.f / lt;
    const size_t trow = (size_t)(s0 + qt * 256 + w * 64 + qs * 32 + l31);
#pragma unroll
    for (int dvt = 0; dvt < 2; dvt++) {
      const f32x16& oo = qs ? (dvt ? o11 : o10) : (dvt ? o01 : o00);
#pragma unroll
      for (int rg = 0; rg < 4; rg++) {
        const int dv = dvt * 32 + 8 * rg + 4 * hh;
        uint2 pk = make_uint2(pack2(oo[rg * 4 + 0] * inv, oo[rg * 4 + 1] * inv), pack2(oo[rg * 4 + 2] * inv, oo[rg * 4 + 3] * inv));
        *(uint2*)(Z1 + trow * 1024 + h * 64 + dv) = pk;
      }
    }
  }
}

__device__ __forceinline__ void phase_attn_scan3(const Params& p, bf16_t* sm) {
  const int tidx_ = opaque_tid();
  __shared__ int s_item;
  int* cnt = (int*)(p.ws + OFF_CNT);
  const int tid = tidx_;
  const int xcc = (int)(__builtin_amdgcn_s_getreg((3 << 11) | 20) & 0xFu) & 7;
  bool use_offs;
  {
    const int lane = tid & 63;
    const float* gq = p.in[20]; const float* gk = p.in[21];
    float a = fmaxf(fabsf(gq[lane]), lane < 32 ? fabsf(gq[64 + lane]) : 0.f);
    float b = fmaxf(fabsf(gk[lane]), lane < 32 ? fabsf(gk[64 + lane]) : 0.f);
#pragma unroll
    for (int o_ = 32; o_ > 0; o_ >>= 1) { a = fmaxf(a, __shfl_xor(a, o_)); b = fmaxf(b, __shfl_xor(b, o_)); }
    const float bound = 96.f * QSCALE * a * b * 1.03f;
    use_offs = !(bound < 64.f);
  }
  for (int dq = 0; dq < 8; ++dq) {
    const int q = (xcc + dq) & 7;
    while (true) {
      __syncthreads();
      if (tid == 0) s_item = atomicAdd(&cnt[q], 1);
      __syncthreads();
      const int it = s_item;
      if (it >= 256) break;
      int seq, h, qt;
      if (it < 128) { const int pair = q + 8 * (it >> 6); seq = pair >> 3; h = pair & 7; qt = it & 63; }
      else { const int j = it - 128; const int pair = q + 8 * (j >> 4); seq = 2 + (pair >> 3); h = pair & 7; qt = j & 15; }
      if (use_offs) attn_item<true>(p, seq, h, qt, sm); else attn_item<false>(p, seq, h, qt, sm);
    }
  }
  while (true) {
    __syncthreads();
    if (tid == 0) s_item = atomicAdd(&cnt[8], 1);
    __syncthreads();
    const int it = s_item;
    if (it >= 1024) break;
    scan3_item(p, it);
  }
}

__device__ __forceinline__ void phase_gres_norm(const Params& p, const bf16_t* A, const bf16_t* W, int layer, bool res_from_input, bf16_t* sm) {
  const int tidx_ = opaque_tid();
  const int lane = tidx_ & 63, wave = tidx_ >> 6, wm = wave >> 1, wn = wave & 1;
  const float* mod = (const float*)(p.ws + OFF_MOD);
  const float* g = p.in[7] + layer * 1024;
  bf16_t* H = (bf16_t*)(p.ws + OFF_H);
  for (int mt = blockIdx.x; mt < 512; mt += gridDim.x) {
    SeqInfo si = seq_of(mt * 128);
    const float* g1 = mod + (layer * 10 + si.b) * 6144 + 2 * 1024;
#pragma unroll 1
    for (int nt = 0; nt < 8; nt++) {
      f32x16 acc[2][2];
      gemm_tile(A + (size_t)mt * 128 * 1024, 1024, W + (size_t)nt * 128 * 1024, 1024, 1024, acc, sm);
      int mrow0 = mt * 128;
      asm volatile("" : "+s"(mrow0));
      const float* xb = res_from_input ? (mrow0 < 32768 ? p.in[0] : p.in[1] - (size_t)32768 * 1024) : p.out;
#pragma unroll
      for (int ni = 0; ni < 2; ni++) {
        const int col = nt * 128 + EPI_COL(wn, ni, lane);
        const float gg = g1[col];
#pragma unroll
        for (int mi = 0; mi < 2; mi++)
#pragma unroll
          for (int r = 0; r < 16; r++) {
            const unsigned off = (unsigned)((mrow0 + EPI_ROW(wm, mi, r, lane)) * 1024 + col);
            p.out[off] = xb[off] + gg * acc[mi][ni][r];
          }
      }
    }
    __syncthreads();
    const float* md = mod + (layer * 10 + si.b) * 6144 + 3 * 1024;
#pragma unroll 1
    for (int rr = wave; rr < 128; rr += 4) {
      const int t = mt * 128 + rr;
      const float* x = p.out + (size_t)t * 1024;
      float4 v[4];
      float ss = 0.f;
#pragma unroll
      for (int j = 0; j < 4; j++) {
        v[j] = *(const float4*)(x + j * 256 + lane * 4);
        ss += v[j].x * v[j].x + v[j].y * v[j].y + v[j].z * v[j].z + v[j].w * v[j].w;
      }
      ss = wave_sum(ss);
      const float rstd = rsqrtf(ss * (1.f / 1024.f) + EPSN);
#pragma unroll
      for (int j = 0; j < 4; j++) {
        const int idx = j * 256 + lane * 4;
        float4 gg = *(const float4*)(g + idx);
        float4 sh = *(const float4*)(md + idx);
        float4 sc = *(const float4*)(md + 1024 + idx);
        float y0 = v[j].x * rstd * gg.x * (1.f + sc.x) + sh.x;
        float y1 = v[j].y * rstd * gg.y * (1.f + sc.y) + sh.y;
        float y2 = v[j].z * rstd * gg.z * (1.f + sc.z) + sh.z;
        float y3 = v[j].w * rstd * gg.w * (1.f + sc.w) + sh.w;
        *(uint2*)(H + (size_t)t * 1024 + idx) = make_uint2(pack2(y0, y1), pack2(y2, y3));
      }
    }
    __syncthreads();
  }
}

__device__ __forceinline__ void phase_pq(const Params& p, int layer, bf16_t* sm) {
  const int tidx_ = opaque_tid();
  const int lane = tidx_ & 63, wave = tidx_ >> 6, wm = wave >> 1, wn = wave & 1;
  const bf16_t* H = (const bf16_t*)(p.ws + OFF_H);
  const bf16_t* W = (const bf16_t*)(p.ws + OFF_WPQ) + (size_t)layer * 2048 * 1024;
  bf16_t* PQ = (bf16_t*)(p.ws + OFF_R1);
  XCD_TILE_LOOP(16, mt, nt) {
    f32x16 acc[2][2];
    gemm_tile(H + (size_t)mt * 128 * 1024, 1024, W + (size_t)nt * 128 * 1024, 1024, 1024, acc, sm);
#pragma unroll
    for (int mi = 0; mi < 2; mi++)
#pragma unroll
      for (int ni = 0; ni < 2; ni++)
#pragma unroll
        for (int r = 0; r < 16; r++)
          sm[EPI_ROW(wm, mi, r, lane) * CS_LD + EPI_COL(wn, ni, lane)] = f2bf(acc[mi][ni][r]);
    __syncthreads();
    tile_copy_out(sm, PQ + (size_t)mt * 128 * 2048 + nt * 128, 2048, 4);
    __syncthreads();
  }
}

__device__ __forceinline__ int ordf(float x) { int b = __float_as_int(x); return b ^ ((b >> 31) & 0x7fffffff); }
__device__ __forceinline__ float unordf(int o) { return __int_as_float(o ^ ((o >> 31) & 0x7fffffff)); }
#define KEY_MIN ((int)0x80000000)
#define KINS(L, key)                                              \
  {                                                               \
    int cx_ = (key);                                              \
    _Pragma("unroll") for (int k_ = 0; k_ < 16; k_++) {           \
      const int hi_ = max(L[k_], cx_);                            \
      cx_ = min(L[k_], cx_);                                      \
      L[k_] = hi_;                                                \
    }                                                             \
  }
#define KSTAGE(c_, st_)                                                  \
  _Pragma("unroll") for (int i_ = 0; i_ < 16; i_++) {                     \
    if ((i_ & (st_)) == 0) {                                              \
      const int hi_ = max(c_[i_], c_[i_ + (st_)]);                        \
      const int lo_ = min(c_[i_], c_[i_ + (st_)]);                        \
      c_[i_] = hi_; c_[i_ + (st_)] = lo_;                                 \
    }                                                                     \
  }
#define KMERGE(L)                                                                     \
  {                                                                                   \
    int c_[16];                                                                       \
    _Pragma("unroll") for (int k_ = 0; k_ < 16; k_++) c_[k_] = max(L[k_], __shfl_xor(L[15 - k_], 1)); \
    KSTAGE(c_, 8) KSTAGE(c_, 4) KSTAGE(c_, 2) KSTAGE(c_, 1)                           \
    _Pragma("unroll") for (int k_ = 0; k_ < 16; k_++) L[k_] = c_[k_];                 \
  }

#define KSORT16(V) { \
    { const int hi_ = max(V[0], V[1]); const int lo_ = min(V[0], V[1]); V[0] = hi_; V[1] = lo_; } \
    { const int hi_ = max(V[3], V[2]); const int lo_ = min(V[3], V[2]); V[3] = hi_; V[2] = lo_; } \
    { const int hi_ = max(V[4], V[5]); const int lo_ = min(V[4], V[5]); V[4] = hi_; V[5] = lo_; } \
    { const int hi_ = max(V[7], V[6]); const int lo_ = min(V[7], V[6]); V[7] = hi_; V[6] = lo_; } \
    { const int hi_ = max(V[8], V[9]); const int lo_ = min(V[8], V[9]); V[8] = hi_; V[9] = lo_; } \
    { const int hi_ = max(V[11], V[10]); const int lo_ = min(V[11], V[10]); V[11] = hi_; V[10] = lo_; } \
    { const int hi_ = max(V[12], V[13]); const int lo_ = min(V[12], V[13]); V[12] = hi_; V[13] = lo_; } \
    { const int hi_ = max(V[15], V[14]); const int lo_ = min(V[15], V[14]); V[15] = hi_; V[14] = lo_; } \
    { const int hi_ = max(V[0], V[2]); const int lo_ = min(V[0], V[2]); V[0] = hi_; V[2] = lo_; } \
    { const int hi_ = max(V[1], V[3]); const int lo_ = min(V[1], V[3]); V[1] = hi_; V[3] = lo_; } \
    { const int hi_ = max(V[6], V[4]); const int lo_ = min(V[6], V[4]); V[6] = hi_; V[4] = lo_; } \
    { const int hi_ = max(V[7], V[5]); const int lo_ = min(V[7], V[5]); V[7] = hi_; V[5] = lo_; } \
    { const int hi_ = max(V[8], V[10]); const int lo_ = min(V[8], V[10]); V[8] = hi_; V[10] = lo_; } \
    { const int hi_ = max(V[9], V[11]); const int lo_ = min(V[9], V[11]); V[9] = hi_; V[11] = lo_; } \
    { const int hi_ = max(V[14], V[12]); const int lo_ = min(V[14], V[12]); V[14] = hi_; V[12] = lo_; } \
    { const int hi_ = max(V[15], V[13]); const int lo_ = min(V[15], V[13]); V[15] = hi_; V[13] = lo_; } \
    { const int hi_ = max(V[0], V[1]); const int lo_ = min(V[0], V[1]); V[0] = hi_; V[1] = lo_; } \
    { const int hi_ = max(V[2], V[3]); const int lo_ = min(V[2], V[3]); V[2] = hi_; V[3] = lo_; } \
    { const int hi_ = max(V[5], V[4]); const int lo_ = min(V[5], V[4]); V[5] = hi_; V[4] = lo_; } \
    { const int hi_ = max(V[7], V[6]); const int lo_ = min(V[7], V[6]); V[7] = hi_; V[6] = lo_; } \
    { const int hi_ = max(V[8], V[9]); const int lo_ = min(V[8], V[9]); V[8] = hi_; V[9] = lo_; } \
    { const int hi_ = max(V[10], V[11]); const int lo_ = min(V[10], V[11]); V[10] = hi_; V[11] = lo_; } \
    { const int hi_ = max(V[13], V[12]); const int lo_ = min(V[13], V[12]); V[13] = hi_; V[12] = lo_; } \
    { const int hi_ = max(V[15], V[14]); const int lo_ = min(V[15], V[14]); V[15] = hi_; V[14] = lo_; } \
    { const int hi_ = max(V[0], V[4]); const int lo_ = min(V[0], V[4]); V[0] = hi_; V[4] = lo_; } \
    { const int hi_ = max(V[1], V[5]); const int lo_ = min(V[1], V[5]); V[1] = hi_; V[5] = lo_; } \
    { const int hi_ = max(V[2], V[6]); const int lo_ = min(V[2], V[6]); V[2] = hi_; V[6] = lo_; } \
    { const int hi_ = max(V[3], V[7]); const int lo_ = min(V[3], V[7]); V[3] = hi_; V[7] = lo_; } \
    { const int hi_ = max(V[12], V[8]); const int lo_ = min(V[12], V[8]); V[12] = hi_; V[8] = lo_; } \
    { const int hi_ = max(V[13], V[9]); const int lo_ = min(V[13], V[9]); V[13] = hi_; V[9] = lo_; } \
    { const int hi_ = max(V[14], V[10]); const int lo_ = min(V[14], V[10]); V[14] = hi_; V[10] = lo_; } \
    { const int hi_ = max(V[15], V[11]); const int lo_ = min(V[15], V[11]); V[15] = hi_; V[11] = lo_; } \
    { const int hi_ = max(V[0], V[2]); const int lo_ = min(V[0], V[2]); V[0] = hi_; V[2] = lo_; } \
    { const int hi_ = max(V[1], V[3]); const int lo_ = min(V[1], V[3]); V[1] = hi_; V[3] = lo_; } \
    { const int hi_ = max(V[4], V[6]); const int lo_ = min(V[4], V[6]); V[4] = hi_; V[6] = lo_; } \
    { const int hi_ = max(V[5], V[7]); const int lo_ = min(V[5], V[7]); V[5] = hi_; V[7] = lo_; } \
    { const int hi_ = max(V[10], V[8]); const int lo_ = min(V[10], V[8]); V[10] = hi_; V[8] = lo_; } \
    { const int hi_ = max(V[11], V[9]); const int lo_ = min(V[11], V[9]); V[11] = hi_; V[9] = lo_; } \
    { const int hi_ = max(V[14], V[12]); const int lo_ = min(V[14], V[12]); V[14] = hi_; V[12] = lo_; } \
    { const int hi_ = max(V[15], V[13]); const int lo_ = min(V[15], V[13]); V[15] = hi_; V[13] = lo_; } \
    { const int hi_ = max(V[0], V[1]); const int lo_ = min(V[0], V[1]); V[0] = hi_; V[1] = lo_; } \
    { const int hi_ = max(V[2], V[3]); const int lo_ = min(V[2], V[3]); V[2] = hi_; V[3] = lo_; } \
    { const int hi_ = max(V[4], V[5]); const int lo_ = min(V[4], V[5]); V[4] = hi_; V[5] = lo_; } \
    { const int hi_ = max(V[6], V[7]); const int lo_ = min(V[6], V[7]); V[6] = hi_; V[7] = lo_; } \
    { const int hi_ = max(V[9], V[8]); const int lo_ = min(V[9], V[8]); V[9] = hi_; V[8] = lo_; } \
    { const int hi_ = max(V[11], V[10]); const int lo_ = min(V[11], V[10]); V[11] = hi_; V[10] = lo_; } \
    { const int hi_ = max(V[13], V[12]); const int lo_ = min(V[13], V[12]); V[13] = hi_; V[12] = lo_; } \
    { const int hi_ = max(V[15], V[14]); const int lo_ = min(V[15], V[14]); V[15] = hi_; V[14] = lo_; } \
    { const int hi_ = max(V[0], V[8]); const int lo_ = min(V[0], V[8]); V[0] = hi_; V[8] = lo_; } \
    { const int hi_ = max(V[1], V[9]); const int lo_ = min(V[1], V[9]); V[1] = hi_; V[9] = lo_; } \
    { const int hi_ = max(V[2], V[10]); const int lo_ = min(V[2], V[10]); V[2] = hi_; V[10] = lo_; } \
    { const int hi_ = max(V[3], V[11]); const int lo_ = min(V[3], V[11]); V[3] = hi_; V[11] = lo_; } \
    { const int hi_ = max(V[4], V[12]); const int lo_ = min(V[4], V[12]); V[4] = hi_; V[12] = lo_; } \
    { const int hi_ = max(V[5], V[13]); const int lo_ = min(V[5], V[13]); V[5] = hi_; V[13] = lo_; } \
    { const int hi_ = max(V[6], V[14]); const int lo_ = min(V[6], V[14]); V[6] = hi_; V[14] = lo_; } \
    { const int hi_ = max(V[7], V[15]); const int lo_ = min(V[7], V[15]); V[7] = hi_; V[15] = lo_; } \
    { const int hi_ = max(V[0], V[4]); const int lo_ = min(V[0], V[4]); V[0] = hi_; V[4] = lo_; } \
    { const int hi_ = max(V[1], V[5]); const int lo_ = min(V[1], V[5]); V[1] = hi_; V[5] = lo_; } \
    { const int hi_ = max(V[2], V[6]); const int lo_ = min(V[2], V[6]); V[2] = hi_; V[6] = lo_; } \
    { const int hi_ = max(V[3], V[7]); const int lo_ = min(V[3], V[7]); V[3] = hi_; V[7] = lo_; } \
    { const int hi_ = max(V[8], V[12]); const int lo_ = min(V[8], V[12]); V[8] = hi_; V[12] = lo_; } \
    { const int hi_ = max(V[9], V[13]); const int lo_ = min(V[9], V[13]); V[9] = hi_; V[13] = lo_; } \
    { const int hi_ = max(V[10], V[14]); const int lo_ = min(V[10], V[14]); V[10] = hi_; V[14] = lo_; } \
    { const int hi_ = max(V[11], V[15]); const int lo_ = min(V[11], V[15]); V[11] = hi_; V[15] = lo_; } \
    { const int hi_ = max(V[0], V[2]); const int lo_ = min(V[0], V[2]); V[0] = hi_; V[2] = lo_; } \
    { const int hi_ = max(V[1], V[3]); const int lo_ = min(V[1], V[3]); V[1] = hi_; V[3] = lo_; } \
    { const int hi_ = max(V[4], V[6]); const int lo_ = min(V[4], V[6]); V[4] = hi_; V[6] = lo_; } \
    { const int hi_ = max(V[5], V[7]); const int lo_ = min(V[5], V[7]); V[5] = hi_; V[7] = lo_; } \
    { const int hi_ = max(V[8], V[10]); const int lo_ = min(V[8], V[10]); V[8] = hi_; V[10] = lo_; } \
    { const int hi_ = max(V[9], V[11]); const int lo_ = min(V[9], V[11]); V[9] = hi_; V[11] = lo_; } \
    { const int hi_ = max(V[12], V[14]); const int lo_ = min(V[12], V[14]); V[12] = hi_; V[14] = lo_; } \
    { const int hi_ = max(V[13], V[15]); const int lo_ = min(V[13], V[15]); V[13] = hi_; V[15] = lo_; } \
    { const int hi_ = max(V[0], V[1]); const int lo_ = min(V[0], V[1]); V[0] = hi_; V[1] = lo_; } \
    { const int hi_ = max(V[2], V[3]); const int lo_ = min(V[2], V[3]); V[2] = hi_; V[3] = lo_; } \
    { const int hi_ = max(V[4], V[5]); const int lo_ = min(V[4], V[5]); V[4] = hi_; V[5] = lo_; } \
    { const int hi_ = max(V[6], V[7]); const int lo_ = min(V[6], V[7]); V[6] = hi_; V[7] = lo_; } \
    { const int hi_ = max(V[8], V[9]); const int lo_ = min(V[8], V[9]); V[8] = hi_; V[9] = lo_; } \
    { const int hi_ = max(V[10], V[11]); const int lo_ = min(V[10], V[11]); V[10] = hi_; V[11] = lo_; } \
    { const int hi_ = max(V[12], V[13]); const int lo_ = min(V[12], V[13]); V[12] = hi_; V[13] = lo_; } \
    { const int hi_ = max(V[14], V[15]); const int lo_ = min(V[14], V[15]); V[14] = hi_; V[15] = lo_; } \
  }
#define KMERGE2(L, G) { \
    int c_[16]; \
    _Pragma("unroll") for (int k_ = 0; k_ < 16; k_++) c_[k_] = max(L[k_], G[15 - k_]); \
    KSTAGE(c_, 8) KSTAGE(c_, 4) KSTAGE(c_, 2) KSTAGE(c_, 1) \
    _Pragma("unroll") for (int k_ = 0; k_ < 16; k_++) L[k_] = c_[k_]; \
  }
__device__ __forceinline__ void phase_topk(const Params& p, int layer, bf16_t* sm) {
  const int tidx_ = opaque_tid();
  const int tid = tidx_, lane = tid & 63, wave = tid >> 6, wm = wave >> 1, wn = wave & 1;
  const bf16_t* H = (const bf16_t*)(p.ws + OFF_H);
  const bf16_t* WPQ = (const bf16_t*)(p.ws + OFF_WPQ) + (size_t)layer * 2048 * 1024;
  const bf16_t* KEYS = (const bf16_t*)(p.ws + OFF_KEYS) + (size_t)layer * 2 * 16384;
  int* IDX = (int*)(p.ws + OFF_IDX);
  float* GW = (float*)(p.ws + OFF_GW);
  float* sc = (float*)sm;
  int* ib = (int*)sm;
  const int r = tid >> 1, hf = tid & 1;
#pragma unroll 1
  for (int mt = blockIdx.x; mt < 512; mt += gridDim.x)
#pragma unroll 1
  for (int h = 0; h < 8; h++) {
    int k1[16], k2[16];
#pragma unroll
    for (int pp = 0; pp < 2; pp++) {
      f32x16 acc[2][2];
      gemm_tile(H + (size_t)mt * 128 * 1024, 1024, WPQ + (size_t)(h * 256 + pp * 128) * 1024, 1024, 1024, acc, sm);
#pragma unroll
      for (int mi = 0; mi < 2; mi++)
#pragma unroll
        for (int ni = 0; ni < 2; ni++)
#pragma unroll
          for (int rr = 0; rr < 16; rr++)
            sm[EPI_ROW(wm, mi, rr, lane) * CS_LD + EPI_COL(wn, ni, lane)] = f2bf(acc[mi][ni][rr]);
      gemm_ldsA_k128(KEYS + pp * 16384, acc, sm);
#pragma unroll
      for (int mi = 0; mi < 2; mi++)
#pragma unroll
        for (int ni = 0; ni < 2; ni++)
#pragma unroll
          for (int rr = 0; rr < 16; rr++)
            sc[EPI_ROW(wm, mi, rr, lane) * 130 + wn * 65 + ni * 32 + (lane & 31)] = acc[mi][ni][rr];
      __syncthreads();
      int L[16];
      const float* rp = sc + r * 130 + hf * 65;
      const int ibase = 127 - hf * 64;
#pragma unroll
      for (int j = 0; j < 16; j++) L[j] = (ordf(rp[j]) & ~127) | (ibase - j);
      KSORT16(L);
#pragma unroll 1
      for (int g = 1; g < 4; g++) {
        int G[16];
#pragma unroll
        for (int j = 0; j < 16; j++) G[j] = (ordf(rp[g * 16 + j]) & ~127) | (ibase - (g * 16 + j));
        KSORT16(G);
        KMERGE2(L, G);
      }
      KMERGE(L);
      if (pp == 0) {
#pragma unroll
        for (int k = 0; k < 16; k++) k1[k] = L[k];
      } else {
#pragma unroll
        for (int k = 0; k < 16; k++) k2[k] = L[k];
      }
      __syncthreads();
    }
    if (hf == 0) {
#pragma unroll
      for (int k = 0; k < 16; k++) { ib[r * 32 + k] = 127 - (k1[k] & 127); ib[r * 32 + 16 + k] = 127 - (k2[k] & 127); }
    }
    float A[16], B[16];
#pragma unroll
    for (int k = 0; k < 16; k++) {
      const float v1 = unordf(k1[k] & ~127), v2 = unordf(k2[k] & ~127);
      A[k] = hf ? v2 : v1;
      B[k] = hf ? v1 : v2;
    }
    int F[16], F2[16];
    F[0] = (ordf(A[0] + B[1]) & ~255) | (255 - (hf ? 16 : 1));
    F[1] = (ordf(A[0] + B[2]) & ~255) | (255 - (hf ? 32 : 2));
    F[2] = (ordf(A[0] + B[3]) & ~255) | (255 - (hf ? 48 : 3));
    F[3] = (ordf(A[0] + B[4]) & ~255) | (255 - (hf ? 64 : 4));
    F[4] = (ordf(A[0] + B[5]) & ~255) | (255 - (hf ? 80 : 5));
    F[5] = (ordf(A[0] + B[6]) & ~255) | (255 - (hf ? 96 : 6));
    F[6] = (ordf(A[0] + B[7]) & ~255) | (255 - (hf ? 112 : 7));
    F[7] = (ordf(A[0] + B[8]) & ~255) | (255 - (hf ? 128 : 8));
    F[8] = (ordf(A[0] + B[9]) & ~255) | (255 - (hf ? 144 : 9));
    F[9] = (ordf(A[0] + B[10]) & ~255) | (255 - (hf ? 160 : 10));
    F[10] = (ordf(A[0] + B[11]) & ~255) | (255 - (hf ? 176 : 11));
    F[11] = (ordf(A[0] + B[12]) & ~255) | (255 - (hf ? 192 : 12));
    F[12] = (ordf(A[0] + B[13]) & ~255) | (255 - (hf ? 208 : 13));
    F[13] = (ordf(A[0] + B[14]) & ~255) | (255 - (hf ? 224 : 14));
    F[14] = (ordf(A[0] + B[15]) & ~255) | (255 - (hf ? 240 : 15));
    F[15] = (ordf(A[1] + B[2]) & ~255) | (255 - (hf ? 33 : 18));
    F2[0] = (ordf(A[1] + B[3]) & ~255) | (255 - (hf ? 49 : 19));
    F2[1] = (ordf(A[1] + B[4]) & ~255) | (255 - (hf ? 65 : 20));
    F2[2] = (ordf(A[1] + B[5]) & ~255) | (255 - (hf ? 81 : 21));
    F2[3] = (ordf(A[1] + B[6]) & ~255) | (255 - (hf ? 97 : 22));
    F2[4] = (ordf(A[1] + B[7]) & ~255) | (255 - (hf ? 113 : 23));
    F2[5] = (ordf(A[2] + B[3]) & ~255) | (255 - (hf ? 50 : 35));
    F2[6] = (ordf(A[2] + B[4]) & ~255) | (255 - (hf ? 66 : 36));
    F2[7] = hf ? KEY_MIN : ((ordf(A[0] + B[0]) & ~255) | (255 - 0));
    F2[8] = hf ? KEY_MIN : ((ordf(A[1] + B[1]) & ~255) | (255 - 17));
    F2[9] = hf ? KEY_MIN : ((ordf(A[2] + B[2]) & ~255) | (255 - 34));
    F2[10] = hf ? KEY_MIN : ((ordf(A[3] + B[3]) & ~255) | (255 - 51));
    F2[11] = KEY_MIN;
    F2[12] = KEY_MIN;
    F2[13] = KEY_MIN;
    F2[14] = KEY_MIN;
    F2[15] = KEY_MIN;
    KSORT16(F);
    KSORT16(F2);
    KMERGE2(F, F2);
    KMERGE(F);
    __syncthreads();
    float e[16], se = 0.f;
    const float fmx = unordf(F[0] & ~255);
#pragma unroll
    for (int k = 0; k < 16; k++) { e[k] = __expf(unordf(F[k] & ~255) - fmx); se += e[k]; }
    const float inv = 1.f / se;
    int oi[8]; float og[8];
    const int hmask = -hf;
#pragma unroll
    for (int k = 0; k < 8; k++) {
      const int key = (F[k + 8] & hmask) | (F[k] & ~hmask);
      const int j = 255 - (key & 255);
      oi[k] = ib[r * 32 + (j >> 4)] * 128 + ib[r * 32 + 16 + (j & 15)];
      og[k] = __int_as_float((__float_as_int(e[k + 8]) & hmask) | (__float_as_int(e[k]) & ~hmask)) * inv;
    }
    const size_t o = ((size_t)(mt * 128 + r)) * 128 + h * 16 + hf * 8;
    *(int4*)(IDX + o) = make_int4(oi[0], oi[1], oi[2], oi[3]);
    *(int4*)(IDX + o + 4) = make_int4(oi[4], oi[5], oi[6], oi[7]);
    *(float4*)(GW + o) = make_float4(og[0], og[1], og[2], og[3]);
    *(float4*)(GW + o + 4) = make_float4(og[4], og[5], og[6], og[7]);
    __syncthreads();
    if (mt == (int)blockIdx.x) phase_uvconv(p, layer, h, 8);
  }
}

__device__ __forceinline__ float dot16_fp8(uint4 u, const f32x2* hf) {
  f32x2 a = __builtin_amdgcn_cvt_pk_f32_fp8((int)u.x, false) * hf[0];
  a += __builtin_amdgcn_cvt_pk_f32_fp8((int)u.x, true) * hf[1];
  a += __builtin_amdgcn_cvt_pk_f32_fp8((int)u.y, false) * hf[2];
  a += __builtin_amdgcn_cvt_pk_f32_fp8((int)u.y, true) * hf[3];
  a += __builtin_amdgcn_cvt_pk_f32_fp8((int)u.z, false) * hf[4];
  a += __builtin_amdgcn_cvt_pk_f32_fp8((int)u.z, true) * hf[5];
  a += __builtin_amdgcn_cvt_pk_f32_fp8((int)u.w, false) * hf[6];
  a += __builtin_amdgcn_cvt_pk_f32_fp8((int)u.w, true) * hf[7];
  return a.x + a.y;
}
__device__ __forceinline__ void fma16_fp8(f32x2* o, uint4 u, float a) {
  f32x2 aa = {a, a};
  o[0] += __builtin_amdgcn_cvt_pk_f32_fp8((int)u.x, false) * aa;
  o[1] += __builtin_amdgcn_cvt_pk_f32_fp8((int)u.x, true) * aa;
  o[2] += __builtin_amdgcn_cvt_pk_f32_fp8((int)u.y, false) * aa;
  o[3] += __builtin_amdgcn_cvt_pk_f32_fp8((int)u.y, true) * aa;
  o[4] += __builtin_amdgcn_cvt_pk_f32_fp8((int)u.z, false) * aa;
  o[5] += __builtin_amdgcn_cvt_pk_f32_fp8((int)u.z, true) * aa;
  o[6] += __builtin_amdgcn_cvt_pk_f32_fp8((int)u.w, false) * aa;
  o[7] += __builtin_amdgcn_cvt_pk_f32_fp8((int)u.w, true) * aa;
}
constexpr size_t OFF_ACT = OFF_B + 128 * MBY;
__device__ __forceinline__ void phase_gatherU(const Params& p) {
  const int tidx_ = opaque_tid();
  const int lane = tidx_ & 63;
  const int gw = (blockIdx.x * 256 + tidx_) >> 6, nw = gridDim.x * 4;
  const bf16_t* H = (const bf16_t*)(p.ws + OFF_H);
  const unsigned char* UT = (const unsigned char*)(p.ws + OFF_UT);
  const int* IDX = (const int*)(p.ws + OFF_IDX);
  const float* GW = (const float*)(p.ws + OFF_GW);
  float* ACT = (float*)(p.ws + OFF_ACT);
  const bool b5 = (lane & 32) != 0, b4 = (lane & 16) != 0, b3 = (lane & 8) != 0;
  uint4 nh0 = make_uint4(0u, 0u, 0u, 0u), nh1 = nh0; int nid0 = 0, nid1 = 0; float ng0 = 0.f, ng1 = 0.f;
  if (gw < T_TOK) {
    nh0 = *(const uint4*)(H + (size_t)gw * 1024 + lane * 16);
    nh1 = *(const uint4*)(H + (size_t)gw * 1024 + lane * 16 + 8);
    nid0 = IDX[(size_t)gw * 128 + lane]; nid1 = IDX[(size_t)gw * 128 + 64 + lane];
    ng0 = GW[(size_t)gw * 128 + lane]; ng1 = GW[(size_t)gw * 128 + 64 + lane];
  }
  for (int t = gw; t < T_TOK; t += nw) {
    const uint4 h0 = nh0, h1 = nh1;
    const int id0 = nid0, id1 = nid1;
    const float g0 = ng0, g1 = ng1;
    {
      const int tn = t + nw;
      if (tn < T_TOK) {
        nh0 = *(const uint4*)(H + (size_t)tn * 1024 + lane * 16);
        nh1 = *(const uint4*)(H + (size_t)tn * 1024 + lane * 16 + 8);
        nid0 = IDX[(size_t)tn * 128 + lane]; nid1 = IDX[(size_t)tn * 128 + 64 + lane];
        ng0 = GW[(size_t)tn * 128 + lane]; ng1 = GW[(size_t)tn * 128 + 64 + lane];
      }
    }
    f32x2 hf[8];
    {
      hf[0] = f32x2{lo2f(h0.x), hi2f(h0.x)}; hf[1] = f32x2{lo2f(h0.y), hi2f(h0.y)};
      hf[2] = f32x2{lo2f(h0.z), hi2f(h0.z)}; hf[3] = f32x2{lo2f(h0.w), hi2f(h0.w)};
      hf[4] = f32x2{lo2f(h1.x), hi2f(h1.x)}; hf[5] = f32x2{lo2f(h1.y), hi2f(h1.y)};
      hf[6] = f32x2{lo2f(h1.z), hi2f(h1.z)}; hf[7] = f32x2{lo2f(h1.w), hi2f(h1.w)};
    }
    float act0 = 0.f, act1 = 0.f;
    for (int half = 0; half < 2; half++) {
      const int idv = half ? id1 : id0;
      const float gv = half ? g1 : g0;
      float acth = 0.f;
#pragma unroll
      for (int gq = 0; gq < 8; gq += 2) {
        uint4 ua[16];
#pragma unroll
        for (int e = 0; e < 16; e++) {
          const int ex = __builtin_amdgcn_readlane(idv, gq * 8 + e);
          ua[e] = *(const uint4*)(UT + (size_t)ex * 1024 + lane * 16);
        }
#pragma unroll
        for (int g2 = 0; g2 < 2; g2++) {
          float d[8];
#pragma unroll
          for (int e = 0; e < 8; e++) d[e] = dot16_fp8(ua[g2 * 8 + e], hf);
          float e4[4], e2[2], e1;
#pragma unroll
          for (int i = 0; i < 4; i++) {
            const float snd = b5 ? d[i] : d[i + 4];
            const float kp = b5 ? d[i + 4] : d[i];
            e4[i] = kp + __shfl_xor(snd, 32);
          }
#pragma unroll
          for (int i = 0; i < 2; i++) {
            const float snd = b4 ? e4[i] : e4[i + 2];
            const float kp = b4 ? e4[i + 2] : e4[i];
            e2[i] = kp + __shfl_xor(snd, 16);
          }
          {
            const float snd = b3 ? e2[0] : e2[1];
            const float kp = b3 ? e2[1] : e2[0];
            e1 = kp + __shfl_xor(snd, 8);
          }
          e1 += __shfl_xor(e1, 4);
          e1 += __shfl_xor(e1, 2);
          e1 += __shfl_xor(e1, 1);
          const int grp = gq + g2;
          const float gE = __shfl(gv, grp * 8 + (lane >> 3));
          const float mine = gelu_t(e1 * (1.f / U_SCALE)) * gE * (1.f / V_SCALE);
          const float got = __shfl(mine, (lane & 7) * 8);
          acth = ((lane >> 3) == grp) ? got : acth;
        }
      }
      if (half) act1 = acth; else act0 = acth;
    }
    ACT[(size_t)t * 128 + lane] = act0;
    ACT[(size_t)t * 128 + 64 + lane] = act1;
  }
}

__device__ __forceinline__ void phase_gatherV(const Params& p, int layer) {
  const int tidx_ = opaque_tid();
  const int lane = tidx_ & 63;
  const int gw = (blockIdx.x * 256 + tidx_) >> 6, nw = gridDim.x * 4;
  const unsigned char* VT = (const unsigned char*)(p.ws + OFF_VTAB);
  const int* IDX = (const int*)(p.ws + OFF_IDX);
  const float* ACT = (const float*)(p.ws + OFF_ACT);
  const float* mod = (const float*)(p.ws + OFF_MOD);
  int nid0 = 0, nid1 = 0; float na0 = 0.f, na1 = 0.f;
  if (gw < T_TOK) {
    nid0 = IDX[(size_t)gw * 128 + lane]; nid1 = IDX[(size_t)gw * 128 + 64 + lane];
    na0 = ACT[(size_t)gw * 128 + lane]; na1 = ACT[(size_t)gw * 128 + 64 + lane];
  }
  for (int t = gw; t < T_TOK; t += nw) {
    const int id0 = nid0, id1 = nid1;
    const float a0 = na0, a1 = na1;
    {
      const int tn = t + nw;
      if (tn < T_TOK) {
        nid0 = IDX[(size_t)tn * 128 + lane]; nid1 = IDX[(size_t)tn * 128 + 64 + lane];
        na0 = ACT[(size_t)tn * 128 + lane]; na1 = ACT[(size_t)tn * 128 + 64 + lane];
      }
    }
    f32x2 o[8];
#pragma unroll
    for (int j = 0; j < 8; j++) o[j] = f32x2{0.f, 0.f};
    for (int half = 0; half < 2; half++) {
      const int idv = half ? id1 : id0;
      const int av = __float_as_int(half ? a1 : a0);
#pragma unroll
      for (int gq = 0; gq < 8; gq += 2) {
        uint4 va[16];
#pragma unroll
        for (int e = 0; e < 16; e++) {
          const int ex = __builtin_amdgcn_readlane(idv, gq * 8 + e);
          va[e] = *(const uint4*)(VT + (size_t)ex * 1024 + lane * 16);
        }
#pragma unroll
        for (int e = 0; e < 16; e++) {
          const float ae = __int_as_float(__builtin_amdgcn_readlane(av, gq * 8 + e));
          fma16_fp8(o, va[e], ae);
        }
      }
    }
    SeqInfo si = seq_of(t);
    const float* g2p = mod + (layer * 10 + si.b) * 6144 + 5 * 1024 + lane * 16;
    float* orow = p.out + (size_t)t * 1024 + lane * 16;
    float4 xn[4];
    float ssx = 0.f;
#pragma unroll
    for (int j = 0; j < 4; j++) {
      float4 xv = *(float4*)(orow + j * 4);
      float4 gg = *(const float4*)(g2p + j * 4);
      xv.x += gg.x * o[2 * j].x; xv.y += gg.y * o[2 * j].y;
      xv.z += gg.z * o[2 * j + 1].x; xv.w += gg.w * o[2 * j + 1].y;
      *(float4*)(orow + j * 4) = xv;
      xn[j] = xv;
      ssx += xv.x * xv.x + xv.y * xv.y + xv.z * xv.z + xv.w * xv.w;
    }
    if (layer == 0) {
      ssx = wave_sum(ssx);
      const float rstd = rsqrtf(ssx * (1.f / 1024.f) + EPSN);
      const float* gn = p.in[6] + 1024 + lane * 16;
      const float* md = mod + (1 * 10 + si.b) * 6144 + lane * 16;
      unsigned pk[8];
#pragma unroll
      for (int j = 0; j < 4; j++) {
        float4 gg = *(const float4*)(gn + j * 4);
        float4 sh = *(const float4*)(md + j * 4);
        float4 sc = *(const float4*)(md + 1024 + j * 4);
        const float y0 = xn[j].x * rstd * gg.x * (1.f + sc.x) + sh.x;
        const float y1 = xn[j].y * rstd * gg.y * (1.f + sc.y) + sh.y;
        const float y2 = xn[j].z * rstd * gg.z * (1.f + sc.z) + sh.z;
        const float y3 = xn[j].w * rstd * gg.w * (1.f + sc.w) + sh.w;
        pk[2 * j] = pack2(y0, y1); pk[2 * j + 1] = pack2(y2, y3);
      }
      bf16_t* hw = (bf16_t*)(p.ws + OFF_H) + (size_t)t * 1024 + lane * 16;
      *(uint4*)(hw) = make_uint4(pk[0], pk[1], pk[2], pk[3]);
      *(uint4*)(hw + 8) = make_uint4(pk[4], pk[5], pk[6], pk[7]);
    }
  }
}

__device__ __forceinline__ void phase_g8(const Params& p, bf16_t* sm) {
  const int tidx_ = opaque_tid();
  const int lane = tidx_ & 63, wave = tidx_ >> 6, wm = wave >> 1, wn = wave & 1;
  const bf16_t* H = (const bf16_t*)(p.ws + OFF_H);
  const bf16_t* W = (const bf16_t*)(p.ws + OFF_WCIN);
  bf16_t* BG = (bf16_t*)(p.ws + OFF_R1);
  bf16_t* U1 = (bf16_t*)(p.ws + OFF_R1 + 128 * MBY);
  XCD_TILE_LOOP(24, mt, nt) {
    f32x16 acc[2][2];
    gemm_tile(H + (size_t)mt * 128 * 1024, 1024, W + (size_t)nt * 128 * 1024, 1024, 1024, acc, sm);
    if (nt < 8) {
#pragma unroll
      for (int mi = 0; mi < 2; mi++)
#pragma unroll
        for (int ni = 0; ni < 2; ni++)
#pragma unroll
          for (int r = 0; r < 16; r++)
            sm[EPI_ROW(wm, mi, r, lane) * CS_LD + EPI_COL(wn, ni, lane)] = f2bf(acc[mi][ni][r]);
      __syncthreads();
      tile_copy_out(sm, BG + (size_t)mt * 128 * 1024 + nt * 128, 1024, 4);
    } else {
#pragma unroll
      for (int mi = 0; mi < 2; mi++)
#pragma unroll
        for (int r = 0; r < 16; r++)
          sm[EPI_ROW(wm, mi, r, lane) * CS_LD + wn * 32 + (lane & 31)] = f2bf(acc[mi][0][r] * acc[mi][1][r]);
      __syncthreads();
      tile_copy_out(sm, U1 + (size_t)mt * 128 * 1024 + (nt - 8) * 64, 1024, 3);
    }
    __syncthreads();
  }
}

__device__ __forceinline__ void phase_conv1(const Params& p) {
  const int tidx_ = opaque_tid();
  const int gtid = blockIdx.x * 256 + tidx_, gsz = gridDim.x * 256;
  const bf16_t* BG = (const bf16_t*)(p.ws + OFF_R1);
  const bf16_t* U1 = (const bf16_t*)(p.ws + OFF_R1 + 128 * MBY);
  bf16_t* Y = (bf16_t*)(p.ws + OFF_H);
  const float* cw = p.in[24];
  for (int mt_ = blockIdx.x; mt_ < 512; mt_ += gridDim.x)
  for (int j_ = tidx_; j_ < 16384; j_ += 256) {
    const int t = mt_ * 128 + (j_ >> 7), c = (j_ & 127) * 8;
    SeqInfo si = seq_of(t);
    float acc[8];
#pragma unroll
    for (int j = 0; j < 8; j++) acc[j] = 0.f;
#pragma unroll
    for (int k = 0; k < 3; k++) {
      const int tt = t + k - 1;
      if (tt >= si.s0 && tt < si.s0 + si.S) {
        uint4 v = *(const uint4*)(U1 + (size_t)tt * 1024 + c);
        const float* w = cw + k * 1024 + c;
        acc[0] += w[0] * lo2f(v.x); acc[1] += w[1] * hi2f(v.x);
        acc[2] += w[2] * lo2f(v.y); acc[3] += w[3] * hi2f(v.y);
        acc[4] += w[4] * lo2f(v.z); acc[5] += w[5] * hi2f(v.z);
        acc[6] += w[6] * lo2f(v.w); acc[7] += w[7] * hi2f(v.w);
      }
    }
    uint4 b = *(const uint4*)(BG + (size_t)t * 1024 + c);
    float bf[8]; unpack8(b, bf);
#pragma unroll
    for (int j = 0; j < 8; j++) acc[j] *= bf[j];
    *(uint4*)(Y + (size_t)t * 1024 + c) = pack8(acc);
  }
}

__device__ __forceinline__ void gbar_sync(unsigned* bar, unsigned& gen) {
  __syncthreads();
  gen++;
  if (threadIdx.x == 0) {
    __builtin_amdgcn_fence(__ATOMIC_RELEASE, "agent");
    const unsigned G = gridDim.x, b = blockIdx.x, x = b & 7u, y = (b >> 3) & 7u;
    const unsigned nA = (G - (x + 8u * y) + 63u) / 64u;
    const unsigned nBf = (G - x + 7u) / 8u, nB = nBf < 8u ? nBf : 8u;
    const unsigned nR = G < 8u ? G : 8u;
    unsigned* cA = bar + (x * 8u + y) * 16u;
    unsigned* cB = bar + 1024u + x * 16u;
    unsigned* cR = bar + 1024u + 128u;
    unsigned* fl = bar + 1024u + 256u;
    if (atomicAdd(cA, 1u) == nA - 1u) {
      atomicExch(cA, 0u);
      if (atomicAdd(cB, 1u) == nB - 1u) {
        atomicExch(cB, 0u);
        if (atomicAdd(cR, 1u) == nR - 1u) {
          atomicExch(cR, 0u);
          __builtin_amdgcn_fence(__ATOMIC_RELEASE, "agent");
#pragma unroll
          for (int i = 0; i < 8; i++) __hip_atomic_store(fl + i * 16, gen, __ATOMIC_RELAXED, __HIP_MEMORY_SCOPE_AGENT);
        }
      }
    }
    unsigned spins = 0;
    while (__hip_atomic_load(fl + x * 16u, __ATOMIC_RELAXED, __HIP_MEMORY_SCOPE_AGENT) < gen) {
      __builtin_amdgcn_s_sleep(2);
      if (++spins > (1u << 18)) break;
    }
    __builtin_amdgcn_fence(__ATOMIC_ACQUIRE, "agent");
  }
  __syncthreads();
}

#ifndef PROBE_MASK
#define PROBE_MASK 0
#endif
#ifndef PROBE_K
#define PROBE_K 1
#endif
#if PROBE_MASK
#define STAMP(k) do { if (blockIdx.x == 0 && threadIdx.x == 0) ((volatile unsigned long long*)(ws + OFF_CNT + 1024))[k] = wall_clock64(); } while (0)
#else
#define STAMP(k) do { } while (0)
#endif
__global__ void __launch_bounds__(256, 2) mega_fwd(Params p) {
  extern __shared__ __attribute__((aligned(16))) unsigned char smem[];
  cg::grid_group grid = cg::this_grid();
  bf16_t* sm = (bf16_t*)smem;
  unsigned char* ws = p.ws;
  unsigned* bar_ = (unsigned*)(ws + OFF_BAR);
  unsigned bgen_ = 0;

  STAMP(0);
  phase_prep(p, smem);
  grid.sync(); STAMP(1);
  phase_norm(p, 0, 1, true);
  gbar_sync(bar_, bgen_); STAMP(2);
  phase_g1(p, sm);
  gbar_sync(bar_, bgen_); STAMP(3);
  phase_conv0(p);
  gbar_sync(bar_, bgen_); STAMP(4);
  phase_g234(p, sm);
  gbar_sync(bar_, bgen_); STAMP(5);
  phase_qkprep_scan1(p);
  gbar_sync(bar_, bgen_); STAMP(6); STAMP(7);
  phase_attn_scan3(p, sm);
  gbar_sync(bar_, bgen_); STAMP(8);
  phase_gres_norm(p, (const bf16_t*)(ws + OFF_R1), (const bf16_t*)(ws + OFF_WOUT), 0, true, sm);
  STAMP(9);
  __syncthreads();
  STAMP(10); STAMP(11);
  phase_topk(p, 0, sm);
  gbar_sync(bar_, bgen_); STAMP(12);
  phase_gatherU(p);
  gbar_sync(bar_, bgen_);
  phase_gatherV(p, 0);
  gbar_sync(bar_, bgen_); STAMP(13);
  STAMP(14);
  phase_g8(p, sm);
  gbar_sync(bar_, bgen_); STAMP(15);
  phase_conv1(p);
  __syncthreads(); STAMP(16);
  phase_gres_norm(p, (const bf16_t*)(ws + OFF_H), (const bf16_t*)(ws + OFF_WCOUT), 1, false, sm);
  STAMP(17);
  __syncthreads();
  STAMP(18); STAMP(19);
  phase_topk(p, 1, sm);
  gbar_sync(bar_, bgen_); STAMP(20);
  phase_gatherU(p);
  gbar_sync(bar_, bgen_);
  phase_gatherV(p, 1);
#if PROBE_MASK
  gbar_sync(bar_, bgen_); STAMP(21);
  __threadfence();
  gbar_sync(bar_, bgen_);
  {
    const volatile unsigned long long* ts = (const volatile unsigned long long*)(ws + OFF_CNT + 1024);
    unsigned long long tot = 0;
    for (int k = 0; k < 21; k++) if ((PROBE_MASK >> k) & 1) tot += ts[k + 1] - ts[k];
    tot *= PROBE_K;
    const unsigned long long t0 = wall_clock64();
    while (wall_clock64() - t0 < tot) { }
  }
#endif
}

extern "C" void kernel_launch(void* const* d_in, const int* in_sizes, int n_in, void* d_out, int out_size, void* d_ws,
                              size_t ws_size, hipStream_t stream) {
  static int grid_blocks = 0;
  if (grid_blocks == 0) {
    if (n_in != 31 || ws_size < WS_NEED) {
      fprintf(stderr, "kernel_launch: unexpected n_in %d or ws_size %zu (< %zu)\n", n_in, ws_size, (size_t)WS_NEED);
      grid_blocks = -1;
      return;
    }
    int dev = 0, cus = 0, per_cu = 0;
    hipGetDevice(&dev);
    hipDeviceGetAttribute(&cus, hipDeviceAttributeMultiprocessorCount, dev);
    if (hipFuncSetAttribute((const void*)mega_fwd, hipFuncAttributeMaxDynamicSharedMemorySize, LDS_BYTES) != hipSuccess) {
      fprintf(stderr, "kernel_launch: hipFuncSetAttribute failed\n");
      grid_blocks = -1;
      return;
    }
    hipOccupancyMaxActiveBlocksPerMultiprocessor(&per_cu, (const void*)mega_fwd, 256, LDS_BYTES);
    if (per_cu < 1) per_cu = 1;
    if (per_cu > 2) per_cu = 2;
    grid_blocks = cus * per_cu;
    fprintf(stderr, "kernel_launch: cus %d per_cu %d grid %d ws %zu\n", cus, per_cu, grid_blocks, ws_size);
  }
  if (grid_blocks < 0) return;
  Params p{};
  for (int i = 0; i < 31; i++) p.in[i] = (const float*)d_in[i];
  p.out = (float*)d_out;
  p.ws = (unsigned char*)d_ws;
  void* args[] = {&p};
  hipError_t e = hipLaunchCooperativeKernel((const void*)mega_fwd, dim3(grid_blocks), dim3(256), args, LDS_BYTES, stream);
  if (e != hipSuccess) fprintf(stderr, "cooperative launch failed: %s (grid %d)\n", hipGetErrorString(e), grid_blocks);
}
```

```cpp
#include <hip/hip_runtime.h>
#include <hip/hip_cooperative_groups.h>
#include <cstdio>
#include <cstdint>
namespace cg = cooperative_groups;

typedef unsigned short bf16_t;
using bf16x8 = __attribute__((ext_vector_type(8))) short;
using bf16x4 = __attribute__((ext_vector_type(4))) short;
using f32x16 = __attribute__((ext_vector_type(16))) float;

#define T_TOK 65536
#define EPSN 1e-6f

struct Params {
  const float* in[31];
  float* out;
  unsigned char* ws;
};

constexpr size_t MBY = (size_t)1 << 20;
constexpr size_t OFF_WIN = 0;
constexpr size_t OFF_WUQ = OFF_WIN + (size_t)1536 * 1024 * 2;
constexpr size_t OFF_WUKV = OFF_WUQ + (size_t)768 * 256 * 2;
constexpr size_t OFF_WGATE = OFF_WUKV + (size_t)1024 * 128 * 2;
constexpr size_t OFF_WOUT = OFF_WGATE + (size_t)16 * 128 * 64 * 2;
constexpr size_t OFF_WCIN = OFF_WOUT + (size_t)1024 * 1024 * 2;
constexpr size_t OFF_WCOUT = OFF_WCIN + (size_t)3072 * 1024 * 2;
constexpr size_t OFF_WPQ = OFF_WCOUT + (size_t)1024 * 1024 * 2;
constexpr size_t OFF_KEYS = OFF_WPQ + (size_t)2 * 2048 * 1024 * 2;
constexpr size_t OFF_MOD = OFF_KEYS + (size_t)4 * 128 * 128 * 2;
constexpr size_t OFF_C8 = OFF_MOD + (size_t)2 * 10 * 6144 * 4;
constexpr size_t OFF_RSTDQ = OFF_C8 + 4096;
constexpr size_t OFF_RSTDKV = OFF_RSTDQ + (size_t)T_TOK * 4;
constexpr size_t OFF_AGGA = OFF_RSTDKV + (size_t)T_TOK * 4;
constexpr size_t OFF_AGGB = OFF_AGGA + 2 * MBY;
constexpr size_t OFF_CARRY = OFF_AGGB + 2 * MBY;
constexpr size_t OFF_CNT = OFF_CARRY + 2 * MBY;
constexpr size_t OFF_BAR = OFF_CNT + 8192;
static_assert(OFF_BAR + 8192 < 40 * MBY, "small region overflow");
constexpr size_t OFF_H = 40 * MBY;
constexpr size_t OFF_R1 = 168 * MBY;
constexpr size_t OFF_Z2 = OFF_R1 + 128 * MBY;
constexpr size_t OFF_XC = OFF_R1 + 180 * MBY;
constexpr size_t OFF_B = 424 * MBY;
constexpr size_t OFF_VT = OFF_B + 96 * MBY;
constexpr size_t OFF_UT = OFF_B;
constexpr size_t OFF_VTAB = OFF_B + 32 * MBY;
constexpr size_t OFF_IDX = OFF_B + 64 * MBY;
constexpr size_t OFF_GW = OFF_B + 96 * MBY;
constexpr size_t WS_NEED = 584 * MBY;

#define LDS_BYTES 73728

__device__ __forceinline__ float bf2f(unsigned short h) { return __uint_as_float(((unsigned)h) << 16); }
__device__ __forceinline__ unsigned short f2bf(float f) {
  unsigned u = __float_as_uint(f);
  u += 0x7fffu + ((u >> 16) & 1u);
  return (unsigned short)(u >> 16);
}
typedef __bf16 hwbf16x2 __attribute__((ext_vector_type(2)));
typedef float f32x2 __attribute__((ext_vector_type(2)));
__device__ __forceinline__ unsigned pack2(float a, float b) {
  f32x2 v = {a, b};
  hwbf16x2 r = __builtin_convertvector(v, hwbf16x2);
  return *(unsigned*)&r;
}
__device__ __forceinline__ float lo2f(unsigned u) { return __uint_as_float(u << 16); }
__device__ __forceinline__ float hi2f(unsigned u) { return __uint_as_float(u & 0xffff0000u); }
__device__ __forceinline__ float fexp2(float x) { return __builtin_amdgcn_exp2f(x); }
__device__ __forceinline__ float frcp(float x) { return __builtin_amdgcn_rcpf(x); }
__device__ __forceinline__ float gelu_t(float x) {
  float u = 0.7978845608f * (x + 0.044715f * x * x * x);
  float t = 1.f - 2.f * frcp(1.f + fexp2(u * 2.8853900817779268f));
  return 0.5f * x * (1.f + t);
}
__device__ __forceinline__ float sigmoid_f(float x) { return frcp(1.f + fexp2(-1.4426950408889634f * x)); }
__device__ __forceinline__ float wave_sum(float v) {
#pragma unroll
  for (int o = 32; o > 0; o >>= 1) v += __shfl_xor(v, o);
  return v;
}
__device__ __forceinline__ int opaque_tid() { int t = threadIdx.x; asm volatile("" : "+v"(t)); return t; }
struct SeqInfo { int b, s0, S; };
__device__ __forceinline__ SeqInfo seq_of(int t) {
  SeqInfo r;
  if (t < 32768) { r.b = t >> 14; r.s0 = r.b << 14; r.S = 16384; }
  else { int u = (t - 32768) >> 12; r.b = 2 + u; r.s0 = 32768 + (u << 12); r.S = 4096; }
  return r;
}
__device__ __forceinline__ const float* xin_row(const Params& p, int t) {
  return t < 32768 ? p.in[0] + (size_t)t * 1024 : p.in[1] + (size_t)(t - 32768) * 1024;
}

#define GT_BUF 16384
__device__ __forceinline__ void gemm_tile(const bf16_t* __restrict__ A, int lda, const bf16_t* __restrict__ B, int ldb,
                                          int K, f32x16 (&acc)[2][2], bf16_t* sm) {
  const int tidx_ = opaque_tid();
  const int tid = tidx_, lane = tid & 63, wave = tid >> 6, wm = wave >> 1, wn = wave & 1;
  const int nk = K >> 6;
  const bf16_t* src = wave < 2 ? A : B;
  const unsigned ld = (unsigned)(wave < 2 ? lda : ldb);
  const int i0 = (wave & 1) * 8;
  char* dbase = (char*)sm + (wave >> 1) * 16384 + i0 * 1024 + lane * 16;
#define GOFF(j_) ({ const unsigned s_ = (unsigned)((i0 + (j_)) * 64 + lane); const unsigned r_ = s_ >> 3; const unsigned c_ = (s_ & 7u) ^ ((r_ >> 1) & 7u); r_ * ld + c_ * 8u; })
  const unsigned g0 = GOFF(0), g1 = GOFF(1), g2 = GOFF(2), g3 = GOFF(3), g4 = GOFF(4), g5 = GOFF(5), g6 = GOFF(6), g7 = GOFF(7);
#undef GOFF
#define DMA1(gj_, j_, sp_, db_) __builtin_amdgcn_global_load_lds((const unsigned*)((sp_) + (gj_)), (unsigned __attribute__((address_space(3)))*)((db_) + (j_) * 1024), 16, 0, 0)
#define DMA_TILE(kt_, buf_)                                                       \
  {                                                                               \
    const bf16_t* sp_ = src + (kt_) * 64;                                         \
    char* db_ = dbase + (buf_) * (GT_BUF * 2);                                    \
    DMA1(g0, 0, sp_, db_); DMA1(g1, 1, sp_, db_); DMA1(g2, 2, sp_, db_);          \
    DMA1(g3, 3, sp_, db_); DMA1(g4, 4, sp_, db_); DMA1(g5, 5, sp_, db_);          \
    DMA1(g6, 6, sp_, db_); DMA1(g7, 7, sp_, db_);                                 \
  }
  DMA_TILE(0, 0);
#pragma unroll
  for (int mi = 0; mi < 2; mi++)
#pragma unroll
    for (int ni = 0; ni < 2; ni++)
#pragma unroll
      for (int r = 0; r < 16; r++) acc[mi][ni][r] = 0.f;
  asm volatile("s_waitcnt vmcnt(0)" ::: "memory");
  __syncthreads();
  const int sw = ((lane & 31) >> 1) & 7, hh = lane >> 5;
  const int arow = (wm * 64 + (lane & 31)) * 64;
  const int brow = 8192 + (wn * 64 + (lane & 31)) * 64;
  for (int kt = 0; kt < nk; ++kt) {
    if (kt + 1 < nk) DMA_TILE(kt + 1, (kt + 1) & 1);
    const bf16_t* cA = sm + (kt & 1) * GT_BUF;
#pragma unroll
    for (int kk = 0; kk < 4; ++kk) {
      const int pc = ((kk * 2 + hh) ^ sw) * 8;
      bf16x8 a[2], b[2];
#pragma unroll
      for (int mi = 0; mi < 2; mi++) a[mi] = *(const bf16x8*)(cA + arow + mi * 32 * 64 + pc);
#pragma unroll
      for (int ni = 0; ni < 2; ni++) b[ni] = *(const bf16x8*)(cA + brow + ni * 32 * 64 + pc);
#pragma unroll
      for (int mi = 0; mi < 2; mi++)
#pragma unroll
        for (int ni = 0; ni < 2; ni++)
          acc[mi][ni] = __builtin_amdgcn_mfma_f32_32x32x16_bf16(a[mi], b[ni], acc[mi][ni], 0, 0, 0);
    }
    asm volatile("s_waitcnt vmcnt(0)" ::: "memory");
    __syncthreads();
  }
#undef DMA1
#undef DMA_TILE
}

#define CS_LD 136
__device__ __forceinline__ void gemm_ldsA_k128(const bf16_t* __restrict__ B, f32x16 (&acc)[2][2], bf16_t* sm) {
  const int tidx_ = opaque_tid();
  const int tid = tidx_, lane = tid & 63, wave = tid >> 6, wm = wave >> 1, wn = wave & 1;
  const int lr = tid >> 3, lc = (tid & 7) * 8;
  const bf16_t* Bp = B + (size_t)lr * 128 + lc;
  bf16_t* sB = sm + 128 * CS_LD;
  uint4 b0 = *(const uint4*)(Bp), b1 = *(const uint4*)(Bp + 32 * 128), b2 = *(const uint4*)(Bp + 64 * 128), b3 = *(const uint4*)(Bp + 96 * 128);
  uint4 c0 = *(const uint4*)(Bp + 64), c1 = *(const uint4*)(Bp + 32 * 128 + 64), c2 = *(const uint4*)(Bp + 64 * 128 + 64), c3 = *(const uint4*)(Bp + 96 * 128 + 64);
  const int so = lr * 72 + lc;
  *(uint4*)(sB + so) = b0; *(uint4*)(sB + so + 32 * 72) = b1; *(uint4*)(sB + so + 64 * 72) = b2; *(uint4*)(sB + so + 96 * 72) = b3;
  *(uint4*)(sB + 128 * 72 + so) = c0; *(uint4*)(sB + 128 * 72 + so + 32 * 72) = c1;
  *(uint4*)(sB + 128 * 72 + so + 64 * 72) = c2; *(uint4*)(sB + 128 * 72 + so + 96 * 72) = c3;
#pragma unroll
  for (int mi = 0; mi < 2; mi++)
#pragma unroll
    for (int ni = 0; ni < 2; ni++)
#pragma unroll
      for (int r = 0; r < 16; r++) acc[mi][ni][r] = 0.f;
  __syncthreads();
  const int aoff = (wm * 64 + (lane & 31)) * CS_LD + (lane >> 5) * 8;
  const int boff = (wn * 64 + (lane & 31)) * 72 + (lane >> 5) * 8;
#pragma unroll
  for (int kt = 0; kt < 2; kt++)
#pragma unroll
    for (int kk = 0; kk < 4; ++kk) {
      bf16x8 a[2], b[2];
#pragma unroll
      for (int mi = 0; mi < 2; mi++) a[mi] = *(const bf16x8*)(sm + aoff + mi * 32 * CS_LD + kt * 64 + kk * 16);
#pragma unroll
      for (int ni = 0; ni < 2; ni++) b[ni] = *(const bf16x8*)(sB + kt * 128 * 72 + boff + ni * 32 * 72 + kk * 16);
#pragma unroll
      for (int mi = 0; mi < 2; mi++)
#pragma unroll
        for (int ni = 0; ni < 2; ni++)
          acc[mi][ni] = __builtin_amdgcn_mfma_f32_32x32x16_bf16(a[mi], b[ni], acc[mi][ni], 0, 0, 0);
    }
  __syncthreads();
}

#define EPI_ROW(wm, mi, r, lane) ((wm) * 64 + (mi) * 32 + 8 * ((r) >> 2) + 4 * ((lane) >> 5) + ((r) & 3))
#define EPI_COL(wn, ni, lane) ((wn) * 64 + (ni) * 32 + ((lane) & 31))

template <class F>
__device__ __forceinline__ void tconv(bf16_t* dst, int N, int K, F src, float* tile, int& rot) {
  const int tidx_ = opaque_tid();
  const int tn = N >> 6, tk = K >> 6;
  int first = (int)blockIdx.x - rot; if (first < 0) first += gridDim.x;
  rot = (rot + tn * tk) % (int)gridDim.x;
  for (int it = first; it < tn * tk; it += gridDim.x) {
    const int n0 = (it % tn) << 6, k0 = (it / tn) << 6;
    for (int i = tidx_; i < 4096; i += 256) { int kk = i >> 6, nn = i & 63; tile[kk * 65 + nn] = src(k0 + kk, n0 + nn); }
    __syncthreads();
    for (int i = tidx_; i < 4096; i += 256) { int nn = i >> 6, kk = i & 63; dst[(size_t)(n0 + nn) * K + k0 + kk] = f2bf(tile[kk * 65 + nn]); }
    __syncthreads();
  }
}

__device__ __forceinline__ void phase_prep(const Params& p, unsigned char* smem) {
  const int tidx_ = opaque_tid();
  unsigned char* ws = p.ws;
  float* tile = (float*)smem;
  int rot = 0;
  const int tid = tidx_;
  const int gtid = blockIdx.x * 256 + tid, gsz = gridDim.x * 256;
  {
    const float* w_in = p.in[8];
    tconv((bf16_t*)(ws + OFF_WIN), 1536, 1024, [=](int k, int n) { return n < 1440 ? w_in[(size_t)k * 1440 + n] : 0.f; }, tile, rot);
    const float* w_uq = p.in[17]; const float* qn = p.in[16];
    tconv((bf16_t*)(ws + OFF_WUQ), 768, 256, [=](int k, int n) { return w_uq[k * 768 + n] * qn[k]; }, tile, rot);
    const float* w_ukv = p.in[19]; const float* kvn = p.in[18];
    tconv((bf16_t*)(ws + OFF_WUKV), 1024, 128, [=](int k, int n) { return w_ukv[k * 1024 + n] * kvn[k]; }, tile, rot);
    const float* wa = p.in[11]; const float* wx = p.in[13];
    for (int hd = 0; hd < 16; ++hd) {
      const int h = hd >> 1, d = hd & 1;
      tconv((bf16_t*)(ws + OFF_WGATE) + hd * 128 * 64, 128, 64, [=](int k, int n) {
        int wn = n >> 6, ty = (n >> 5) & 1, j = n & 31; int c = wn * 32 + j;
        const float* W = ty ? wx : wa;
        return W[((d * 8 + h) * 64 + k) * 64 + c]; }, tile, rot);
    }
    const float* w_out = p.in[22];
    tconv((bf16_t*)(ws + OFF_WOUT), 1024, 1024, [=](int k, int n) { return w_out[((k + 512) & 1023) * 1024 + n]; }, tile, rot);
    const float* c_w_in = p.in[23];
    tconv((bf16_t*)(ws + OFF_WCIN), 3072, 1024, [=](int k, int n) {
      int col;
      if (n < 1024) col = n;
      else { int q = n - 1024; int tl = q >> 7, wi = q & 127; int wn = wi >> 6, ty = (wi >> 5) & 1, j = wi & 31; col = 1024 + ty * 1024 + tl * 64 + wn * 32 + j; }
      return c_w_in[(size_t)k * 3072 + col]; }, tile, rot);
    const float* c_w_out = p.in[25];
    tconv((bf16_t*)(ws + OFF_WCOUT), 1024, 1024, [=](int k, int n) { return c_w_out[k * 1024 + n]; }, tile, rot);
    const float* wq = p.in[26];
    for (int l = 0; l < 2; ++l)
      tconv((bf16_t*)(ws + OFF_WPQ) + (size_t)l * 2048 * 1024, 2048, 1024, [=](int k, int n) { return wq[((size_t)(l * 1024 + k)) * 2048 + n]; }, tile, rot);
  }
  {
    bf16_t* keys = (bf16_t*)(ws + OFF_KEYS);
    const float* k1 = p.in[27]; const float* k2 = p.in[28];
    for (int i = gtid; i < 65536; i += gsz) {
      int l = i >> 15, pp = (i >> 14) & 1, r = i & 16383;
      keys[i] = f2bf((pp ? k2 : k1)[l * 16384 + r]);
    }
    float* c8 = (float*)(ws + OFF_C8);
    const float* lam = p.in[15];
    for (int i = gtid; i < 1024; i += gsz) c8[i] = 8.f * log1pf(__expf(-lam[i])) * 1.44269504f;
    if (gtid < 16) ((int*)(ws + OFF_CNT))[gtid] = 0;
    for (int i = gtid; i < 2048; i += gsz) ((unsigned*)(ws + OFF_BAR))[i] = 0u;
  }
  {
    float* silu_s = (float*)smem;
    float* red = silu_s + 10240;
    float* mod = (float*)(ws + OFF_MOD);
    const float* cp = p.in[2]; const float* cs = p.in[3];
    const float* ada_w = p.in[4]; const float* ada_b = p.in[5];
    __syncthreads();
    for (int i = tid; i < 10240; i += 256) {
      int b = i >> 10, k = i & 1023;
      float c = b < 2 ? cp[b * 1024 + k] : cs[(b - 2) * 1024 + k];
      silu_s[i] = c / (1.f + __expf(-c));
    }
    __syncthreads();
    for (int it = blockIdx.x; it < 192; it += gridDim.x) {
      const int l = it / 96, n = (it % 96) * 64 + (tid & 63), kq = tid >> 6;
      float acc[10];
#pragma unroll
      for (int b = 0; b < 10; b++) acc[b] = 0.f;
#pragma unroll 8
      for (int k = kq * 256; k < kq * 256 + 256; ++k) {
        float w = ada_w[((size_t)(l * 1024 + k)) * 6144 + n];
#pragma unroll
        for (int b = 0; b < 10; b++) acc[b] += silu_s[b * 1024 + k] * w;
      }
#pragma unroll
      for (int b = 0; b < 10; b++) red[(kq * 10 + b) * 64 + (tid & 63)] = acc[b];
      __syncthreads();
      if (tid < 64) {
#pragma unroll
        for (int b = 0; b < 10; b++)
          mod[(l * 10 + b) * 6144 + n] = ada_b[l * 6144 + n] + red[(0 * 10 + b) * 64 + tid] + red[(1 * 10 + b) * 64 + tid] +
                                         red[(2 * 10 + b) * 64 + tid] + red[(3 * 10 + b) * 64 + tid];
      }
      __syncthreads();
    }
  }
}

#define U_SCALE 64.f
#define V_SCALE 8.f
__device__ __forceinline__ unsigned pack_fp8x4(float4 a, float sc) {
  int pk = __builtin_amdgcn_cvt_pk_fp8_f32(a.x * sc, a.y * sc, 0, false);
  pk = __builtin_amdgcn_cvt_pk_fp8_f32(a.z * sc, a.w * sc, pk, true);
  return (unsigned)pk;
}
__device__ __forceinline__ void phase_uvconv(const Params& p, int l, int part, int nparts) {
  const int tidx_ = opaque_tid();
  const int gtid = blockIdx.x * 256 + tidx_, gsz = gridDim.x * 256;
  const float4* us = (const float4*)(p.in[29] + (size_t)l * 16384 * 1024);
  const float4* vs = (const float4*)(p.in[30] + (size_t)l * 16384 * 1024);
  unsigned* ud = (unsigned*)(p.ws + OFF_UT);
  unsigned* vd = (unsigned*)(p.ws + OFF_VTAB);
  for (int i = gtid + part * gsz; i < 16384 * 256; i += gsz * nparts) {
    ud[i] = pack_fp8x4(us[i], U_SCALE);
    vd[i] = pack_fp8x4(vs[i], V_SCALE);
  }
}

__device__ __forceinline__ void phase_norm(const Params& p, int layer, int which, bool from_input) {
  const int tidx_ = opaque_tid();
  const int lane = tidx_ & 63;
  const int gw = (blockIdx.x * 256 + tidx_) >> 6, nw = gridDim.x * 4;
  const float* g = (which == 1 ? p.in[6] : p.in[7]) + layer * 1024;
  const float* mod = (const float*)(p.ws + OFF_MOD);
  bf16_t* H = (bf16_t*)(p.ws + OFF_H);
  for (int t = gw; t < T_TOK; t += nw) {
    SeqInfo si = seq_of(t);
    const float* x = from_input ? xin_row(p, t) : p.out + (size_t)t * 1024;
    const float* md = mod + (layer * 10 + si.b) * 6144 + (which == 1 ? 0 : 3 * 1024);
    float4 v[4];
    float ss = 0.f;
#pragma unroll
    for (int j = 0; j < 4; j++) {
      v[j] = *(const float4*)(x + j * 256 + lane * 4);
      ss += v[j].x * v[j].x + v[j].y * v[j].y + v[j].z * v[j].z + v[j].w * v[j].w;
    }
    ss = wave_sum(ss);
    const float rstd = rsqrtf(ss * (1.f / 1024.f) + EPSN);
#pragma unroll
    for (int j = 0; j < 4; j++) {
      const int idx = j * 256 + lane * 4;
      float4 gg = *(const float4*)(g + idx);
      float4 sh = *(const float4*)(md + idx);
      float4 sc = *(const float4*)(md + 1024 + idx);
      float y0 = v[j].x * rstd * gg.x * (1.f + sc.x) + sh.x;
      float y1 = v[j].y * rstd * gg.y * (1.f + sc.y) + sh.y;
      float y2 = v[j].z * rstd * gg.z * (1.f + sc.z) + sh.z;
      float y3 = v[j].w * rstd * gg.w * (1.f + sc.w) + sh.w;
      *(uint2*)(H + (size_t)t * 1024 + idx) = make_uint2(pack2(y0, y1), pack2(y2, y3));
    }
  }
}

#define XCD_TILE_LOOP(NT_, mt_, nt_)                                                               \
  for (int li_ = (int)(blockIdx.x >> 3), mt_ = 0, nt_ = 0;                                          \
       li_ < 64 * (NT_) && ((mt_ = (li_ / (NT_)) * 8 + (int)(blockIdx.x & 7)), (nt_ = li_ % (NT_)), true); \
       li_ += (int)(gridDim.x >> 3))

__device__ __forceinline__ void tile_copy_out(const bf16_t* cs, bf16_t* dst, size_t ldd, int nchunk_log2) {
  const int tidx_ = opaque_tid();
  const int per_row = 1 << nchunk_log2;
  const int total = 128 << nchunk_log2;
  for (int c = tidx_; c < total; c += 256) {
    const int row = c >> nchunk_log2, cc = c & (per_row - 1);
    const uint4 v = *(const uint4*)(cs + row * CS_LD + cc * 8);
    *(uint4*)(dst + (size_t)row * ldd + cc * 8) = v;
  }
}

__device__ __forceinline__ void phase_g1(const Params& p, bf16_t* sm) {
  const int tidx_ = opaque_tid();
  const int lane = tidx_ & 63, wave = tidx_ >> 6, wm = wave >> 1, wn = wave & 1;
  const bf16_t* H = (const bf16_t*)(p.ws + OFF_H);
  const bf16_t* W = (const bf16_t*)(p.ws + OFF_WIN);
  bf16_t* Z1 = (bf16_t*)(p.ws + OFF_R1);
  bf16_t* Z2 = (bf16_t*)(p.ws + OFF_Z2);
  XCD_TILE_LOOP(12, mt, nt) {
    f32x16 acc[2][2];
    gemm_tile(H + (size_t)mt * 128 * 1024, 1024, W + (size_t)nt * 128 * 1024, 1024, 1024, acc, sm);
#pragma unroll
    for (int mi = 0; mi < 2; mi++)
#pragma unroll
      for (int ni = 0; ni < 2; ni++)
#pragma unroll
        for (int r = 0; r < 16; r++)
          sm[EPI_ROW(wm, mi, r, lane) * CS_LD + EPI_COL(wn, ni, lane)] = f2bf(acc[mi][ni][r]);
    __syncthreads();
    if (nt < 8) tile_copy_out(sm, Z1 + (size_t)mt * 128 * 1024 + nt * 128, 1024, 4);
    else if (nt < 11) tile_copy_out(sm, Z2 + (size_t)mt * 128 * 416 + (nt - 8) * 128, 416, 4);
    else tile_copy_out(sm, Z2 + (size_t)mt * 128 * 416 + 384, 416, 2);
    __syncthreads();
  }
}

__device__ __forceinline__ void phase_conv0(const Params& p) {
  const int tidx_ = opaque_tid();
  const int gtid = blockIdx.x * 256 + tidx_, gsz = gridDim.x * 256;
  const bf16_t* Z1 = (const bf16_t*)(p.ws + OFF_R1);
  const bf16_t* Z2 = (const bf16_t*)(p.ws + OFF_Z2);
  bf16_t* XC = (bf16_t*)(p.ws + OFF_XC);
  const float* cw = p.in[9]; const float* cb = p.in[10];
  for (int i = gtid; i < T_TOK * 64; i += gsz) {
    const int t = i >> 6, c = (i & 63) * 8;
    SeqInfo si = seq_of(t);
    float acc[8];
#pragma unroll
    for (int j = 0; j < 8; j++) acc[j] = cb[c + j];
#pragma unroll
    for (int k = 0; k < 4; k++) {
      const int tt = t + k - 2;
      if (tt >= si.s0 && tt < si.s0 + si.S) {
        uint4 v = *(const uint4*)(Z1 + (size_t)tt * 1024 + c);
        const float* w = cw + k * 512 + c;
        acc[0] += w[0] * lo2f(v.x); acc[1] += w[1] * hi2f(v.x);
        acc[2] += w[2] * lo2f(v.y); acc[3] += w[3] * hi2f(v.y);
        acc[4] += w[4] * lo2f(v.z); acc[5] += w[5] * hi2f(v.z);
        acc[6] += w[6] * lo2f(v.w); acc[7] += w[7] * hi2f(v.w);
      }
    }
    *(uint4*)(XC + (size_t)t * 512 + c) = make_uint4(pack2(acc[0], acc[1]), pack2(acc[2], acc[3]), pack2(acc[4], acc[5]), pack2(acc[6], acc[7]));
  }
  const int lane = tidx_ & 63;
  const int gw = gtid >> 6, nw = gsz >> 6;
  float* rq = (float*)(p.ws + OFF_RSTDQ);
  float* rkv = (float*)(p.ws + OFF_RSTDKV);
  for (int t = gw; t < T_TOK; t += nw) {
    const bf16_t* z = Z2 + (size_t)t * 416;
    uint2 a = *(const uint2*)(z + lane * 4);
    unsigned b = *(const unsigned*)(z + 256 + lane * 2);
    float ssq = lo2f(a.x) * lo2f(a.x) + hi2f(a.x) * hi2f(a.x) + lo2f(a.y) * lo2f(a.y) + hi2f(a.y) * hi2f(a.y);
    float ssk = lo2f(b) * lo2f(b) + hi2f(b) * hi2f(b);
    ssq = wave_sum(ssq); ssk = wave_sum(ssk);
    if (lane == 0) { rq[t] = rsqrtf(ssq * (1.f / 256.f) + EPSN); rkv[t] = rsqrtf(ssk * (1.f / 128.f) + EPSN); }
  }
}

__device__ __forceinline__ void phase_g234(const Params& p, bf16_t* sm) {
  const int tidx_ = opaque_tid();
  const int lane = tidx_ & 63, wave = tidx_ >> 6, wm = wave >> 1, wn = wave & 1;
  const bf16_t* Z2 = (const bf16_t*)(p.ws + OFF_Z2);
  const bf16_t* XC = (const bf16_t*)(p.ws + OFF_XC);
  bf16_t* QR = (bf16_t*)(p.ws + OFF_H);
  bf16_t* Kb = (bf16_t*)(p.ws + OFF_B);
  bf16_t* Vt = (bf16_t*)(p.ws + OFF_VT);
  unsigned* AB = (unsigned*)p.out;
  const float* rq = (const float*)(p.ws + OFF_RSTDQ);
  const float* rkv = (const float*)(p.ws + OFF_RSTDKV);
  const float* c8 = (const float*)(p.ws + OFF_C8);
  for (int it = blockIdx.x; it < 15360; it += gridDim.x) {
    f32x16 acc[2][2];
    if (it < 3072) {
      const int mt = it / 6, nt = it % 6;
      gemm_tile(Z2 + (size_t)mt * 128 * 416, 416, (const bf16_t*)(p.ws + OFF_WUQ) + nt * 128 * 256, 256, 256, acc, sm);
#pragma unroll
      for (int mi = 0; mi < 2; mi++)
#pragma unroll
        for (int r = 0; r < 16; r++) {
          const int rl = EPI_ROW(wm, mi, r, lane);
          const float rs = rq[mt * 128 + rl];
#pragma unroll
          for (int ni = 0; ni < 2; ni++) sm[rl * CS_LD + EPI_COL(wn, ni, lane)] = f2bf(acc[mi][ni][r] * rs);
        }
      __syncthreads();
      tile_copy_out(sm, QR + (size_t)mt * 128 * 768 + nt * 128, 768, 4);
      __syncthreads();
    } else if (it < 7168) {
      const int j = it - 3072;
      const int mt = j >> 3, h = j & 7;
      gemm_tile(Z2 + (size_t)mt * 128 * 416 + 256, 416, (const bf16_t*)(p.ws + OFF_WUKV) + h * 128 * 128, 128, 128, acc, sm);
      SeqInfo si = seq_of(mt * 128);
      if (wn == 0) {
#pragma unroll
        for (int mi = 0; mi < 2; mi++)
#pragma unroll
          for (int r = 0; r < 16; r++) {
            const int row = mt * 128 + EPI_ROW(wm, mi, r, lane);
            const float rs = rkv[row];
            const size_t krow = (size_t)si.s0 * 8 + (size_t)h * si.S + (row - si.s0);
#pragma unroll
            for (int ni = 0; ni < 2; ni++)
              Kb[krow * 96 + ni * 32 + (lane & 31)] = f2bf(acc[mi][ni][r] * rs);
          }
      } else {
        bf16_t* vb = Vt + ((size_t)si.s0 * 8 + (size_t)h * si.S) * 64;
#pragma unroll
        for (int mi = 0; mi < 2; mi++)
#pragma unroll
          for (int rg = 0; rg < 4; rg++) {
            const int t4 = mt * 128 + wm * 64 + mi * 32 + 8 * rg + 4 * (lane >> 5);
            const float r0 = rkv[t4], r1 = rkv[t4 + 1], r2 = rkv[t4 + 2], r3 = rkv[t4 + 3];
#pragma unroll
            for (int ni = 0; ni < 2; ni++) {
              const int dv = ni * 32 + (lane & 31);
              uint2 pk = make_uint2(pack2(acc[mi][ni][rg * 4 + 0] * r0, acc[mi][ni][rg * 4 + 1] * r1),
                                    pack2(acc[mi][ni][rg * 4 + 2] * r2, acc[mi][ni][rg * 4 + 3] * r3));
              const int ps_ = t4 - si.s0;
              const int pp_ = (ps_ & ~12) | ((ps_ & 4) << 1) | ((ps_ & 8) >> 1);
              *(uint2*)(vb + (size_t)dv * si.S + pp_) = pk;
            }
          }
      }
    } else {
      const int j = it - 7168;
      const int mt = j >> 4, hd = j & 15, h = hd >> 1, d = hd & 1;
      gemm_tile(XC + (size_t)mt * 128 * 512 + h * 64, 512, (const bf16_t*)(p.ws + OFF_WGATE) + hd * 128 * 64, 64, 64, acc, sm);
      const int c = h * 64 + wn * 32 + (lane & 31);
      const float ba = p.in[12][d * 512 + c], bx = p.in[14][d * 512 + c], cc8 = c8[d * 512 + c];
#pragma unroll
      for (int mi = 0; mi < 2; mi++)
#pragma unroll
        for (int r = 0; r < 16; r++) {
          const int row = mt * 128 + EPI_ROW(wm, mi, r, lane);
          const float rg = sigmoid_f(acc[mi][0][r] + ba);
          const float ig = sigmoid_f(acc[mi][1][r] + bx);
          const float l2a = -rg * cc8;
          const float a2 = fexp2(2.f * l2a);
          const float xv = bf2f(XC[(size_t)row * 512 + c]);
          const float bb = __builtin_amdgcn_sqrtf(fmaxf(1.f - a2, 0.f)) * ig * xv;
          AB[((size_t)d * T_TOK + row) * 512 + c] = pack2(l2a, bb);
        }
    }
  }
}

__device__ __forceinline__ void unpack8(uint4 v, float* f) {
  f[0] = lo2f(v.x); f[1] = hi2f(v.x); f[2] = lo2f(v.y); f[3] = hi2f(v.y);
  f[4] = lo2f(v.z); f[5] = hi2f(v.z); f[6] = lo2f(v.w); f[7] = hi2f(v.w);
}
__device__ __forceinline__ uint4 pack8(const float* f) {
  return make_uint4(pack2(f[0], f[1]), pack2(f[2], f[3]), pack2(f[4], f[5]), pack2(f[6], f[7]));
}
__device__ __forceinline__ float sumsq8(uint4 v) {
  float a0 = lo2f(v.x), a1 = hi2f(v.x), a2 = lo2f(v.y), a3 = hi2f(v.y), a4 = lo2f(v.z), a5 = hi2f(v.z), a6 = lo2f(v.w), a7 = hi2f(v.w);
  return a0 * a0 + a1 * a1 + a2 * a2 + a3 * a3 + a4 * a4 + a5 * a5 + a6 * a6 + a7 * a7;
}
__device__ __forceinline__ void norm_rope96(uint4 (&v)[12], const float* __restrict__ gain, float outscale, const float (&cs)[16], const float (&sn)[16]) {
  float ss = 0.f;
#pragma unroll
  for (int i = 0; i < 12; i++) ss += sumsq8(v[i]);
  const float rstd = rsqrtf(ss * (1.f / 96.f) + EPSN);
#pragma unroll
  for (int i = 0; i < 8; i++) {
    float f[8]; unpack8(v[i], f);
#pragma unroll
    for (int j = 0; j < 8; j++) f[j] = f[j] * rstd * gain[i * 8 + j] * outscale;
    v[i] = pack8(f);
  }
#pragma unroll
  for (int q = 0; q < 2; q++) {
    float f1[8], f2[8]; unpack8(v[8 + q], f1); unpack8(v[10 + q], f2);
#pragma unroll
    for (int j = 0; j < 8; j++) {
      const float r1 = f1[j] * rstd * gain[64 + q * 8 + j];
      const float r2 = f2[j] * rstd * gain[80 + q * 8 + j];
      const float c = cs[q * 8 + j], s = sn[q * 8 + j];
      f1[j] = (r1 * c - r2 * s) * outscale;
      f2[j] = (r2 * c + r1 * s) * outscale;
    }
    v[8 + q] = pack8(f1); v[10 + q] = pack8(f2);
  }
}

#define QSCALE (0.10206207261596575f * 1.4426950408889634f)

__device__ __forceinline__ void phase_qkprep_scan1(const Params& p) {
  const int tidx_ = opaque_tid();
  const int tid = tidx_;
  bf16_t* QR = (bf16_t*)(p.ws + OFF_H);
  bf16_t* Kb = (bf16_t*)(p.ws + OFF_B);
  const bf16_t* Z2 = (const bf16_t*)(p.ws + OFF_Z2);
  const unsigned* AB = (const unsigned*)p.out;
  float* aggA = (float*)(p.ws + OFF_AGGA);
  float* aggB = (float*)(p.ws + OFF_AGGB);
  for (int it = blockIdx.x; it < 4096; it += gridDim.x) {
    if (it < 2048) {
      const int i = it * 256 + tid;
      const int t = i >> 3, h = i & 7;
      SeqInfo si = seq_of(t);
      const float pos = (float)(t - si.s0);
      float cs[16], sn[16];
#pragma unroll
      for (int k = 0; k < 16; k++) {
        const float inv = exp2f(-(float)k * (13.287712379549449f / 16.f));
        float rev = pos * inv * 0.15915494309189535f;
        rev = rev - floorf(rev);
        cs[k] = __builtin_amdgcn_cosf(rev);
        sn[k] = __builtin_amdgcn_sinf(rev);
      }
      uint4 v[12];
      bf16_t* qp = QR + (size_t)t * 768 + h * 96;
#pragma unroll
      for (int k = 0; k < 12; k++) v[k] = *(const uint4*)(qp + k * 8);
      norm_rope96(v, p.in[20], QSCALE, cs, sn);
#pragma unroll
      for (int k = 0; k < 12; k++) *(uint4*)(qp + k * 8) = v[k];
      bf16_t* kp = Kb + ((size_t)si.s0 * 8 + (size_t)h * si.S + (t - si.s0)) * 96;
#pragma unroll
      for (int k = 0; k < 8; k++) v[k] = *(const uint4*)(kp + k * 8);
#pragma unroll
      for (int k = 0; k < 4; k++) v[8 + k] = *(const uint4*)(Z2 + (size_t)t * 416 + 384 + k * 8);
      norm_rope96(v, p.in[21], 1.f, cs, sn);
#pragma unroll
      for (int k = 0; k < 12; k++) *(uint4*)(kp + k * 8) = v[k];
    } else {
      const int i = (it - 2048) * 256 + tid;
      const int c = i & 511, ch = (i >> 9) & 511, d = i >> 18;
      const unsigned* ab = AB + ((size_t)d * T_TOK + (size_t)ch * 128) * 512 + c;
      float A = 1.f, Bv = 0.f;
      if (d == 0) {
        for (int sb = 0; sb < 128; sb += 16) {
          unsigned u[16];
#pragma unroll
          for (int j = 0; j < 16; j++) u[j] = ab[(size_t)(sb + j) * 512];
#pragma unroll
          for (int j = 0; j < 16; j++) { float a = fexp2(lo2f(u[j])); Bv = a * Bv + hi2f(u[j]); A *= a; }
        }
      } else {
        for (int sb = 112; sb >= 0; sb -= 16) {
          unsigned u[16];
#pragma unroll
          for (int j = 0; j < 16; j++) u[j] = ab[(size_t)(sb + j) * 512];
#pragma unroll
          for (int j = 15; j >= 0; j--) { float a = fexp2(lo2f(u[j])); Bv = a * Bv + hi2f(u[j]); A *= a; }
        }
      }
      aggA[i] = A; aggB[i] = Bv;
    }
  }
}

__device__ __forceinline__ void phase_scan2(const Params& p) {
  const int tidx_ = opaque_tid();
  const int gtid = blockIdx.x * 256 + tidx_, gsz = gridDim.x * 256;
  const float* aggA = (const float*)(p.ws + OFF_AGGA);
  const float* aggB = (const float*)(p.ws + OFF_AGGB);
  float* carry = (float*)(p.ws + OFF_CARRY);
  for (int i = gtid; i < 10240; i += gsz) {
    const int d = i / 5120, rem = i % 5120, seq = rem >> 9, c = rem & 511;
    const int ch0 = seq < 2 ? seq * 128 : 256 + (seq - 2) * 32;
    const int nch = seq < 2 ? 128 : 32;
    float cr = 0.f;
    const int ob = ((d * 512) + ch0) * 512 + c;
    if (d == 0) {
      for (int jb = 0; jb < nch; jb += 16) {
        float av[16], bv[16];
#pragma unroll
        for (int j = 0; j < 16; j++) { av[j] = aggA[ob + (jb + j) * 512]; bv[j] = aggB[ob + (jb + j) * 512]; }
#pragma unroll
        for (int j = 0; j < 16; j++) { carry[ob + (jb + j) * 512] = cr; cr = av[j] * cr + bv[j]; }
      }
    } else {
      for (int jb = nch - 16; jb >= 0; jb -= 16) {
        float av[16], bv[16];
#pragma unroll
        for (int j = 0; j < 16; j++) { av[j] = aggA[ob + (jb + j) * 512]; bv[j] = aggB[ob + (jb + j) * 512]; }
#pragma unroll
        for (int j = 15; j >= 0; j--) { carry[ob + (jb + j) * 512] = cr; cr = av[j] * cr + bv[j]; }
      }
    }
  }
}

__device__ __forceinline__ void scan3_item(const Params& p, int it) {
  const int tidx_ = opaque_tid();
  const int i = it * 256 + tidx_;
  const int c = i & 511, ch = i >> 9;
  unsigned* AB = (unsigned*)p.out;
  bf16_t* Z1 = (bf16_t*)(p.ws + OFF_R1);
  unsigned* abf = AB + ((size_t)ch * 128) * 512 + c;
  unsigned* abb = AB + ((size_t)T_TOK + (size_t)ch * 128) * 512 + c;
  const float* aggA = (const float*)(p.ws + OFF_AGGA);
  const float* aggB = (const float*)(p.ws + OFF_AGGB);
  const int ch0 = ch < 256 ? (ch & ~127) : (ch & ~31);
  const int nch = ch < 256 ? 128 : 32;
  float hst = 0.f;
#pragma unroll 8
  for (int j = ch0; j < ch; j++) hst = aggA[j * 512 + c] * hst + aggB[j * 512 + c];
  for (int sb = 0; sb < 128; sb += 16) {
    unsigned u[16];
#pragma unroll
    for (int j = 0; j < 16; j++) u[j] = abf[(size_t)(sb + j) * 512];
#pragma unroll
    for (int j = 0; j < 16; j++) { hst = fexp2(lo2f(u[j])) * hst + hi2f(u[j]); u[j] = __float_as_uint(hst); }
#pragma unroll
    for (int j = 0; j < 16; j++) abf[(size_t)(sb + j) * 512] = u[j];
  }
  hst = 0.f;
#pragma unroll 8
  for (int j = ch0 + nch - 1; j > ch; j--) hst = aggA[(512 + j) * 512 + c] * hst + aggB[(512 + j) * 512 + c];
  bf16_t* zp = Z1 + ((size_t)ch * 128) * 1024 + 512 + c;
  for (int sb = 112; sb >= 0; sb -= 16) {
    unsigned u[16]; float fw[16]; unsigned short yv[16];
#pragma unroll
    for (int j = 0; j < 16; j++) { u[j] = abb[(size_t)(sb + j) * 512]; fw[j] = __uint_as_float(abf[(size_t)(sb + j) * 512]); yv[j] = zp[(size_t)(sb + j) * 1024]; }
#pragma unroll
    for (int j = 15; j >= 0; j--) {
      hst = fexp2(lo2f(u[j])) * hst + hi2f(u[j]);
      const float tot = hst + fw[j];
      yv[j] = f2bf(tot * gelu_t(bf2f(yv[j])));
    }
#pragma unroll
    for (int j = 0; j < 16; j++) zp[(size_t)(sb + j) * 1024] = yv[j];
  }
}

#define KS_STRIDE 104
#define VS_STRIDE 72
#define ATT_BUF (64 * KS_STRIDE + 64 * VS_STRIDE)
__device__ __forceinline__ float xhalf_max(float x) {
  auto r = __builtin_amdgcn_permlane32_swap(__float_as_int(x), __float_as_int(x), false, false);
  return fmaxf(__int_as_float(r[0]), __int_as_float(r[1]));
}
template <bool OFFS>
__device__ __forceinline__ void attn_item(const Params& p, int seq, int h, int qt, bf16_t* sm) {
  const int tidx_ = opaque_tid();
  const int tid = tidx_, lane = tid & 63, w = tid >> 6, hh = lane >> 5, l31 = lane & 31;
  int s0, S;
  if (seq < 2) { s0 = seq << 14; S = 16384; } else { s0 = 32768 + ((seq - 2) << 12); S = 4096; }
  const bf16_t* Q = (const bf16_t*)(p.ws + OFF_H) + ((size_t)(s0 + qt * 256)) * 768 + h * 96;
  const bf16_t* Kp = (const bf16_t*)(p.ws + OFF_B) + ((size_t)s0 * 8 + (size_t)h * S) * 96;
  const bf16_t* Vp = (const bf16_t*)(p.ws + OFF_VT) + ((size_t)s0 * 8 + (size_t)h * S) * 64;
  bf16_t* Z1 = (bf16_t*)(p.ws + OFF_R1);
  bf16x8 qf[2][6];
#pragma unroll
  for (int qs = 0; qs < 2; qs++)
#pragma unroll
    for (int kk = 0; kk < 6; kk++) qf[qs][kk] = *(const bf16x8*)(Q + (size_t)(w * 64 + qs * 32 + l31) * 768 + kk * 16 + hh * 8);
  f32x16 o00, o01, o10, o11;
#pragma unroll
  for (int r = 0; r < 16; r++) { o00[r] = 0.f; o01[r] = 0.f; o10[r] = 0.f; o11[r] = 0.f; }
  float l0 = 0.f, l1 = 0.f;
  float negc0 = 0.f, negc1 = 0.f;
  if (OFFS) {
    float qa = 0.f, qb = 0.f;
#pragma unroll
    for (int kk = 0; kk < 6; kk++)
#pragma unroll
      for (int j = 0; j < 8; j++) {
        const float x = bf2f((unsigned short)qf[0][kk][j]); qa += x * x;
        const float y = bf2f((unsigned short)qf[1][kk][j]); qb += y * y;
      }
    qa += __shfl_xor(qa, 32);
    qb += __shfl_xor(qb, 32);
    const float* gk = p.in[21];
    float gm = fmaxf(fabsf(gk[lane]), lane < 32 ? fabsf(gk[64 + lane]) : 0.f);
#pragma unroll
    for (int o_ = 32; o_ > 0; o_ >>= 1) gm = fmaxf(gm, __shfl_xor(gm, o_));
    negc0 = -(sqrtf(qa) * 9.797958971f * gm * 1.01f + 1e-3f);
    negc1 = -(sqrtf(qb) * 9.797958971f * gm * 1.01f + 1e-3f);
  }
  const int kr0 = tid / 12, kc0 = (tid % 12) * 8;
  const int kr1 = (tid + 256) / 12, kc1 = ((tid + 256) % 12) * 8;
  const int kr2 = (tid + 512) / 12, kc2 = ((tid + 512) % 12) * 8;
  const int vr0 = tid >> 3, vc0 = (tid & 7) * 8;
  const int vr1 = (tid + 256) >> 3, vc1 = vc0;
  const int ko0 = kr0 * KS_STRIDE + kc0, ko1 = kr1 * KS_STRIDE + kc1, ko2 = kr2 * KS_STRIDE + kc2;
  const int vo0 = 64 * KS_STRIDE + vr0 * VS_STRIDE + vc0, vo1 = 64 * KS_STRIDE + vr1 * VS_STRIDE + vc1;
  const unsigned kq0 = (unsigned)(kr0 * 96 + kc0), kq1 = (unsigned)(kr1 * 96 + kc1), kq2 = (unsigned)(kr2 * 96 + kc2);
  const unsigned vq0 = (unsigned)(vr0 * S + vc0), vq1 = (unsigned)(vr1 * S + vc1);
  uint4 rk0 = *(const uint4*)(Kp + kq0), rk1 = *(const uint4*)(Kp + kq1), rk2 = *(const uint4*)(Kp + kq2);
  uint4 rv0 = *(const uint4*)(Vp + vq0), rv1 = *(const uint4*)(Vp + vq1);
  const int nt = S >> 6;
  __syncthreads();
  *(uint4*)(sm + ko0) = rk0; *(uint4*)(sm + ko1) = rk1; *(uint4*)(sm + ko2) = rk2;
  *(uint4*)(sm + vo0) = rv0; *(uint4*)(sm + vo1) = rv1;
  __syncthreads();
  const int koff = l31 * KS_STRIDE + hh * 8;
  const int voff = 64 * KS_STRIDE + l31 * VS_STRIDE + hh * 8;
  for (int kt = 0; kt < nt; ++kt) {
    const bf16_t* Ks = sm + (kt & 1) * ATT_BUF;
    if (kt + 1 < nt) {
      const bf16_t* Kn = Kp + (size_t)(kt + 1) * 64 * 96;
      const bf16_t* Vn = Vp + (size_t)(kt + 1) * 64;
      rk0 = *(const uint4*)(Kn + kq0); rk1 = *(const uint4*)(Kn + kq1); rk2 = *(const uint4*)(Kn + kq2);
      rv0 = *(const uint4*)(Vn + vq0); rv1 = *(const uint4*)(Vn + vq1);
    }
#pragma unroll 1
    for (int sub = 0; sub < 2; sub++) {
      f32x16 sv0, sv1;
#pragma unroll
      for (int r = 0; r < 16; r++) { sv0[r] = 0.f; sv1[r] = 0.f; }
      const bf16_t* Kr = Ks + koff + sub * 32 * KS_STRIDE;
#pragma unroll
      for (int kk = 0; kk < 6; kk++) {
        bf16x8 kf = *(const bf16x8*)(Kr + kk * 16);
        sv0 = __builtin_amdgcn_mfma_f32_32x32x16_bf16(kf, qf[0][kk], sv0, 0, 0, 0);
        sv1 = __builtin_amdgcn_mfma_f32_32x32x16_bf16(kf, qf[1][kk], sv1, 0, 0, 0);
      }
      float ps0 = 0.f, ps1 = 0.f;
#pragma unroll
      for (int r = 0; r < 16; r++) { float pv = fexp2(OFFS ? sv0[r] + negc0 : sv0[r]); ps0 += pv; sv0[r] = pv; }
#pragma unroll
      for (int r = 0; r < 16; r++) { float pv = fexp2(OFFS ? sv1[r] + negc1 : sv1[r]); ps1 += pv; sv1[r] = pv; }
      l0 += ps0; l1 += ps1;
      const bf16_t* Vr = Ks + voff + sub * 32;
#pragma unroll
      for (int st = 0; st < 2; st++) {
        union { bf16x8 v; unsigned u[4]; } pf0, pf1;
#pragma unroll
        for (int j = 0; j < 4; j++) {
          pf0.u[j] = pack2(sv0[8 * st + 2 * j], sv0[8 * st + 2 * j + 1]);
          pf1.u[j] = pack2(sv1[8 * st + 2 * j], sv1[8 * st + 2 * j + 1]);
        }
        bf16x8 vfa = *(const bf16x8*)(Vr + 16 * st);
        bf16x8 vfb = *(const bf16x8*)(Vr + 32 * VS_STRIDE + 16 * st);
        o00 = __builtin_amdgcn_mfma_f32_32x32x16_bf16(vfa, pf0.v, o00, 0, 0, 0);
        o10 = __builtin_amdgcn_mfma_f32_32x32x16_bf16(vfa, pf1.v, o10, 0, 0, 0);
        o01 = __builtin_amdgcn_mfma_f32_32x32x16_bf16(vfb, pf0.v, o01, 0, 0, 0);
        o11 = __builtin_amdgcn_mfma_f32_32x32x16_bf16(vfb, pf1.v, o11, 0, 0, 0);
      }
    }
    if (kt + 1 < nt) {
      bf16_t* nK = sm + ((kt + 1) & 1) * ATT_BUF;
      *(uint4*)(nK + ko0) = rk0; *(uint4*)(nK + ko1) = rk1; *(uint4*)(nK + ko2) = rk2;
      *(uint4*)(nK + vo0) = rv0; *(uint4*)(nK + vo1) = rv1;
    }
    __syncthreads();
  }
#pragma unroll
  for (int qs = 0; qs < 2; qs++) {
    const float lq = qs ? l1 : l0;
    const float lt = lq + __shfl_xor(lq, 32);
    const float inv = 1.f / lt;
    const size_t trow = (size_t)(s0 + qt * 256 + w * 64 + qs * 32 + l31);
#pragma unroll
    for (int dvt = 0; dvt < 2; dvt++) {
      const f32x16& oo = qs ? (dvt ? o11 : o10) : (dvt ? o01 : o00);
#pragma unroll
      for (int rg = 0; rg < 4; rg++) {
        const int dv = dvt * 32 + 8 * rg + 4 * hh;
        uint2 pk = make_uint2(pack2(oo[rg * 4 + 0] * inv, oo[rg * 4 + 1] * inv), pack2(oo[rg * 4 + 2] * inv, oo[rg * 4 + 3] * inv));
        *(uint2*)(Z1 + trow * 1024 + h * 64 + dv) = pk;
      }
    }
  }
}

__device__ __forceinline__ void phase_attn_scan3(const Params& p, bf16_t* sm) {
  const int tidx_ = opaque_tid();
  __shared__ int s_item;
  int* cnt = (int*)(p.ws + OFF_CNT);
  const int tid = tidx_;
  const int xcc = (int)(__builtin_amdgcn_s_getreg((3 << 11) | 20) & 0xFu) & 7;
  bool use_offs;
  {
    const int lane = tid & 63;
    const float* gq = p.in[20]; const float* gk = p.in[21];
    float a = fmaxf(fabsf(gq[lane]), lane < 32 ? fabsf(gq[64 + lane]) : 0.f);
    float b = fmaxf(fabsf(gk[lane]), lane < 32 ? fabsf(gk[64 + lane]) : 0.f);
#pragma unroll
    for (int o_ = 32; o_ > 0; o_ >>= 1) { a = fmaxf(a, __shfl_xor(a, o_)); b = fmaxf(b, __shfl_xor(b, o_)); }
    const float bound = 96.f * QSCALE * a * b * 1.03f;
    use_offs = !(bound < 64.f);
  }
  for (int dq = 0; dq < 8; ++dq) {
    const int q = (xcc + dq) & 7;
    while (true) {
      __syncthreads();
      if (tid == 0) s_item = atomicAdd(&cnt[q], 1);
      __syncthreads();
      const int it = s_item;
      if (it >= 256) break;
      int seq, h, qt;
      if (it < 128) { const int pair = q + 8 * (it >> 6); seq = pair >> 3; h = pair & 7; qt = it & 63; }
      else { const int j = it - 128; const int pair = q + 8 * (j >> 4); seq = 2 + (pair >> 3); h = pair & 7; qt = j & 15; }
      if (use_offs) attn_item<true>(p, seq, h, qt, sm); else attn_item<false>(p, seq, h, qt, sm);
    }
  }
  while (true) {
    __syncthreads();
    if (tid == 0) s_item = atomicAdd(&cnt[8], 1);
    __syncthreads();
    const int it = s_item;
    if (it >= 1024) break;
    scan3_item(p, it);
  }
}

__device__ __forceinline__ void phase_gres_norm(const Params& p, const bf16_t* A, const bf16_t* W, int layer, bool res_from_input, bf16_t* sm) {
  const int tidx_ = opaque_tid();
  const int lane = tidx_ & 63, wave = tidx_ >> 6, wm = wave >> 1, wn = wave & 1;
  const float* mod = (const float*)(p.ws + OFF_MOD);
  const float* g = p.in[7] + layer * 1024;
  bf16_t* H = (bf16_t*)(p.ws + OFF_H);
  for (int mt = blockIdx.x; mt < 512; mt += gridDim.x) {
    SeqInfo si = seq_of(mt * 128);
    const float* g1 = mod + (layer * 10 + si.b) * 6144 + 2 * 1024;
#pragma unroll 1
    for (int nt = 0; nt < 8; nt++) {
      f32x16 acc[2][2];
      gemm_tile(A + (size_t)mt * 128 * 1024, 1024, W + (size_t)nt * 128 * 1024, 1024, 1024, acc, sm);
      int mrow0 = mt * 128;
      asm volatile("" : "+s"(mrow0));
      const float* xb = res_from_input ? (mrow0 < 32768 ? p.in[0] : p.in[1] - (size_t)32768 * 1024) : p.out;
#pragma unroll
      for (int ni = 0; ni < 2; ni++) {
        const int col = nt * 128 + EPI_COL(wn, ni, lane);
        const float gg = g1[col];
#pragma unroll
        for (int mi = 0; mi < 2; mi++)
#pragma unroll
          for (int r = 0; r < 16; r++) {
            const unsigned off = (unsigned)((mrow0 + EPI_ROW(wm, mi, r, lane)) * 1024 + col);
            p.out[off] = xb[off] + gg * acc[mi][ni][r];
          }
      }
    }
    __syncthreads();
    const float* md = mod + (layer * 10 + si.b) * 6144 + 3 * 1024;
#pragma unroll 1
    for (int rr = wave; rr < 128; rr += 4) {
      const int t = mt * 128 + rr;
      const float* x = p.out + (size_t)t * 1024;
      float4 v[4];
      float ss = 0.f;
#pragma unroll
      for (int j = 0; j < 4; j++) {
        v[j] = *(const float4*)(x + j * 256 + lane * 4);
        ss += v[j].x * v[j].x + v[j].y * v[j].y + v[j].z * v[j].z + v[j].w * v[j].w;
      }
      ss = wave_sum(ss);
      const float rstd = rsqrtf(ss * (1.f / 1024.f) + EPSN);
#pragma unroll
      for (int j = 0; j < 4; j++) {
        const int idx = j * 256 + lane * 4;
        float4 gg = *(const float4*)(g + idx);
        float4 sh = *(const float4*)(md + idx);
        float4 sc = *(const float4*)(md + 1024 + idx);
        float y0 = v[j].x * rstd * gg.x * (1.f + sc.x) + sh.x;
        float y1 = v[j].y * rstd * gg.y * (1.f + sc.y) + sh.y;
        float y2 = v[j].z * rstd * gg.z * (1.f + sc.z) + sh.z;
        float y3 = v[j].w * rstd * gg.w * (1.f + sc.w) + sh.w;
        *(uint2*)(H + (size_t)t * 1024 + idx) = make_uint2(pack2(y0, y1), pack2(y2, y3));
      }
    }
    __syncthreads();
  }
}

__device__ __forceinline__ void phase_pq(const Params& p, int layer, bf16_t* sm) {
  const int tidx_ = opaque_tid();
  const int lane = tidx_ & 63, wave = tidx_ >> 6, wm = wave >> 1, wn = wave & 1;
  const bf16_t* H = (const bf16_t*)(p.ws + OFF_H);
  const bf16_t* W = (const bf16_t*)(p.ws + OFF_WPQ) + (size_t)layer * 2048 * 1024;
  bf16_t* PQ = (bf16_t*)(p.ws + OFF_R1);
  XCD_TILE_LOOP(16, mt, nt) {
    f32x16 acc[2][2];
    gemm_tile(H + (size_t)mt * 128 * 1024, 1024, W + (size_t)nt * 128 * 1024, 1024, 1024, acc, sm);
#pragma unroll
    for (int mi = 0; mi < 2; mi++)
#pragma unroll
      for (int ni = 0; ni < 2; ni++)
#pragma unroll
        for (int r = 0; r < 16; r++)
          sm[EPI_ROW(wm, mi, r, lane) * CS_LD + EPI_COL(wn, ni, lane)] = f2bf(acc[mi][ni][r]);
    __syncthreads();
    tile_copy_out(sm, PQ + (size_t)mt * 128 * 2048 + nt * 128, 2048, 4);
    __syncthreads();
  }
}

__device__ __forceinline__ int ordf(float x) { int b = __float_as_int(x); return b ^ ((b >> 31) & 0x7fffffff); }
__device__ __forceinline__ float unordf(int o) { return __int_as_float(o ^ ((o >> 31) & 0x7fffffff)); }
#define KEY_MIN ((int)0x80000000)
#define KINS(L, key)                                              \
  {                                                               \
    int cx_ = (key);                                              \
    _Pragma("unroll") for (int k_ = 0; k_ < 16; k_++) {           \
      const int hi_ = max(L[k_], cx_);                            \
      cx_ = min(L[k_], cx_);                                      \
      L[k_] = hi_;                                                \
    }                                                             \
  }
#define KSTAGE(c_, st_)                                                  \
  _Pragma("unroll") for (int i_ = 0; i_ < 16; i_++) {                     \
    if ((i_ & (st_)) == 0) {                                              \
      const int hi_ = max(c_[i_], c_[i_ + (st_)]);                        \
      const int lo_ = min(c_[i_], c_[i_ + (st_)]);                        \
      c_[i_] = hi_; c_[i_ + (st_)] = lo_;                                 \
    }                                                                     \
  }
#define KMERGE(L)                                                                     \
  {                                                                                   \
    int c_[16];                                                                       \
    _Pragma("unroll") for (int k_ = 0; k_ < 16; k_++) c_[k_] = max(L[k_], __shfl_xor(L[15 - k_], 1)); \
    KSTAGE(c_, 8) KSTAGE(c_, 4) KSTAGE(c_, 2) KSTAGE(c_, 1)                           \
    _Pragma("unroll") for (int k_ = 0; k_ < 16; k_++) L[k_] = c_[k_];                 \
  }

#define KSORT16(V) { \
    { const int hi_ = max(V[0], V[1]); const int lo_ = min(V[0], V[1]); V[0] = hi_; V[1] = lo_; } \
    { const int hi_ = max(V[3], V[2]); const int lo_ = min(V[3], V[2]); V[3] = hi_; V[2] = lo_; } \
    { const int hi_ = max(V[4], V[5]); const int lo_ = min(V[4], V[5]); V[4] = hi_; V[5] = lo_; } \
    { const int hi_ = max(V[7], V[6]); const int lo_ = min(V[7], V[6]); V[7] = hi_; V[6] = lo_; } \
    { const int hi_ = max(V[8], V[9]); const int lo_ = min(V[8], V[9]); V[8] = hi_; V[9] = lo_; } \
    { const int hi_ = max(V[11], V[10]); const int lo_ = min(V[11], V[10]); V[11] = hi_; V[10] = lo_; } \
    { const int hi_ = max(V[12], V[13]); const int lo_ = min(V[12], V[13]); V[12] = hi_; V[13] = lo_; } \
    { const int hi_ = max(V[15], V[14]); const int lo_ = min(V[15], V[14]); V[15] = hi_; V[14] = lo_; } \
    { const int hi_ = max(V[0], V[2]); const int lo_ = min(V[0], V[2]); V[0] = hi_; V[2] = lo_; } \
    { const int hi_ = max(V[1], V[3]); const int lo_ = min(V[1], V[3]); V[1] = hi_; V[3] = lo_; } \
    { const int hi_ = max(V[6], V[4]); const int lo_ = min(V[6], V[4]); V[6] = hi_; V[4] = lo_; } \
    { const int hi_ = max(V[7], V[5]); const int lo_ = min(V[7], V[5]); V[7] = hi_; V[5] = lo_; } \
    { const int hi_ = max(V[8], V[10]); const int lo_ = min(V[8], V[10]); V[8] = hi_; V[10] = lo_; } \
    { const int hi_ = max(V[9], V[11]); const int lo_ = min(V[9], V[11]); V[9] = hi_; V[11] = lo_; } \
    { const int hi_ = max(V[14], V[12]); const int lo_ = min(V[14], V[12]); V[14] = hi_; V[12] = lo_; } \
    { const int hi_ = max(V[15], V[13]); const int lo_ = min(V[15], V[13]); V[15] = hi_; V[13] = lo_; } \
    { const int hi_ = max(V[0], V[1]); const int lo_ = min(V[0], V[1]); V[0] = hi_; V[1] = lo_; } \
    { const int hi_ = max(V[2], V[3]); const int lo_ = min(V[2], V[3]); V[2] = hi_; V[3] = lo_; } \
    { const int hi_ = max(V[5], V[4]); const int lo_ = min(V[5], V[4]); V[5] = hi_; V[4] = lo_; } \
    { const int hi_ = max(V[7], V[6]); const int lo_ = min(V[7], V[6]); V[7] = hi_; V[6] = lo_; } \
    { const int hi_ = max(V[8], V[9]); const int lo_ = min(V[8], V[9]); V[8] = hi_; V[9] = lo_; } \
    { const int hi_ = max(V[10], V[11]); const int lo_ = min(V[10], V[11]); V[10] = hi_; V[11] = lo_; } \
    { const int hi_ = max(V[13], V[12]); const int lo_ = min(V[13], V[12]); V[13] = hi_; V[12] = lo_; } \
    { const int hi_ = max(V[15], V[14]); const int lo_ = min(V[15], V[14]); V[15] = hi_; V[14] = lo_; } \
    { const int hi_ = max(V[0], V[4]); const int lo_ = min(V[0], V[4]); V[0] = hi_; V[4] = lo_; } \
    { const int hi_ = max(V[1], V[5]); const int lo_ = min(V[1], V[5]); V[1] = hi_; V[5] = lo_; } \
    { const int hi_ = max(V[2], V[6]); const int lo_ = min(V[2], V[6]); V[2] = hi_; V[6] = lo_; } \
    { const int hi_ = max(V[3], V[7]); const int lo_ = min(V[3], V[7]); V[3] = hi_; V[7] = lo_; } \
    { const int hi_ = max(V[12], V[8]); const int lo_ = min(V[12], V[8]); V[12] = hi_; V[8] = lo_; } \
    { const int hi_ = max(V[13], V[9]); const int lo_ = min(V[13], V[9]); V[13] = hi_; V[9] = lo_; } \
    { const int hi_ = max(V[14], V[10]); const int lo_ = min(V[14], V[10]); V[14] = hi_; V[10] = lo_; } \
    { const int hi_ = max(V[15], V[11]); const int lo_ = min(V[15], V[11]); V[15] = hi_; V[11] = lo_; } \
    { const int hi_ = max(V[0], V[2]); const int lo_ = min(V[0], V[2]); V[0] = hi_; V[2] = lo_; } \
    { const int hi_ = max(V[1], V[3]); const int lo_ = min(V[1], V[3]); V[1] = hi_; V[3] = lo_; } \
    { const int hi_ = max(V[4], V[6]); const int lo_ = min(V[4], V[6]); V[4] = hi_; V[6] = lo_; } \
    { const int hi_ = max(V[5], V[7]); const int lo_ = min(V[5], V[7]); V[5] = hi_; V[7] = lo_; } \
    { const int hi_ = max(V[10], V[8]); const int lo_ = min(V[10], V[8]); V[10] = hi_; V[8] = lo_; } \
    { const int hi_ = max(V[11], V[9]); const int lo_ = min(V[11], V[9]); V[11] = hi_; V[9] = lo_; } \
    { const int hi_ = max(V[14], V[12]); const int lo_ = min(V[14], V[12]); V[14] = hi_; V[12] = lo_; } \
    { const int hi_ = max(V[15], V[13]); const int lo_ = min(V[15], V[13]); V[15] = hi_; V[13] = lo_; } \
    { const int hi_ = max(V[0], V[1]); const int lo_ = min(V[0], V[1]); V[0] = hi_; V[1] = lo_; } \
    { const int hi_ = max(V[2], V[3]); const int lo_ = min(V[2], V[3]); V[2] = hi_; V[3] = lo_; } \
    { const int hi_ = max(V[4], V[5]); const int lo_ = min(V[4], V[5]); V[4] = hi_; V[5] = lo_; } \
    { const int hi_ = max(V[6], V[7]); const int lo_ = min(V[6], V[7]); V[6] = hi_; V[7] = lo_; } \
    { const int hi_ = max(V[9], V[8]); const int lo_ = min(V[9], V[8]); V[9] = hi_; V[8] = lo_; } \
    { const int hi_ = max(V[11], V[10]); const int lo_ = min(V[11], V[10]); V[11] = hi_; V[10] = lo_; } \
    { const int hi_ = max(V[13], V[12]); const int lo_ = min(V[13], V[12]); V[13] = hi_; V[12] = lo_; } \
    { const int hi_ = max(V[15], V[14]); const int lo_ = min(V[15], V[14]); V[15] = hi_; V[14] = lo_; } \
    { const int hi_ = max(V[0], V[8]); const int lo_ = min(V[0], V[8]); V[0] = hi_; V[8] = lo_; } \
    { const int hi_ = max(V[1], V[9]); const int lo_ = min(V[1], V[9]); V[1] = hi_; V[9] = lo_; } \
    { const int hi_ = max(V[2], V[10]); const int lo_ = min(V[2], V[10]); V[2] = hi_; V[10] = lo_; } \
    { const int hi_ = max(V[3], V[11]); const int lo_ = min(V[3], V[11]); V[3] = hi_; V[11] = lo_; } \
    { const int hi_ = max(V[4], V[12]); const int lo_ = min(V[4], V[12]); V[4] = hi_; V[12] = lo_; } \
    { const int hi_ = max(V[5], V[13]); const int lo_ = min(V[5], V[13]); V[5] = hi_; V[13] = lo_; } \
    { const int hi_ = max(V[6], V[14]); const int lo_ = min(V[6], V[14]); V[6] = hi_; V[14] = lo_; } \
    { const int hi_ = max(V[7], V[15]); const int lo_ = min(V[7], V[15]); V[7] = hi_; V[15] = lo_; } \
    { const int hi_ = max(V[0], V[4]); const int lo_ = min(V[0], V[4]); V[0] = hi_; V[4] = lo_; } \
    { const int hi_ = max(V[1], V[5]); const int lo_ = min(V[1], V[5]); V[1] = hi_; V[5] = lo_; } \
    { const int hi_ = max(V[2], V[6]); const int lo_ = min(V[2], V[6]); V[2] = hi_; V[6] = lo_; } \
    { const int hi_ = max(V[3], V[7]); const int lo_ = min(V[3], V[7]); V[3] = hi_; V[7] = lo_; } \
    { const int hi_ = max(V[8], V[12]); const int lo_ = min(V[8], V[12]); V[8] = hi_; V[12] = lo_; } \
    { const int hi_ = max(V[9], V[13]); const int lo_ = min(V[9], V[13]); V[9] = hi_; V[13] = lo_; } \
    { const int hi_ = max(V[10], V[14]); const int lo_ = min(V[10], V[14]); V[10] = hi_; V[14] = lo_; } \
    { const int hi_ = max(V[11], V[15]); const int lo_ = min(V[11], V[15]); V[11] = hi_; V[15] = lo_; } \
    { const int hi_ = max(V[0], V[2]); const int lo_ = min(V[0], V[2]); V[0] = hi_; V[2] = lo_; } \
    { const int hi_ = max(V[1], V[3]); const int lo_ = min(V[1], V[3]); V[1] = hi_; V[3] = lo_; } \
    { const int hi_ = max(V[4], V[6]); const int lo_ = min(V[4], V[6]); V[4] = hi_; V[6] = lo_; } \
    { const int hi_ = max(V[5], V[7]); const int lo_ = min(V[5], V[7]); V[5] = hi_; V[7] = lo_; } \
    { const int hi_ = max(V[8], V[10]); const int lo_ = min(V[8], V[10]); V[8] = hi_; V[10] = lo_; } \
    { const int hi_ = max(V[9], V[11]); const int lo_ = min(V[9], V[11]); V[9] = hi_; V[11] = lo_; } \
    { const int hi_ = max(V[12], V[14]); const int lo_ = min(V[12], V[14]); V[12] = hi_; V[14] = lo_; } \
    { const int hi_ = max(V[13], V[15]); const int lo_ = min(V[13], V[15]); V[13] = hi_; V[15] = lo_; } \
    { const int hi_ = max(V[0], V[1]); const int lo_ = min(V[0], V[1]); V[0] = hi_; V[1] = lo_; } \
    { const int hi_ = max(V[2], V[3]); const int lo_ = min(V[2], V[3]); V[2] = hi_; V[3] = lo_; } \
    { const int hi_ = max(V[4], V[5]); const int lo_ = min(V[4], V[5]); V[4] = hi_; V[5] = lo_; } \
    { const int hi_ = max(V[6], V[7]); const int lo_ = min(V[6], V[7]); V[6] = hi_; V[7] = lo_; } \
    { const int hi_ = max(V[8], V[9]); const int lo_ = min(V[8], V[9]); V[8] = hi_; V[9] = lo_; } \
    { const int hi_ = max(V[10], V[11]); const int lo_ = min(V[10], V[11]); V[10] = hi_; V[11] = lo_; } \
    { const int hi_ = max(V[12], V[13]); const int lo_ = min(V[12], V[13]); V[12] = hi_; V[13] = lo_; } \
    { const int hi_ = max(V[14], V[15]); const int lo_ = min(V[14], V[15]); V[14] = hi_; V[15] = lo_; } \
  }
#define KMERGE2(L, G) { \
    int c_[16]; \
    _Pragma("unroll") for (int k_ = 0; k_ < 16; k_++) c_[k_] = max(L[k_], G[15 - k_]); \
    KSTAGE(c_, 8) KSTAGE(c_, 4) KSTAGE(c_, 2) KSTAGE(c_, 1) \
    _Pragma("unroll") for (int k_ = 0; k_ < 16; k_++) L[k_] = c_[k_]; \
  }
__device__ __forceinline__ void phase_topk(const Params& p, int layer, bf16_t* sm) {
  const int tidx_ = opaque_tid();
  const int tid = tidx_, lane = tid & 63, wave = tid >> 6, wm = wave >> 1, wn = wave & 1;
  const bf16_t* H = (const bf16_t*)(p.ws + OFF_H);
  const bf16_t* WPQ = (const bf16_t*)(p.ws + OFF_WPQ) + (size_t)layer * 2048 * 1024;
  const bf16_t* KEYS = (const bf16_t*)(p.ws + OFF_KEYS) + (size_t)layer * 2 * 16384;
  int* IDX = (int*)(p.ws + OFF_IDX);
  float* GW = (float*)(p.ws + OFF_GW);
  float* sc = (float*)sm;
  int* ib = (int*)sm;
  const int r = tid >> 1, hf = tid & 1;
#pragma unroll 1
  for (int mt = blockIdx.x; mt < 512; mt += gridDim.x)
#pragma unroll 1
  for (int h = 0; h < 8; h++) {
    int k1[16], k2[16];
#pragma unroll
    for (int pp = 0; pp < 2; pp++) {
      f32x16 acc[2][2];
      gemm_tile(H + (size_t)mt * 128 * 1024, 1024, WPQ + (size_t)(h * 256 + pp * 128) * 1024, 1024, 1024, acc, sm);
#pragma unroll
      for (int mi = 0; mi < 2; mi++)
#pragma unroll
        for (int ni = 0; ni < 2; ni++)
#pragma unroll
          for (int rr = 0; rr < 16; rr++)
            sm[EPI_ROW(wm, mi, rr, lane) * CS_LD + EPI_COL(wn, ni, lane)] = f2bf(acc[mi][ni][rr]);
      gemm_ldsA_k128(KEYS + pp * 16384, acc, sm);
#pragma unroll
      for (int mi = 0; mi < 2; mi++)
#pragma unroll
        for (int ni = 0; ni < 2; ni++)
#pragma unroll
          for (int rr = 0; rr < 16; rr++)
            sc[EPI_ROW(wm, mi, rr, lane) * 130 + wn * 65 + ni * 32 + (lane & 31)] = acc[mi][ni][rr];
      __syncthreads();
      int L[16];
      const float* rp = sc + r * 130 + hf * 65;
      const int ibase = 127 - hf * 64;
#pragma unroll
      for (int j = 0; j < 16; j++) L[j] = (ordf(rp[j]) & ~127) | (ibase - j);
      KSORT16(L);
#pragma unroll 1
      for (int g = 1; g < 4; g++) {
        int G[16];
#pragma unroll
        for (int j = 0; j < 16; j++) G[j] = (ordf(rp[g * 16 + j]) & ~127) | (ibase - (g * 16 + j));
        KSORT16(G);
        KMERGE2(L, G);
      }
      KMERGE(L);
      if (pp == 0) {
#pragma unroll
        for (int k = 0; k < 16; k++) k1[k] = L[k];
      } else {
#pragma unroll
        for (int k = 0; k < 16; k++) k2[k] = L[k];
      }
      __syncthreads();
    }
    if (hf == 0) {
#pragma unroll
      for (int k = 0; k < 16; k++) { ib[r * 32 + k] = 127 - (k1[k] & 127); ib[r * 32 + 16 + k] = 127 - (k2[k] & 127); }
    }
    float A[16], B[16];
#pragma unroll
    for (int k = 0; k < 16; k++) {
      const float v1 = unordf(k1[k] & ~127), v2 = unordf(k2[k] & ~127);
      A[k] = hf ? v2 : v1;
      B[k] = hf ? v1 : v2;
    }
    int F[16], F2[16];
    F[0] = (ordf(A[0] + B[1]) & ~255) | (255 - (hf ? 16 : 1));
    F[1] = (ordf(A[0] + B[2]) & ~255) | (255 - (hf ? 32 : 2));
    F[2] = (ordf(A[0] + B[3]) & ~255) | (255 - (hf ? 48 : 3));
    F[3] = (ordf(A[0] + B[4]) & ~255) | (255 - (hf ? 64 : 4));
    F[4] = (ordf(A[0] + B[5]) & ~255) | (255 - (hf ? 80 : 5));
    F[5] = (ordf(A[0] + B[6]) & ~255) | (255 - (hf ? 96 : 6));
    F[6] = (ordf(A[0] + B[7]) & ~255) | (255 - (hf ? 112 : 7));
    F[7] = (ordf(A[0] + B[8]) & ~255) | (255 - (hf ? 128 : 8));
    F[8] = (ordf(A[0] + B[9]) & ~255) | (255 - (hf ? 144 : 9));
    F[9] = (ordf(A[0] + B[10]) & ~255) | (255 - (hf ? 160 : 10));
    F[10] = (ordf(A[0] + B[11]) & ~255) | (255 - (hf ? 176 : 11));
    F[11] = (ordf(A[0] + B[12]) & ~255) | (255 - (hf ? 192 : 12));
    F[12] = (ordf(A[0] + B[13]) & ~255) | (255 - (hf ? 208 : 13));
    F[13] = (ordf(A[0] + B[14]) & ~255) | (255 - (hf ? 224 : 14));
    F[14] = (ordf(A[0] + B[15]) & ~255) | (255 - (hf ? 240 : 15));
    F[15] = (ordf(A[1] + B[2]) & ~255) | (255 - (hf ? 33 : 18));
    F2[0] = (ordf(A[1] + B[3]) & ~255) | (255 - (hf ? 49 : 19));
    F2[1] = (ordf(A[1] + B[4]) & ~255) | (255 - (hf ? 65 : 20));
    F2[2] = (ordf(A[1] + B[5]) & ~255) | (255 - (hf ? 81 : 21));
    F2[3] = (ordf(A[1] + B[6]) & ~255) | (255 - (hf ? 97 : 22));
    F2[4] = (ordf(A[1] + B[7]) & ~255) | (255 - (hf ? 113 : 23));
    F2[5] = (ordf(A[2] + B[3]) & ~255) | (255 - (hf ? 50 : 35));
    F2[6] = (ordf(A[2] + B[4]) & ~255) | (255 - (hf ? 66 : 36));
    F2[7] = hf ? KEY_MIN : ((ordf(A[0] + B[0]) & ~255) | (255 - 0));
    F2[8] = hf ? KEY_MIN : ((ordf(A[1] + B[1]) & ~255) | (255 - 17));
    F2[9] = hf ? KEY_MIN : ((ordf(A[2] + B[2]) & ~255) | (255 - 34));
    F2[10] = hf ? KEY_MIN : ((ordf(A[3] + B[3]) & ~255) | (255 - 51));
    F2[11] = KEY_MIN;
    F2[12] = KEY_MIN;
    F2[13] = KEY_MIN;
    F2[14] = KEY_MIN;
    F2[15] = KEY_MIN;
    KSORT16(F);
    KSORT16(F2);
    KMERGE2(F, F2);
    KMERGE(F);
    __syncthreads();
    float e[16], se = 0.f;
    const float fmx = unordf(F[0] & ~255);
#pragma unroll
    for (int k = 0; k < 16; k++) { e[k] = __expf(unordf(F[k] & ~255) - fmx); se += e[k]; }
    const float inv = 1.f / se;
    int oi[8]; float og[8];
    const int hmask = -hf;
#pragma unroll
    for (int k = 0; k < 8; k++) {
      const int key = (F[k + 8] & hmask) | (F[k] & ~hmask);
      const int j = 255 - (key & 255);
      oi[k] = ib[r * 32 + (j >> 4)] * 128 + ib[r * 32 + 16 + (j & 15)];
      og[k] = __int_as_float((__float_as_int(e[k + 8]) & hmask) | (__float_as_int(e[k]) & ~hmask)) * inv;
    }
    const size_t o = ((size_t)(mt * 128 + r)) * 128 + h * 16 + hf * 8;
    *(int4*)(IDX + o) = make_int4(oi[0], oi[1], oi[2], oi[3]);
    *(int4*)(IDX + o + 4) = make_int4(oi[4], oi[5], oi[6], oi[7]);
    *(float4*)(GW + o) = make_float4(og[0], og[1], og[2], og[3]);
    *(float4*)(GW + o + 4) = make_float4(og[4], og[5], og[6], og[7]);
    __syncthreads();
    if (mt == (int)blockIdx.x) phase_uvconv(p, layer, h, 8);
  }
}

__device__ __forceinline__ float dot16_fp8(uint4 u, const f32x2* hf) {
  f32x2 a = __builtin_amdgcn_cvt_pk_f32_fp8((int)u.x, false) * hf[0];
  a += __builtin_amdgcn_cvt_pk_f32_fp8((int)u.x, true) * hf[1];
  a += __builtin_amdgcn_cvt_pk_f32_fp8((int)u.y, false) * hf[2];
  a += __builtin_amdgcn_cvt_pk_f32_fp8((int)u.y, true) * hf[3];
  a += __builtin_amdgcn_cvt_pk_f32_fp8((int)u.z, false) * hf[4];
  a += __builtin_amdgcn_cvt_pk_f32_fp8((int)u.z, true) * hf[5];
  a += __builtin_amdgcn_cvt_pk_f32_fp8((int)u.w, false) * hf[6];
  a += __builtin_amdgcn_cvt_pk_f32_fp8((int)u.w, true) * hf[7];
  return a.x + a.y;
}
__device__ __forceinline__ void fma16_fp8(f32x2* o, uint4 u, float a) {
  f32x2 aa = {a, a};
  o[0] += __builtin_amdgcn_cvt_pk_f32_fp8((int)u.x, false) * aa;
  o[1] += __builtin_amdgcn_cvt_pk_f32_fp8((int)u.x, true) * aa;
  o[2] += __builtin_amdgcn_cvt_pk_f32_fp8((int)u.y, false) * aa;
  o[3] += __builtin_amdgcn_cvt_pk_f32_fp8((int)u.y, true) * aa;
  o[4] += __builtin_amdgcn_cvt_pk_f32_fp8((int)u.z, false) * aa;
  o[5] += __builtin_amdgcn_cvt_pk_f32_fp8((int)u.z, true) * aa;
  o[6] += __builtin_amdgcn_cvt_pk_f32_fp8((int)u.w, false) * aa;
  o[7] += __builtin_amdgcn_cvt_pk_f32_fp8((int)u.w, true) * aa;
}
constexpr size_t OFF_ACT = OFF_B + 128 * MBY;
__device__ __forceinline__ void phase_gatherU(const Params& p) {
  const int tidx_ = opaque_tid();
  const int lane = tidx_ & 63;
  const int gw = (blockIdx.x * 256 + tidx_) >> 6, nw = gridDim.x * 4;
  const bf16_t* H = (const bf16_t*)(p.ws + OFF_H);
  const unsigned char* UT = (const unsigned char*)(p.ws + OFF_UT);
  const int* IDX = (const int*)(p.ws + OFF_IDX);
  const float* GW = (const float*)(p.ws + OFF_GW);
  float* ACT = (float*)(p.ws + OFF_ACT);
  const bool b5 = (lane & 32) != 0, b4 = (lane & 16) != 0, b3 = (lane & 8) != 0;
  uint4 nh0 = make_uint4(0u, 0u, 0u, 0u), nh1 = nh0; int nid0 = 0, nid1 = 0; float ng0 = 0.f, ng1 = 0.f;
  if (gw < T_TOK) {
    nh0 = *(const uint4*)(H + (size_t)gw * 1024 + lane * 16);
    nh1 = *(const uint4*)(H + (size_t)gw * 1024 + lane * 16 + 8);
    nid0 = IDX[(size_t)gw * 128 + lane]; nid1 = IDX[(size_t)gw * 128 + 64 + lane];
    ng0 = GW[(size_t)gw * 128 + lane]; ng1 = GW[(size_t)gw * 128 + 64 + lane];
  }
  for (int t = gw; t < T_TOK; t += nw) {
    const uint4 h0 = nh0, h1 = nh1;
    const int id0 = nid0, id1 = nid1;
    const float g0 = ng0, g1 = ng1;
    {
      const int tn = t + nw;
      if (tn < T_TOK) {
        nh0 = *(const uint4*)(H + (size_t)tn * 1024 + lane * 16);
        nh1 = *(const uint4*)(H + (size_t)tn * 1024 + lane * 16 + 8);
        nid0 = IDX[(size_t)tn * 128 + lane]; nid1 = IDX[(size_t)tn * 128 + 64 + lane];
        ng0 = GW[(size_t)tn * 128 + lane]; ng1 = GW[(size_t)tn * 128 + 64 + lane];
      }
    }
    f32x2 hf[8];
    {
      hf[0] = f32x2{lo2f(h0.x), hi2f(h0.x)}; hf[1] = f32x2{lo2f(h0.y), hi2f(h0.y)};
      hf[2] = f32x2{lo2f(h0.z), hi2f(h0.z)}; hf[3] = f32x2{lo2f(h0.w), hi2f(h0.w)};
      hf[4] = f32x2{lo2f(h1.x), hi2f(h1.x)}; hf[5] = f32x2{lo2f(h1.y), hi2f(h1.y)};
      hf[6] = f32x2{lo2f(h1.z), hi2f(h1.z)}; hf[7] = f32x2{lo2f(h1.w), hi2f(h1.w)};
    }
    float act0 = 0.f, act1 = 0.f;
    for (int half = 0; half < 2; half++) {
      const int idv = half ? id1 : id0;
      const float gv = half ? g1 : g0;
      float acth = 0.f;
#pragma unroll
      for (int gq = 0; gq < 8; gq += 2) {
        uint4 ua[16];
#pragma unroll
        for (int e = 0; e < 16; e++) {
          const int ex = __builtin_amdgcn_readlane(idv, gq * 8 + e);
          ua[e] = *(const uint4*)(UT + (size_t)ex * 1024 + lane * 16);
        }
#pragma unroll
        for (int g2 = 0; g2 < 2; g2++) {
          float d[8];
#pragma unroll
          for (int e = 0; e < 8; e++) d[e] = dot16_fp8(ua[g2 * 8 + e], hf);
          float e4[4], e2[2], e1;
#pragma unroll
          for (int i = 0; i < 4; i++) {
            const float snd = b5 ? d[i] : d[i + 4];
            const float kp = b5 ? d[i + 4] : d[i];
            e4[i] = kp + __shfl_xor(snd, 32);
          }
#pragma unroll
          for (int i = 0; i < 2; i++) {
            const float snd = b4 ? e4[i] : e4[i + 2];
            const float kp = b4 ? e4[i + 2] : e4[i];
            e2[i] = kp + __shfl_xor(snd, 16);
          }
          {
            const float snd = b3 ? e2[0] : e2[1];
            const float kp = b3 ? e2[1] : e2[0];
            e1 = kp + __shfl_xor(snd, 8);
          }
          e1 += __shfl_xor(e1, 4);
          e1 += __shfl_xor(e1, 2);
          e1 += __shfl_xor(e1, 1);
          const int grp = gq + g2;
          const float gE = __shfl(gv, grp * 8 + (lane >> 3));
          const float mine = gelu_t(e1 * (1.f / U_SCALE)) * gE * (1.f / V_SCALE);
          const float got = __shfl(mine, (lane & 7) * 8);
          acth = ((lane >> 3) == grp) ? got : acth;
        }
      }
      if (half) act1 = acth; else act0 = acth;
    }
    ACT[(size_t)t * 128 + lane] = act0;
    ACT[(size_t)t * 128 + 64 + lane] = act1;
  }
}

__device__ __forceinline__ void phase_gatherV(const Params& p, int layer) {
  const int tidx_ = opaque_tid();
  const int lane = tidx_ & 63;
  const int gw = (blockIdx.x * 256 + tidx_) >> 6, nw = gridDim.x * 4;
  const unsigned char* VT = (const unsigned char*)(p.ws + OFF_VTAB);
  const int* IDX = (const int*)(p.ws + OFF_IDX);
  const float* ACT = (const float*)(p.ws + OFF_ACT);
  const float* mod = (const float*)(p.ws + OFF_MOD);
  int nid0 = 0, nid1 = 0; float na0 = 0.f, na1 = 0.f;
  if (gw < T_TOK) {
    nid0 = IDX[(size_t)gw * 128 + lane]; nid1 = IDX[(size_t)gw * 128 + 64 + lane];
    na0 = ACT[(size_t)gw * 128 + lane]; na1 = ACT[(size_t)gw * 128 + 64 + lane];
  }
  for (int t = gw; t < T_TOK; t += nw) {
    const int id0 = nid0, id1 = nid1;
    const float a0 = na0, a1 = na1;
    {
      const int tn = t + nw;
      if (tn < T_TOK) {
        nid0 = IDX[(size_t)tn * 128 + lane]; nid1 = IDX[(size_t)tn * 128 + 64 + lane];
        na0 = ACT[(size_t)tn * 128 + lane]; na1 = ACT[(size_t)tn * 128 + 64 + lane];
      }
    }
    SeqInfo si = seq_of(t);
    const float* g2p = mod + (layer * 10 + si.b) * 6144 + 5 * 1024 + lane * 16;
    float* orow = p.out + (size_t)t * 1024 + lane * 16;
    float4 xin4[4], gg4[4];
#pragma unroll
    for (int j = 0; j < 4; j++) { xin4[j] = *(const float4*)(orow + j * 4); gg4[j] = *(const float4*)(g2p + j * 4); }
    f32x2 o[8];
#pragma unroll
    for (int j = 0; j < 8; j++) o[j] = f32x2{0.f, 0.f};
    for (int half = 0; half < 2; half++) {
      const int idv = half ? id1 : id0;
      const int av = __float_as_int(half ? a1 : a0);
#pragma unroll
      for (int gq = 0; gq < 8; gq += 2) {
        uint4 va[16];
#pragma unroll
        for (int e = 0; e < 16; e++) {
          const int ex = __builtin_amdgcn_readlane(idv, gq * 8 + e);
          va[e] = *(const uint4*)(VT + (size_t)ex * 1024 + lane * 16);
        }
#pragma unroll
        for (int e = 0; e < 16; e++) {
          const float ae = __int_as_float(__builtin_amdgcn_readlane(av, gq * 8 + e));
          fma16_fp8(o, va[e], ae);
        }
      }
    }
    float4 xn[4];
    float ssx = 0.f;
#pragma unroll
    for (int j = 0; j < 4; j++) {
      float4 xv = xin4[j];
      float4 gg = gg4[j];
      xv.x += gg.x * o[2 * j].x; xv.y += gg.y * o[2 * j].y;
      xv.z += gg.z * o[2 * j + 1].x; xv.w += gg.w * o[2 * j + 1].y;
      *(float4*)(orow + j * 4) = xv;
      xn[j] = xv;
      ssx += xv.x * xv.x + xv.y * xv.y + xv.z * xv.z + xv.w * xv.w;
    }
    if (layer == 0) {
      ssx = wave_sum(ssx);
      const float rstd = rsqrtf(ssx * (1.f / 1024.f) + EPSN);
      const float* gn = p.in[6] + 1024 + lane * 16;
      const float* md = mod + (1 * 10 + si.b) * 6144 + lane * 16;
      unsigned pk[8];
#pragma unroll
      for (int j = 0; j < 4; j++) {
        float4 gg = *(const float4*)(gn + j * 4);
        float4 sh = *(const float4*)(md + j * 4);
        float4 sc = *(const float4*)(md + 1024 + j * 4);
        const float y0 = xn[j].x * rstd * gg.x * (1.f + sc.x) + sh.x;
        const float y1 = xn[j].y * rstd * gg.y * (1.f + sc.y) + sh.y;
        const float y2 = xn[j].z * rstd * gg.z * (1.f + sc.z) + sh.z;
        const float y3 = xn[j].w * rstd * gg.w * (1.f + sc.w) + sh.w;
        pk[2 * j] = pack2(y0, y1); pk[2 * j + 1] = pack2(y2, y3);
      }
      bf16_t* hw = (bf16_t*)(p.ws + OFF_H) + (size_t)t * 1024 + lane * 16;
      *(uint4*)(hw) = make_uint4(pk[0], pk[1], pk[2], pk[3]);
      *(uint4*)(hw + 8) = make_uint4(pk[4], pk[5], pk[6], pk[7]);
    }
  }
}

__device__ __forceinline__ void phase_g8(const Params& p, bf16_t* sm) {
  const int tidx_ = opaque_tid();
  const int lane = tidx_ & 63, wave = tidx_ >> 6, wm = wave >> 1, wn = wave & 1;
  const bf16_t* H = (const bf16_t*)(p.ws + OFF_H);
  const bf16_t* W = (const bf16_t*)(p.ws + OFF_WCIN);
  bf16_t* BG = (bf16_t*)(p.ws + OFF_R1);
  bf16_t* U1 = (bf16_t*)(p.ws + OFF_R1 + 128 * MBY);
  XCD_TILE_LOOP(24, mt, nt) {
    f32x16 acc[2][2];
    gemm_tile(H + (size_t)mt * 128 * 1024, 1024, W + (size_t)nt * 128 * 1024, 1024, 1024, acc, sm);
    if (nt < 8) {
#pragma unroll
      for (int mi = 0; mi < 2; mi++)
#pragma unroll
        for (int ni = 0; ni < 2; ni++)
#pragma unroll
          for (int r = 0; r < 16; r++)
            sm[EPI_ROW(wm, mi, r, lane) * CS_LD + EPI_COL(wn, ni, lane)] = f2bf(acc[mi][ni][r]);
      __syncthreads();
      tile_copy_out(sm, BG + (size_t)mt * 128 * 1024 + nt * 128, 1024, 4);
    } else {
#pragma unroll
      for (int mi = 0; mi < 2; mi++)
#pragma unroll
        for (int r = 0; r < 16; r++)
          sm[EPI_ROW(wm, mi, r, lane) * CS_LD + wn * 32 + (lane & 31)] = f2bf(acc[mi][0][r] * acc[mi][1][r]);
      __syncthreads();
      tile_copy_out(sm, U1 + (size_t)mt * 128 * 1024 + (nt - 8) * 64, 1024, 3);
    }
    __syncthreads();
  }
}

__device__ __forceinline__ void phase_conv1(const Params& p) {
  const int tidx_ = opaque_tid();
  const int gtid = blockIdx.x * 256 + tidx_, gsz = gridDim.x * 256;
  const bf16_t* BG = (const bf16_t*)(p.ws + OFF_R1);
  const bf16_t* U1 = (const bf16_t*)(p.ws + OFF_R1 + 128 * MBY);
  bf16_t* Y = (bf16_t*)(p.ws + OFF_H);
  const float* cw = p.in[24];
  for (int mt_ = blockIdx.x; mt_ < 512; mt_ += gridDim.x)
  for (int j_ = tidx_; j_ < 16384; j_ += 256) {
    const int t = mt_ * 128 + (j_ >> 7), c = (j_ & 127) * 8;
    SeqInfo si = seq_of(t);
    float acc[8];
#pragma unroll
    for (int j = 0; j < 8; j++) acc[j] = 0.f;
#pragma unroll
    for (int k = 0; k < 3; k++) {
      const int tt = t + k - 1;
      if (tt >= si.s0 && tt < si.s0 + si.S) {
        uint4 v = *(const uint4*)(U1 + (size_t)tt * 1024 + c);
        const float* w = cw + k * 1024 + c;
        acc[0] += w[0] * lo2f(v.x); acc[1] += w[1] * hi2f(v.x);
        acc[2] += w[2] * lo2f(v.y); acc[3] += w[3] * hi2f(v.y);
        acc[4] += w[4] * lo2f(v.z); acc[5] += w[5] * hi2f(v.z);
        acc[6] += w[6] * lo2f(v.w); acc[7] += w[7] * hi2f(v.w);
      }
    }
    uint4 b = *(const uint4*)(BG + (size_t)t * 1024 + c);
    float bf[8]; unpack8(b, bf);
#pragma unroll
    for (int j = 0; j < 8; j++) acc[j] *= bf[j];
    *(uint4*)(Y + (size_t)t * 1024 + c) = pack8(acc);
  }
}

__device__ __forceinline__ void gbar_sync(unsigned* bar, unsigned& gen) {
  __syncthreads();
  gen++;
  if (threadIdx.x == 0) {
    __builtin_amdgcn_fence(__ATOMIC_RELEASE, "agent");
    const unsigned G = gridDim.x, b = blockIdx.x, x = b & 7u, y = (b >> 3) & 7u;
    const unsigned nA = (G - (x + 8u * y) + 63u) / 64u;
    const unsigned nBf = (G - x + 7u) / 8u, nB = nBf < 8u ? nBf : 8u;
    const unsigned nR = G < 8u ? G : 8u;
    unsigned* cA = bar + (x * 8u + y) * 16u;
    unsigned* cB = bar + 1024u + x * 16u;
    unsigned* cR = bar + 1024u + 128u;
    unsigned* fl = bar + 1024u + 256u;
    if (atomicAdd(cA, 1u) == nA - 1u) {
      atomicExch(cA, 0u);
      if (atomicAdd(cB, 1u) == nB - 1u) {
        atomicExch(cB, 0u);
        if (atomicAdd(cR, 1u) == nR - 1u) {
          atomicExch(cR, 0u);
          __builtin_amdgcn_fence(__ATOMIC_RELEASE, "agent");
#pragma unroll
          for (int i = 0; i < 8; i++) __hip_atomic_store(fl + i * 16, gen, __ATOMIC_RELAXED, __HIP_MEMORY_SCOPE_AGENT);
        }
      }
    }
    unsigned spins = 0;
    while (__hip_atomic_load(fl + x * 16u, __ATOMIC_RELAXED, __HIP_MEMORY_SCOPE_AGENT) < gen) {
      __builtin_amdgcn_s_sleep(2);
      if (++spins > (1u << 18)) break;
    }
    __builtin_amdgcn_fence(__ATOMIC_ACQUIRE, "agent");
  }
  __syncthreads();
}

#ifndef PROBE_MASK
#define PROBE_MASK 0
#endif
#ifndef PROBE_K
#define PROBE_K 1
#endif
#if PROBE_MASK
#define STAMP(k) do { if (blockIdx.x == 0 && threadIdx.x == 0) ((volatile unsigned long long*)(ws + OFF_CNT + 1024))[k] = wall_clock64(); } while (0)
#else
#define STAMP(k) do { } while (0)
#endif
__global__ void __launch_bounds__(256, 2) mega_fwd(Params p) {
  extern __shared__ __attribute__((aligned(16))) unsigned char smem[];
  cg::grid_group grid = cg::this_grid();
  bf16_t* sm = (bf16_t*)smem;
  unsigned char* ws = p.ws;
  unsigned* bar_ = (unsigned*)(ws + OFF_BAR);
  unsigned bgen_ = 0;

  STAMP(0);
  phase_prep(p, smem);
  grid.sync(); STAMP(1);
  phase_norm(p, 0, 1, true);
  gbar_sync(bar_, bgen_); STAMP(2);
  phase_g1(p, sm);
  gbar_sync(bar_, bgen_); STAMP(3);
  phase_conv0(p);
  gbar_sync(bar_, bgen_); STAMP(4);
  phase_g234(p, sm);
  gbar_sync(bar_, bgen_); STAMP(5);
  phase_qkprep_scan1(p);
  gbar_sync(bar_, bgen_); STAMP(6); STAMP(7);
  phase_attn_scan3(p, sm);
  gbar_sync(bar_, bgen_); STAMP(8);
  phase_gres_norm(p, (const bf16_t*)(ws + OFF_R1), (const bf16_t*)(ws + OFF_WOUT), 0, true, sm);
  STAMP(9);
  __syncthreads();
  STAMP(10); STAMP(11);
  phase_topk(p, 0, sm);
  gbar_sync(bar_, bgen_); STAMP(12);
  phase_gatherU(p);
  gbar_sync(bar_, bgen_);
  phase_gatherV(p, 0);
  gbar_sync(bar_, bgen_); STAMP(13);
  STAMP(14);
  phase_g8(p, sm);
  gbar_sync(bar_, bgen_); STAMP(15);
  phase_conv1(p);
  __syncthreads(); STAMP(16);
  phase_gres_norm(p, (const bf16_t*)(ws + OFF_H), (const bf16_t*)(ws + OFF_WCOUT), 1, false, sm);
  STAMP(17);
  __syncthreads();
  STAMP(18); STAMP(19);
  phase_topk(p, 1, sm);
  gbar_sync(bar_, bgen_); STAMP(20);
  phase_gatherU(p);
  gbar_sync(bar_, bgen_);
  phase_gatherV(p, 1);
#if PROBE_MASK
  gbar_sync(bar_, bgen_); STAMP(21);
  __threadfence();
  gbar_sync(bar_, bgen_);
  {
    const volatile unsigned long long* ts = (const volatile unsigned long long*)(ws + OFF_CNT + 1024);
    unsigned long long tot = 0;
    for (int k = 0; k < 21; k++) if ((PROBE_MASK >> k) & 1) tot += ts[k + 1] - ts[k];
    tot *= PROBE_K;
    const unsigned long long t0 = wall_clock64();
    while (wall_clock64() - t0 < tot) { }
  }
#endif
}

extern "C" void kernel_launch(void* const* d_in, const int* in_sizes, int n_in, void* d_out, int out_size, void* d_ws,
                              size_t ws_size, hipStream_t stream) {
  static int grid_blocks = 0;
  if (grid_blocks == 0) {
    if (n_in != 31 || ws_size < WS_NEED) {
      fprintf(stderr, "kernel_launch: unexpected n_in %d or ws_size %zu (< %zu)\n", n_in, ws_size, (size_t)WS_NEED);
      grid_blocks = -1;
      return;
    }
    int dev = 0, cus = 0, per_cu = 0;
    hipGetDevice(&dev);
    hipDeviceGetAttribute(&cus, hipDeviceAttributeMultiprocessorCount, dev);
    if (hipFuncSetAttribute((const void*)mega_fwd, hipFuncAttributeMaxDynamicSharedMemorySize, LDS_BYTES) != hipSuccess) {
      fprintf(stderr, "kernel_launch: hipFuncSetAttribute failed\n");
      grid_blocks = -1;
      return;
    }
    hipOccupancyMaxActiveBlocksPerMultiprocessor(&per_cu, (const void*)mega_fwd, 256, LDS_BYTES);
    if (per_cu < 1) per_cu = 1;
    if (per_cu > 2) per_cu = 2;
    grid_blocks = cus * per_cu;
    fprintf(stderr, "kernel_launch: cus %d per_cu %d grid %d ws %zu\n", cus, per_cu, grid_blocks, ws_size);
  }
  if (grid_blocks < 0) return;
  Params p{};
  for (int i = 0; i < 31; i++) p.in[i] = (const float*)d_in[i];
  p.out = (float*)d_out;
  p.ws = (unsigned char*)d_ws;
  void* args[] = {&p};
  hipError_t e = hipLaunchCooperativeKernel((const void*)mega_fwd, dim3(grid_blocks), dim3(256), args, LDS_BYTES, stream);
  if (e != hipSuccess) fprintf(stderr, "cooperative launch failed: %s (grid %d)\n", hipGetErrorString(e), grid_blocks);
}
```
